# Optimizing an MI355X kernel written in HIP

```python
import math
import jax, jax.numpy as jnp
from jax import lax
import numpy as np

D_MODEL = 2048
BATCH = 1
SEQ = 8192
DEPTH = 4

BRANCH_WIDTH = D_MODEL // 2
N_BRANCH = 3
ATTN_HEAD_DIM = 128
ATTN_HEADS = BRANCH_WIDTH // ATTN_HEAD_DIM
ATTN_WIDTH = ATTN_HEADS * ATTN_HEAD_DIM
MOBA_BLOCK = 256
MOBA_TOPK = 3
QUERY_CHUNK = 64
GLA_HEADS = 4
GLA_VAL_DIM = BRANCH_WIDTH // GLA_HEADS
GLA_KEY_DIM = GLA_VAL_DIM // 2
GLA_KEY_WIDTH = GLA_HEADS * GLA_KEY_DIM
GLA_VAL_WIDTH = GLA_HEADS * GLA_VAL_DIM
GLA_GATE_RANK = 16
GLA_GATE_TAU = 16.0
GLA_CHUNK = 64
CONV_WIDTH = BRANCH_WIDTH
CONV_K = 3
D_FF = -(-8 * D_MODEL // (3 * 256)) * 256
RMS_EPS = 1e-6
COL_SIZES = (ATTN_WIDTH, ATTN_WIDTH, ATTN_WIDTH,
             GLA_KEY_WIDTH, GLA_KEY_WIDTH, GLA_VAL_WIDTH,
             GLA_VAL_WIDTH, GLA_GATE_RANK,
             CONV_WIDTH, CONV_WIDTH, CONV_WIDTH,
             N_BRANCH * D_MODEL)
N_IN_COLS = sum(COL_SIZES)

kernel_name = "hybrid_moba_gla_shortconv_swiglu"


def rms_norm(x, w):
    xf = x.astype(jnp.float32)
    y = xf * lax.rsqrt(jnp.mean(xf * xf, axis=-1, keepdims=True) + RMS_EPS)
    return (y * w.astype(jnp.float32)).astype(x.dtype)


def moba_attention(q, k, v):
    B_, S, H, dh = q.shape
    f32 = jnp.float32
    nb = -(-S // MOBA_BLOCK)
    s_pad = nb * MOBA_BLOCK
    topk = min(MOBA_TOPK, nb)
    pad = ((0, 0), (0, s_pad - S), (0, 0), (0, 0))
    kp = jnp.pad(k, pad)
    vp = jnp.pad(v, pad)
    kb = kp.reshape(B_, nb, MOBA_BLOCK, H, dh).transpose(0, 3, 1, 2, 4)
    vb = vp.reshape(B_, nb, MOBA_BLOCK, H, dh).transpose(0, 3, 1, 2, 4)
    k_mean = jnp.mean(kb.astype(f32), axis=3)
    slopes = 2.0 ** (-8.0 * jnp.arange(1, H + 1, dtype=f32) / H)
    scale = 1.0 / math.sqrt(dh)
    bi = jnp.arange(B_)[:, None, None, None]
    hi = jnp.arange(H)[None, None, :, None]
    blk_ids = jnp.arange(nb)
    in_blk = jnp.arange(MOBA_BLOCK)

    def one_chunk(c):
        start = c * QUERY_CHUNK
        qf = lax.dynamic_slice_in_dim(q, start, QUERY_CHUNK, axis=1).astype(f32)
        t_pos = start + jnp.arange(QUERY_CHUNK)
        own = start // MOBA_BLOCK
        gate = jnp.einsum("bqhd,bhnd->bqhn", qf, k_mean)
        gate = jnp.where((blk_ids < own)[None, None, None, :], gate, -jnp.inf)
        _, sel = lax.top_k(gate, topk)
        sel_valid = sel < own
        k_sel = kb[bi, hi, sel].astype(f32)
        v_sel = vb[bi, hi, sel].astype(f32)
        s_sel = jnp.einsum("bqhd,bqhnkd->bqhnk", qf, k_sel) * scale
        kpos_sel = sel[..., None] * MOBA_BLOCK + in_blk
        dist_sel = (t_pos[None, :, None, None, None] - kpos_sel).astype(f32)
        s_sel = s_sel - slopes[None, None, :, None, None] * dist_sel
        s_sel = jnp.where(sel_valid[..., None], s_sel, -jnp.inf)
        k_own = lax.dynamic_slice_in_dim(kp, own * MOBA_BLOCK, MOBA_BLOCK, axis=1).astype(f32)
        v_own = lax.dynamic_slice_in_dim(vp, own * MOBA_BLOCK, MOBA_BLOCK, axis=1).astype(f32)
        s_own = jnp.einsum("bqhd,bkhd->bqhk", qf, k_own) * scale
        dist_own = t_pos[:, None] - (own * MOBA_BLOCK + in_blk)[None, :]
        s_own = s_own - slopes[None, None, :, None] * dist_own[None, :, None, :].astype(f32)
        s_own = jnp.where((dist_own >= 0)[None, :, None, :], s_own, -jnp.inf)
        n_sel = topk * MOBA_BLOCK
        p = jax.nn.softmax(jnp.concatenate(
            [s_sel.reshape(B_, QUERY_CHUNK, H, n_sel), s_own], axis=-1), axis=-1)
        p_sel = p[..., :n_sel].reshape(B_, QUERY_CHUNK, H, topk, MOBA_BLOCK)
        out = (jnp.einsum("bqhnk,bqhnkd->bqhd", p_sel, v_sel)
               + jnp.einsum("bqhk,bkhd->bqhd", p[..., n_sel:], v_own))
        return out.astype(q.dtype)

    outs = lax.map(one_chunk, jnp.arange(S // QUERY_CHUNK))
    return outs.transpose(1, 0, 2, 3, 4).reshape(B_, S, H, dh)


def gla_attention(q, k, v, log_a):
    B_, S, H, dk = q.shape
    dv = v.shape[-1]
    f32 = jnp.float32
    n = S // GLA_CHUNK

    def chunked(t):
        return t.astype(f32).reshape(B_, n, GLA_CHUNK, H, t.shape[-1]).transpose(0, 3, 1, 2, 4)

    qc = chunked(q) * (dk ** -0.5)
    kc, vc = chunked(k), chunked(v)
    b = jnp.cumsum(chunked(log_a), axis=3)
    b_last = b[..., -1:, :]
    q_in = qc * jnp.exp(b)
    k_in = kc * jnp.exp(-b)
    k_dec = kc * jnp.exp(b_last - b)
    causal = jnp.tril(jnp.ones((GLA_CHUNK, GLA_CHUNK), dtype=bool))
    a_intra = jnp.where(causal, jnp.einsum("bhncd,bhnsd->bhncs", q_in, k_in), 0.0)
    o_intra = jnp.einsum("bhncs,bhnse->bhnce", a_intra, vc)
    kv = jnp.einsum("bhncd,bhnce->bhnde", k_dec, vc)
    decay = jnp.exp(b_last[..., 0, :])

    def step(state, inp):
        kv_n, d_n = inp
        return d_n[..., None] * state + kv_n, state

    _, s_prev = lax.scan(step, jnp.zeros((B_, H, dk, dv), f32),
                         (kv.transpose(2, 0, 1, 3, 4), decay.transpose(2, 0, 1, 3)))
    s_prev = s_prev.transpose(1, 2, 0, 3, 4)
    o = o_intra + jnp.einsum("bhncd,bhnde->bhnce", q_in, s_prev)
    return o.transpose(0, 2, 3, 1, 4).reshape(B_, S, H, dv)


def short_conv(u, w):
    ch = u.shape[-1]
    return lax.conv_general_dilated(
        u, w[:, None, :].astype(u.dtype), window_strides=(1,), padding=[(CONV_K - 1, 0)],
        dimension_numbers=("NWC", "WIO", "NWC"), feature_group_count=ch)


def setup_inputs(seed: int = 0) -> dict:
    key = jax.random.key(seed)
    ks = jax.random.split(key, 16)
    L, D = DEPTH, D_MODEL
    nrm = lambda k, shape, s: jax.random.normal(k, shape, jnp.float32) * s
    gain = lambda k, shape: 1.0 + 0.02 * jax.random.normal(k, shape, jnp.float32)
    return {
        "x": nrm(ks[0], (BATCH, SEQ, D), 1.0),
        "norm1_w": gain(ks[1], (L, D)),
        "w_in": nrm(ks[2], (L, D, N_IN_COLS), D ** -0.5),
        "gla_w_up": nrm(ks[3], (L, GLA_GATE_RANK, GLA_KEY_WIDTH), GLA_GATE_RANK ** -0.5),
        "gla_b": nrm(ks[4], (L, GLA_KEY_WIDTH), 0.02),
        "gla_norm_w": gain(ks[5], (L, GLA_VAL_DIM)),
        "conv_w": nrm(ks[6], (L, CONV_K, CONV_WIDTH), CONV_K ** -0.5),
        "w_br_attn": nrm(ks[7], (L, ATTN_WIDTH, D), ATTN_WIDTH ** -0.5),
        "w_br_gla": nrm(ks[8], (L, GLA_VAL_WIDTH, D), GLA_VAL_WIDTH ** -0.5),
        "w_br_conv": nrm(ks[9], (L, CONV_WIDTH, D), CONV_WIDTH ** -0.5),
        "w_out": nrm(ks[10], (L, D, D), D ** -0.5),
        "norm2_w": gain(ks[11], (L, D)),
        "w_ffn_gate": nrm(ks[12], (L, D, D_FF), D ** -0.5),
        "w_ffn_up": nrm(ks[13], (L, D, D_FF), D ** -0.5),
        "w_ffn_down": nrm(ks[14], (L, D_FF, D), D_FF ** -0.5),
        "final_norm_w": gain(ks[15], (D,)),
    }


def reference(x, norm1_w, w_in, gla_w_up, gla_b, gla_norm_w, conv_w, w_br_attn, w_br_gla,
              w_br_conv, w_out, norm2_w, w_ffn_gate, w_ffn_up, w_ffn_down, final_norm_w):
    B_, S, D = x.shape
    f32 = jnp.float32
    splits = [int(s) for s in np.cumsum(COL_SIZES)[:-1]]
    for l in range(DEPTH):
        h = rms_norm(x, norm1_w[l])
        proj = h @ w_in[l]
        (q_a, k_a, v_a, q_g, k_g, v_g, r_g, a_down,
         b_gate, c_gate, u_conv, merge) = jnp.split(proj, splits, axis=-1)
        hs_a = (B_, S, ATTN_HEADS, ATTN_HEAD_DIM)
        o_a = moba_attention(q_a.reshape(hs_a), k_a.reshape(hs_a), v_a.reshape(hs_a))
        br_a = o_a.reshape(B_, S, ATTN_WIDTH) @ w_br_attn[l]
        z = (a_down @ gla_w_up[l]).astype(f32) + gla_b[l].astype(f32)
        log_a = jax.nn.log_sigmoid(z) / GLA_GATE_TAU
        hs_k = (B_, S, GLA_HEADS, GLA_KEY_DIM)
        o_g = gla_attention(q_g.reshape(hs_k), k_g.reshape(hs_k),
                            v_g.reshape(B_, S, GLA_HEADS, GLA_VAL_DIM), log_a.reshape(hs_k))
        o_g = o_g * lax.rsqrt(jnp.mean(o_g * o_g, axis=-1, keepdims=True) + RMS_EPS)
        o_g = o_g * gla_norm_w[l].astype(f32)
        o_g = o_g.reshape(B_, S, GLA_VAL_WIDTH) * jax.nn.silu(r_g.astype(f32))
        br_b = o_g.astype(x.dtype) @ w_br_gla[l]
        y_c = b_gate * short_conv(c_gate * u_conv, conv_w[l])
        br_c = y_c @ w_br_conv[l]
        g = jax.nn.sigmoid(merge.astype(f32)).reshape(B_, S, N_BRANCH, D)
        mixed = (g[:, :, 0] * br_a.astype(f32) + g[:, :, 1] * br_b.astype(f32)
                 + g[:, :, 2] * br_c.astype(f32)).astype(x.dtype)
        x = x + mixed @ w_out[l]
        h2 = rms_norm(x, norm2_w[l])
        x = x + (jax.nn.silu(h2 @ w_ffn_gate[l]) * (h2 @ w_ffn_up[l])) @ w_ffn_down[l]
    return rms_norm(x, final_norm_w)
```

```cpp
#include <hip/hip_runtime.h>
#include <cstdio>
#include <cstdint>
#include <cmath>
namespace pg8 {
#define PG8_LAS __attribute__((address_space(3)))
typedef unsigned short bf16_t;
typedef short bf16x8 __attribute__((ext_vector_type(8)));
typedef float f32x4 __attribute__((ext_vector_type(4)));
typedef unsigned u32x4 __attribute__((ext_vector_type(4)));
constexpr int BM = 256, BK = 64, HALF = 128, HTB = HALF * BK * 2  , STAGE_BYTES = 8 * HTB, NXCD = 8, WGM = 8;

__host__ __device__ __forceinline__ int lds_byte(int r, int c) { const int st = (r >> 4) * 2 + (c >> 5), rr = r & 15, cc = c & 31, ob = rr * 64 + cc * 2; return st * 1024 + (ob ^ (((ob >> 9) & 1) << 5)); }
__host__ __device__ __forceinline__ void stage_rc(int b, int& R, int& C) { const int st = b / 1024, sb = b % 1024, swz = sb ^ (((sb >> 9) & 1) << 5); R = (st >> 1) * 16 + swz / 64; C = (st & 1) * 32 + (swz % 64) / 2; }
__host__ __device__ __forceinline__ int perm32(int rho) { const int n = rho >> 4, i = rho & 15; return 8 * (i >> 2) + 4 * n + (i & 3); }

struct Unit { int pm, pn; };
struct Gemm { const bf16_t* A; const bf16_t* Bt; int M, N, K; };

struct StaticOrder {
    int nM, nN, nwg, G, c;
    __host__ __device__ void init(int M, int N, int G_, int c_) { nM = M / BM; nN = N / BM; nwg = nM * nN; G = G_; c = c_; }
    __host__ __device__ bool next(int i, Unit& u) const {
        const long L = (long)i * G + c; if (L >= nwg) return false;
        int wgid = (int)L; { const int q = nwg / NXCD, r = nwg % NXCD, xcd = wgid % NXCD, off = wgid / NXCD; wgid = (xcd < r ? xcd * (q + 1) : r * (q + 1) + (xcd - r) * q) + off; }
        const int nig = WGM * nN, gid = wgid / nig, fm = gid * WGM, gsz = (nM - fm) < WGM ? (nM - fm) : WGM;
        u.pm = fm + ((wgid % nig) % gsz); u.pn = (wgid % nig) / gsz; return true;
    }
    __device__ __forceinline__ void a_ready(const Unit&) const {}
    __device__ __forceinline__ void done(const Unit&) const {}
};

__device__ __forceinline__ unsigned cvt_pk_bf16(float lo, float hi) { unsigned r; asm volatile("v_cvt_pk_bf16_f32 %0, %1, %2" : "=v"(r) : "v"(lo), "v"(hi)); return r; }
template <class Epi, class Sched, bool ALIGN_EPI = false, bool SP2 = false>
__device__ __forceinline__ void gemm_phase(PG8_LAS unsigned char* lds, const Gemm g, const Sched& S, const Epi& E) {
    int tid_ = threadIdx.x; asm volatile("" : "+v"(tid_));
    const int tid = tid_, wid = __builtin_amdgcn_readfirstlane(tid >> 6), lane = tid & 63, wr = wid >> 2, wc = wid & 3, fr = lane & 15, fq = lane >> 4;
    const int K = g.K, nt = K / BK;
    unsigned voffA[2], voffB[2];
#pragma unroll
    for (int i = 0; i < 2; ++i) { int R, C; stage_rc(tid * 16 + i * 8192, R, C); const int Rb = Epi::PERM ? ((R & ~31) + perm32(R & 31)) : R;
        voffA[i] = (unsigned)(R * K + C) * 2u; voffB[i] = (unsigned)(Rb * K + C) * 2u; }
    const size_t kstep = (size_t)(BK * 2);
    const size_t hstep = (size_t)HALF * K * 2;
    const size_t tstep = 2 * hstep;
    const unsigned ldsw = (unsigned)wid * 1024u;
    const int aoff = lds_byte(wr * 64 + fr, fq * 8), boff = lds_byte(wc * 32 + fr, fq * 8);
#define PG8_SA(b, h) (((b) * 2 + (h)) * HTB)
#define PG8_SB(b, h) ((4 + (b) * 2 + (h)) * HTB)
#define PG8_STAGE(bufoff, gbase, voff) do { _Pragma("unroll") for (int _i = 0; _i < 2; ++_i) \
        __builtin_amdgcn_global_load_lds((const unsigned*)((const char*)(gbase) + (voff)[_i]), (PG8_LAS unsigned*)(lds + (bufoff) + ldsw + _i * 8192), 16, 0, 0); } while (0)
#define PG8_LDA(dst, b, h) do { _Pragma("unroll") for (int m = 0; m < 4; ++m) _Pragma("unroll") for (int k = 0; k < 2; ++k) dst[m][k] = *(const PG8_LAS bf16x8*)(lds + PG8_SA(b, h) + aoff + m * 2048 + k * 1024); } while (0)
#define PG8_LDB(dst, b, h) do { _Pragma("unroll") for (int n = 0; n < 2; ++n) _Pragma("unroll") for (int k = 0; k < 2; ++k) dst[n][k] = *(const PG8_LAS bf16x8*)(lds + PG8_SB(b, h) + boff + n * 2048 + k * 1024); } while (0)
#define PG8_MMA(ai, bj, At, Bt) do { __builtin_amdgcn_s_setprio(1); _Pragma("unroll") for (int m = 0; m < 4; ++m) _Pragma("unroll") for (int n = 0; n < 2; ++n) _Pragma("unroll") for (int k = 0; k < 2; ++k) \
        acc[ai][bj][m][n] = __builtin_amdgcn_mfma_f32_16x16x32_bf16(Bt[n][k], At[m][k], acc[ai][bj][m][n], 0, 0, 0); __builtin_amdgcn_s_setprio(0); } while (0)
#define PG8_WAIT_V(n) asm volatile("s_waitcnt vmcnt(" #n ")" ::: "memory")
#define PG8_WAIT_L(n) asm volatile("s_waitcnt lgkmcnt(" #n ")" ::: "memory")
#define PG8_BAR __builtin_amdgcn_s_barrier()
#define PG8_SCHED __builtin_amdgcn_sched_barrier(0)
    Unit cur, nxt; int ui = 0;
    if (!S.next(0, cur)) return;
    f32x4 acc[2][2][4][2];
#pragma unroll
    for (int a = 0; a < 2; ++a)
#pragma unroll
        for (int b = 0; b < 2; ++b)
#pragma unroll
            for (int m = 0; m < 4; ++m)
#pragma unroll
                for (int n = 0; n < 2; ++n) acc[a][b][m][n] = (f32x4){0.f, 0.f, 0.f, 0.f};
    bf16x8 At[4][2], B0[2][2], B1[2][2];
    const char* cA = (const char*)g.A + (size_t)cur.pm * tstep; const char* cB = (const char*)g.Bt + (size_t)cur.pn * tstep;
    S.a_ready(cur);
    if constexpr (SP2) {
        PG8_STAGE(PG8_SB(0, 0), cB, voffB); PG8_STAGE(PG8_SB(0, 1), cB + hstep, voffB); PG8_STAGE(PG8_SA(0, 0), cA, voffA); PG8_STAGE(PG8_SA(0, 1), cA + hstep, voffA);
        if (wr == 1) PG8_BAR;
        PG8_WAIT_V(2); PG8_BAR;
        PG8_STAGE(PG8_SB(1, 0), cB + kstep, voffB); PG8_STAGE(PG8_SA(1, 0), cA + kstep, voffA); PG8_STAGE(PG8_SB(1, 1), cB + hstep + kstep, voffB);
        PG8_WAIT_V(6); PG8_BAR;
    } else {
        PG8_STAGE(PG8_SB(0, 0), cB, voffB); PG8_STAGE(PG8_SA(0, 0), cA, voffA); PG8_STAGE(PG8_SB(0, 1), cB + hstep, voffB); PG8_STAGE(PG8_SA(0, 1), cA + hstep, voffA);
        if (wr == 1) PG8_BAR;
        PG8_WAIT_V(4); PG8_BAR;
        PG8_STAGE(PG8_SB(1, 0), cB + kstep, voffB); PG8_STAGE(PG8_SA(1, 0), cA + kstep, voffA); PG8_STAGE(PG8_SB(1, 1), cB + hstep + kstep, voffB);
        PG8_WAIT_V(6); PG8_BAR;
    }
    for (;;) {
        const bool has_next = S.next(ui + 1, nxt);
        const char* nA = has_next ? (const char*)g.A + (size_t)nxt.pm * tstep : cA; const char* nB = has_next ? (const char*)g.Bt + (size_t)nxt.pn * tstep : cB;
        for (int t = 0; t < nt; t += 2) {
            const bool last = (t == nt - 2);
            const char* a1 = cA + (size_t)(t + 1) * kstep;
            const char* a2 = last ? nA : cA + (size_t)(t + 2) * kstep; const char* b2 = last ? nB : cB + (size_t)(t + 2) * kstep;
            const char* a3 = a2 + kstep; const char* b3 = b2 + kstep;
            if (last && has_next) S.a_ready(nxt);
            if constexpr (SP2) {
            PG8_LDB(B0, 0, 0); PG8_LDB(B1, 0, 1); PG8_SCHED; PG8_LDA(At, 0, 0); PG8_STAGE(PG8_SA(1, 1), a1 + hstep, voffA);
            PG8_WAIT_V(8); PG8_WAIT_L(0); PG8_BAR; PG8_MMA(0, 0, At, B0); PG8_MMA(0, 1, At, B1); PG8_BAR; PG8_SCHED;
            PG8_LDA(At, 0, 1); PG8_STAGE(PG8_SB(0, 0), b2, voffB); PG8_STAGE(PG8_SB(0, 1), b2 + hstep, voffB); PG8_STAGE(PG8_SA(0, 0), a2, voffA);
            PG8_WAIT_V(8); PG8_WAIT_L(0); PG8_BAR; PG8_MMA(1, 0, At, B0); PG8_MMA(1, 1, At, B1); PG8_BAR; PG8_SCHED;
            PG8_LDB(B0, 1, 0); PG8_LDB(B1, 1, 1); PG8_SCHED; PG8_LDA(At, 1, 0); PG8_STAGE(PG8_SA(0, 1), a2 + hstep, voffA);
            PG8_WAIT_V(8); PG8_WAIT_L(0); PG8_BAR; PG8_MMA(0, 0, At, B0); PG8_MMA(0, 1, At, B1); PG8_BAR; PG8_SCHED;
            PG8_LDA(At, 1, 1); PG8_STAGE(PG8_SB(1, 0), b3, voffB); PG8_STAGE(PG8_SB(1, 1), b3 + hstep, voffB); PG8_STAGE(PG8_SA(1, 0), a3, voffA);
            PG8_WAIT_V(8); PG8_WAIT_L(0); PG8_BAR; PG8_MMA(1, 0, At, B0); PG8_MMA(1, 1, At, B1); PG8_BAR; PG8_SCHED;
            } else {
            PG8_LDB(B0, 0, 0); PG8_SCHED; PG8_LDA(At, 0, 0); PG8_STAGE(PG8_SA(1, 1), a1 + hstep, voffA);
            PG8_WAIT_L(8); PG8_BAR; PG8_WAIT_L(0); PG8_MMA(0, 0, At, B0); PG8_BAR; PG8_SCHED;
            PG8_LDB(B1, 0, 1); PG8_STAGE(PG8_SB(0, 0), b2, voffB);
            PG8_BAR; PG8_WAIT_L(0); PG8_MMA(0, 1, At, B1); PG8_BAR;
            PG8_LDA(At, 0, 1); PG8_STAGE(PG8_SA(0, 0), a2, voffA);
            PG8_BAR; PG8_WAIT_L(0); PG8_MMA(1, 0, At, B0); PG8_BAR; PG8_SCHED;
            PG8_STAGE(PG8_SB(0, 1), b2 + hstep, voffB);
            PG8_WAIT_V(6); PG8_BAR; PG8_MMA(1, 1, At, B1); PG8_BAR;
            PG8_LDB(B0, 1, 0); PG8_SCHED; PG8_LDA(At, 1, 0); PG8_STAGE(PG8_SA(0, 1), a2 + hstep, voffA);
            PG8_WAIT_L(8); PG8_BAR; PG8_WAIT_L(0); PG8_MMA(0, 0, At, B0); PG8_BAR; PG8_SCHED;
            PG8_LDB(B1, 1, 1); PG8_STAGE(PG8_SB(1, 0), b3, voffB);
            PG8_BAR; PG8_WAIT_L(0); PG8_MMA(0, 1, At, B1); PG8_BAR;
            PG8_LDA(At, 1, 1); PG8_STAGE(PG8_SA(1, 0), a3, voffA);
            PG8_BAR; PG8_WAIT_L(0); PG8_MMA(1, 0, At, B0); PG8_BAR; PG8_SCHED;
            PG8_STAGE(PG8_SB(1, 1), b3 + hstep, voffB);
            PG8_WAIT_V(6); PG8_BAR; PG8_MMA(1, 1, At, B1); PG8_BAR;
            }
        }
        if constexpr (ALIGN_EPI) { if (wr == 0) PG8_BAR; }
        if constexpr (!Epi::AFTER_DRAIN) { E(acc, cur, wr, wc, fr, fq); S.done(cur); }
        if (!has_next) break;
#pragma unroll
        for (int a = 0; a < 2; ++a)
#pragma unroll
            for (int b = 0; b < 2; ++b)
#pragma unroll
                for (int m = 0; m < 4; ++m)
#pragma unroll
                    for (int n = 0; n < 2; ++n) acc[a][b][m][n] = (f32x4){0.f, 0.f, 0.f, 0.f};
        cur = nxt; cA = nA; cB = nB; ++ui;
        if constexpr (ALIGN_EPI) { if (wr == 1) PG8_BAR; }
    }
    PG8_WAIT_V(0);
    if constexpr (!ALIGN_EPI) { if (wr == 0) PG8_BAR; }
    PG8_BAR;
    if constexpr (Epi::AFTER_DRAIN) { E.fused(acc, cur, wr, wc, fr, fq, lds, wid, lane); S.done(cur); }
#undef PG8_SA
#undef PG8_SB
#undef PG8_STAGE
#undef PG8_LDA
#undef PG8_LDB
#undef PG8_MMA
#undef PG8_WAIT_V
#undef PG8_WAIT_L
#undef PG8_BAR
#undef PG8_SCHED
}
}
#define GAS __attribute__((address_space(1)))
#define LAS __attribute__((address_space(3)))
typedef unsigned short bf16;
typedef unsigned v4u __attribute__((ext_vector_type(4)));
typedef float f32x4 __attribute__((ext_vector_type(4)));
typedef short bf16x8 __attribute__((ext_vector_type(8)));
typedef GAS unsigned gu32;
typedef GAS unsigned long long gu64;
#define RLX_AGENT __ATOMIC_RELAXED, __HIP_MEMORY_SCOPE_AGENT
#define LDS_WAIT() asm volatile("s_waitcnt lgkmcnt(0)" ::: "memory")
#define VM_WAIT() asm volatile("s_waitcnt vmcnt(0)" ::: "memory")
__device__ __forceinline__ unsigned long long rt() { return __builtin_amdgcn_s_memrealtime(); }
__device__ __forceinline__ unsigned f2bf(float f) { unsigned u = __builtin_bit_cast(unsigned, f); return (u + 0x7fffu + ((u >> 16) & 1u)) >> 16; }
__device__ __forceinline__ unsigned pk2(float lo, float hi) { return f2bf(lo) | (f2bf(hi) << 16); }
#define XB_TMO      128
#define XB_XCNT(j)  (256  + 64 * (j))
#define XB_XSUB(j)  (1280 + 64 * (j))
#define XB_XGEN(j)  (2304 + 64 * (j))
#define XB_TOP      3328
#define XB_TOPGEN   3392
#define XCD_BAR_WORDS 3456
#define XB_SPIN_CAP (1u << 18)

__device__ __forceinline__ unsigned xb_ld(unsigned* p)              { return __hip_atomic_load(p, __ATOMIC_RELAXED, __HIP_MEMORY_SCOPE_AGENT); }
__device__ __forceinline__ unsigned xb_add(unsigned* p, unsigned v) { return __hip_atomic_fetch_add(p, v, __ATOMIC_RELAXED, __HIP_MEMORY_SCOPE_AGENT); }
__device__ __forceinline__ unsigned xb_xcc_id() { return (unsigned)__builtin_amdgcn_s_getreg((3 << 11) | 20) & 0xFu; }
#define XB_SPIN(cond, bar) do { unsigned _sp = 0; while (cond) { __builtin_amdgcn_s_sleep(1); \
    if ((++_sp & 255u) == 0u) { if (xb_ld(&(bar)[XB_TMO])) break; if (_sp > XB_SPIN_CAP) { atomicAdd(&(bar)[XB_TMO], 1u); break; } } } } while (0)

struct XcdBarrier {
    unsigned* bar; unsigned x;
    volatile LAS unsigned* st;
};

__device__ __forceinline__ XcdBarrier xcd_barrier_post(unsigned* bar, volatile LAS unsigned* st) {
    XcdBarrier b; b.bar = bar; b.x = xb_xcc_id(); b.st = st;
    if (threadIdx.x == 0) (void)xb_add(&bar[XB_XCNT(b.x)], 1u);
    return b;
}
__device__ __forceinline__ void xcd_barrier_complete(unsigned* bar, unsigned x, unsigned& nloc, unsigned& nx) {
    const unsigned G = gridDim.x * gridDim.y * gridDim.z;
    unsigned sum, cnt, mine, sp = 0u;
    for (;;) {
        sum = 0u; cnt = 0u; mine = 0u;
#pragma unroll
        for (unsigned j = 0; j < 16; ++j) { const unsigned c = xb_ld(&bar[XB_XCNT(j)]); sum += c; cnt += (c > 0u) ? 1u : 0u; mine = (j == x) ? c : mine; }
        if (sum == G) break;
        __builtin_amdgcn_s_sleep(1);
        if ((++sp & 255u) == 0u) { if (xb_ld(&bar[XB_TMO])) break; if (sp > XB_SPIN_CAP) { atomicAdd(&bar[XB_TMO], 1u); break; } }
    }
    nloc = mine > 0u ? mine : 1u; nx = cnt > 0u ? cnt : 1u;
}

__device__ __forceinline__ void xcd_barrier(const XcdBarrier& b) {
    asm volatile("s_waitcnt vmcnt(0)" ::: "memory");
    __syncthreads();
    if (threadIdx.x == 0) {
        unsigned* bar = b.bar;
        __builtin_amdgcn_s_waitcnt(0);
        unsigned nloc = b.st[0], nx = b.st[1];
        if (nloc == 0u) { xcd_barrier_complete(bar, b.x, nloc, nx); b.st[0] = nloc; b.st[1] = nx; }
        const unsigned old = xb_add(&bar[XB_XSUB(b.x)], 1u);
        const unsigned gen = old / nloc;
        if (old + 1u == (gen + 1u) * nloc) {
            __builtin_amdgcn_fence(__ATOMIC_RELEASE, "agent");
            asm volatile("s_waitcnt vmcnt(0)" ::: "memory");
            const unsigned og = xb_add(&bar[XB_TOP], 1u);
            const unsigned tg = og / nx;
            if (og + 1u == (tg + 1u) * nx) xb_add(&bar[XB_TOPGEN], 1u);
            else XB_SPIN(xb_ld(&bar[XB_TOPGEN]) == tg, bar);
            __builtin_amdgcn_fence(__ATOMIC_ACQUIRE, "agent");
            xb_add(&bar[XB_XGEN(b.x)], 1u);
            asm volatile("s_waitcnt vmcnt(0)" ::: "memory");
        } else {
            XB_SPIN(xb_ld(&bar[XB_XGEN(b.x)]) == gen, bar);
            __builtin_amdgcn_fence(__ATOMIC_ACQUIRE, "agent");
            asm volatile("s_waitcnt vmcnt(0)" ::: "memory");
        }
    }
    __syncthreads();
}
constexpr int S = 8192, D = 2048, NL = 4, DFF = 5632, NIN = 15376, NPROJ = 15872, LDP = 14336, NWAVES = 8;
constexpr int PC_QA = 0, PC_KA = 1024, PC_VA = 2048, PC_QG = 3072, PC_KG = 3584, PC_VG = 4096, PC_RG = 5120, PC_BG = 6144, PC_CU = 7168, PC_G = 8192;
constexpr float RMS_EPS = 1e-6f;
constexpr float FIX_SCALE = 1048576.0f;
constexpr int NPH = 34;
typedef unsigned long long u64;

constexpr size_t MiB = 1u << 20;
constexpr size_t WS_CTL = 0, CTL_ZERO_BYTES = 1 * MiB;
constexpr int CW_BAR = 4096;
constexpr size_t CTL_STATS = 65536;
static_assert(CTL_STATS + (size_t)9 * S * 8 <= CTL_ZERO_BYTES && (CW_BAR + XCD_BAR_WORDS) * 4 <= (int)CTL_STATS, "ctl map");
constexpr size_t W_IN_B = (size_t)NPROJ * D * 2, W_BR_B = (size_t)3 * D * 1024 * 2, W_OUT_B = (size_t)D * D * 2, W_GU_B = (size_t)2 * DFF * D * 2, W_DN_B = (size_t)D * DFF * 2;
constexpr size_t WL_IN = 0, WL_BR = WL_IN + W_IN_B, WL_OUT = WL_BR + W_BR_B, WL_GU = WL_OUT + W_OUT_B, WL_DN = WL_GU + W_GU_B, WL_BYTES = WL_DN + W_DN_B;
constexpr size_t WS_W = 1 * MiB;
constexpr size_t WS_XB = WS_W + NL * WL_BYTES;
constexpr size_t WS_PROJ = WS_XB + (size_t)S * D * 2;
constexpr size_t WS_LA = WS_PROJ + (size_t)S * LDP * 2;
constexpr size_t WS_A3 = WS_LA + (size_t)S * 512 * 4;
constexpr size_t WS_KMEAN = WS_A3 + (size_t)3 * S * 1024 * 2;
constexpr size_t WS_DECAY = WS_KMEAN + (size_t)32 * 1024 * 4;
constexpr size_t WS_KV = WS_DECAY + (size_t)4 * 128 * 128 * 4;
constexpr size_t WS_SPREV = WS_KV + (size_t)4 * 128 * 128 * 256 * 4;
constexpr size_t WS_T = WS_SPREV + (size_t)4 * 128 * 128 * 256 * 4;
constexpr size_t WS_MIXED = WS_T + (size_t)S * D * 4;
constexpr size_t WS_ACT = WS_MIXED + (size_t)S * D * 2;
constexpr size_t WS_END = WS_ACT + (size_t)S * DFF * 2;
static_assert(WS_END < (size_t)1900 * MiB, "workspace");
static_assert(WL_BYTES % 256 == 0 && WS_XB % 256 == 0 && WS_PROJ % 256 == 0 && WS_LA % 256 == 0 && WS_A3 % 256 == 0 && WS_KV % 256 == 0 && WS_T % 256 == 0 && WS_ACT % 256 == 0, "alignment");

constexpr int RING_BYTES = 131072, LDSCTL_OFF = RING_BYTES, MISC_OFF = LDSCTL_OFF + 320, LDS_BYTES = 147456;

__device__ __forceinline__ float bflo(unsigned w) { return __uint_as_float(w << 16); }
__device__ __forceinline__ float bfhi(unsigned w) { return __uint_as_float(w & 0xffff0000u); }
__device__ __forceinline__ float bf2f(bf16 b) { return __uint_as_float(((unsigned)b) << 16); }
__device__ __forceinline__ float wave_sum(float v) {
#pragma unroll
    for (int o = 1; o < 64; o <<= 1) v += __shfl_xor(v, o);
    return v;
}
__device__ __forceinline__ float wave_max(float v) {
#pragma unroll
    for (int o = 1; o < 64; o <<= 1) v = fmaxf(v, __shfl_xor(v, o));
    return v;
}
__device__ __forceinline__ float inv_rms_of(const u64* st, int row) { return rsqrtf((float)st[row] * (1.0f / (FIX_SCALE * (float)D)) + RMS_EPS); }

struct EpiProj {
    static constexpr bool PERM = true, AFTER_DRAIN = false;
    bf16* proj; float* la; const u64* st; const float* glab;
    __device__ __forceinline__ void operator()(const pg8::f32x4 (&acc)[2][2][4][2], const pg8::Unit& u, int wr, int wc, int fr, int fq) const {
        const int row0 = u.pm * 256 + wr * 64 + fr, pn = u.pn, cw = wc * 32 + 8 * fq;
#pragma unroll
        for (int ai = 0; ai < 2; ++ai)
#pragma unroll
            for (int m = 0; m < 4; ++m) {
                const int row = row0 + ai * 128 + m * 16; const float ir = inv_rms_of(st, row);
                if (pn < 28 || (pn >= 36 && pn < 60)) {
                    const bool sig = pn >= 36;
                    bf16* rowp = proj + (size_t)row * LDP + (sig ? PC_G + (pn - 36) * 256 : pn * 256) + cw;
#pragma unroll
                    for (int bj = 0; bj < 2; ++bj) { pg8::f32x4 v0 = acc[ai][bj][m][0] * ir, v1 = acc[ai][bj][m][1] * ir;
                        if (sig) {
#pragma unroll
                            for (int j = 0; j < 4; ++j) { v0[j] = 1.0f / (1.0f + __expf(-v0[j])); v1[j] = 1.0f / (1.0f + __expf(-v1[j])); } }
                        pg8::u32x4 w; w.x = pg8::cvt_pk_bf16(v0[0], v0[1]); w.y = pg8::cvt_pk_bf16(v0[2], v0[3]); w.z = pg8::cvt_pk_bf16(v1[0], v1[1]); w.w = pg8::cvt_pk_bf16(v1[2], v1[3]);
                        *(pg8::u32x4*)(rowp + bj * 128) = w; }
                } else if (pn < 36) {
                    bf16* rowp = proj + (size_t)row * LDP + PC_CU + (pn - 28) * 128 + cw;
                    const pg8::f32x4 v0 = (acc[ai][0][m][0] * ir) * (acc[ai][1][m][0] * ir), v1 = (acc[ai][0][m][1] * ir) * (acc[ai][1][m][1] * ir);
                    pg8::u32x4 w; w.x = pg8::cvt_pk_bf16(v0[0], v0[1]); w.y = pg8::cvt_pk_bf16(v0[2], v0[3]); w.z = pg8::cvt_pk_bf16(v1[0], v1[1]); w.w = pg8::cvt_pk_bf16(v1[2], v1[3]);
                    *(pg8::u32x4*)rowp = w;
                } else {
#pragma unroll
                    for (int bj = 0; bj < 2; ++bj) { const int col = (pn - 60) * 256 + bj * 128 + cw; float* rowp = la + (size_t)row * 512 + col;
#pragma unroll
                        for (int n = 0; n < 2; ++n) { const pg8::f32x4 bv = *(const pg8::f32x4*)(glab + col + 4 * n); pg8::f32x4 z = acc[ai][bj][m][n] * ir + bv, o;
#pragma unroll
                            for (int j = 0; j < 4; ++j) o[j] = (fminf(z[j], 0.f) - log1pf(__expf(-fabsf(z[j])))) * 0.0625f;
                            *(pg8::f32x4*)(rowp + 4 * n) = o; } }
                }
            }
    }
};
struct EpiBranch {
    static constexpr bool PERM = true, AFTER_DRAIN = false;
    const bf16* proj; float* T; bf16* mixed;
    __device__ __forceinline__ void operator()(const pg8::f32x4 (&acc)[2][2][4][2], const pg8::Unit& u, int wr, int wc, int fr, int fq) const {
        const int b = u.pm >> 5, pm = u.pm & 31, pn = u.pn & 7;
        const int row0 = pm * 256 + wr * 64 + fr, col0 = pn * 256 + wc * 32 + 8 * fq;
#pragma unroll
        for (int ai = 0; ai < 2; ++ai)
#pragma unroll
            for (int m = 0; m < 4; ++m) { const int row = row0 + ai * 128 + m * 16;
#pragma unroll
                for (int bj = 0; bj < 2; ++bj) { const int col = col0 + bj * 128;
                    const pg8::u32x4 gw = *(const pg8::u32x4*)(proj + (size_t)row * LDP + PC_G + b * D + col);
                    pg8::f32x4 v0 = acc[ai][bj][m][0], v1 = acc[ai][bj][m][1];
                    v0[0] *= bflo(gw.x); v0[1] *= bfhi(gw.x); v0[2] *= bflo(gw.y); v0[3] *= bfhi(gw.y); v1[0] *= bflo(gw.z); v1[1] *= bfhi(gw.z); v1[2] *= bflo(gw.w); v1[3] *= bfhi(gw.w);
                    float* tp = T + (size_t)row * D + col;
                    if (b > 0) { v0 += *(const pg8::f32x4*)tp; v1 += *(const pg8::f32x4*)(tp + 4); }
                    if (b < 2) { *(pg8::f32x4*)tp = v0; *(pg8::f32x4*)(tp + 4) = v1; }
                    else { pg8::u32x4 w; w.x = pg8::cvt_pk_bf16(v0[0], v0[1]); w.y = pg8::cvt_pk_bf16(v0[2], v0[3]); w.z = pg8::cvt_pk_bf16(v1[0], v1[1]); w.w = pg8::cvt_pk_bf16(v1[2], v1[3]);
                        *(pg8::u32x4*)(mixed + (size_t)row * D + col) = w; } }
                asm volatile("" ::: "memory"); }
    }
};
struct BranchOrder {
    pg8::StaticOrder so;
    __device__ bool next(int i, pg8::Unit& u) const { pg8::Unit t; if (!so.next(i / 3, t)) return false; const int b = i % 3; u.pm = b * 32 + t.pm; u.pn = b * 8 + t.pn; return true; }
    __device__ __forceinline__ void a_ready(const pg8::Unit&) const {}
    __device__ __forceinline__ void done(const pg8::Unit&) const {}
};
struct EpiResid {
    static constexpr bool PERM = true, AFTER_DRAIN = false;
    float* X; bf16* XB; u64* st;
    __device__ __forceinline__ void operator()(const pg8::f32x4 (&acc)[2][2][4][2], const pg8::Unit& u, int wr, int wc, int fr, int fq) const {
        const int row0 = u.pm * 256 + wr * 64 + fr, col0 = u.pn * 256 + wc * 32 + 8 * fq;
#pragma unroll
        for (int ai = 0; ai < 2; ++ai)
#pragma unroll
            for (int m = 0; m < 4; ++m) { const int row = row0 + ai * 128 + m * 16; float ss = 0.f;
#pragma unroll
                for (int bj = 0; bj < 2; ++bj) { const int col = col0 + bj * 128; float* xp = X + (size_t)row * D + col;
                    const pg8::f32x4 v0 = *(const pg8::f32x4*)xp + acc[ai][bj][m][0], v1 = *(const pg8::f32x4*)(xp + 4) + acc[ai][bj][m][1];
                    *(pg8::f32x4*)xp = v0; *(pg8::f32x4*)(xp + 4) = v1;
                    ss += (v0[0] * v0[0] + v0[1] * v0[1]) + (v0[2] * v0[2] + v0[3] * v0[3]) + (v1[0] * v1[0] + v1[1] * v1[1]) + (v1[2] * v1[2] + v1[3] * v1[3]);
                    pg8::u32x4 w; w.x = pg8::cvt_pk_bf16(v0[0], v0[1]); w.y = pg8::cvt_pk_bf16(v0[2], v0[3]); w.z = pg8::cvt_pk_bf16(v1[0], v1[1]); w.w = pg8::cvt_pk_bf16(v1[2], v1[3]);
                    *(pg8::u32x4*)(XB + (size_t)row * D + col) = w; }
                ss += __shfl_xor(ss, 16); ss += __shfl_xor(ss, 32);
                if (fq == 0) __hip_atomic_fetch_add(st + row, (u64)(ss * FIX_SCALE + 0.5f), __ATOMIC_RELAXED, __HIP_MEMORY_SCOPE_AGENT);
                asm volatile("" ::: "memory"); }
    }
};
struct EpiGU {
    static constexpr bool PERM = true, AFTER_DRAIN = false;
    bf16* act; const u64* st;
    __device__ __forceinline__ void operator()(const pg8::f32x4 (&acc)[2][2][4][2], const pg8::Unit& u, int wr, int wc, int fr, int fq) const {
        const int row0 = u.pm * 256 + wr * 64 + fr, col0 = u.pn * 128 + wc * 32 + 8 * fq;
#pragma unroll
        for (int ai = 0; ai < 2; ++ai)
#pragma unroll
            for (int m = 0; m < 4; ++m) { const int row = row0 + ai * 128 + m * 16; const float ir = inv_rms_of(st, row);
                pg8::f32x4 o[2];
#pragma unroll
                for (int n = 0; n < 2; ++n) { const pg8::f32x4 g = acc[ai][0][m][n] * ir, uu = acc[ai][1][m][n] * ir;
#pragma unroll
                    for (int j = 0; j < 4; ++j) o[n][j] = g[j] / (1.0f + __expf(-g[j])) * uu[j]; }
                pg8::u32x4 w; w.x = pg8::cvt_pk_bf16(o[0][0], o[0][1]); w.y = pg8::cvt_pk_bf16(o[0][2], o[0][3]); w.z = pg8::cvt_pk_bf16(o[1][0], o[1][1]); w.w = pg8::cvt_pk_bf16(o[1][2], o[1][3]);
                *(pg8::u32x4*)(act + (size_t)row * DFF + col0) = w; }
    }
};

struct Args { const float* in[16]; float* out; unsigned char* ws; int ph_lo, ph_hi, li, pad; };
struct Ptrs {
    const float *x, *norm1_w, *w_in, *gla_w_up, *gla_b, *gla_norm_w, *conv_w, *w_br0, *w_br1, *w_br2, *w_out, *norm2_w, *w_gate, *w_up, *w_down, *final_w;
    float* X; unsigned char* ws; u64* stats;
    bf16 *XB, *PROJ, *A3, *MIXED, *ACT; float *LA, *KMEAN, *DECAY, *KV, *SPREV, *T;
    int G, vcu;
};
#define OPAQUE_TID() int tid = threadIdx.x; asm volatile("" : "+v"(tid)); const int lane = tid & 63, wave = __builtin_amdgcn_readfirstlane(tid >> 6); (void)lane; (void)wave

__device__ __forceinline__ void xpose_store(LAS float* scr, bf16* dst, int K, int lane) {
    LDS_WAIT(); asm volatile("" ::: "memory");
    const int c = lane & 7;
#pragma unroll
    for (int j = 0; j < 4; ++j) { const int n = (lane >> 3) + 8 * j; const LAS float* s = scr + (8 * c) * 33 + n;
        v4u o; o.x = pk2(s[0 * 33], s[1 * 33]); o.y = pk2(s[2 * 33], s[3 * 33]); o.z = pk2(s[4 * 33], s[5 * 33]); o.w = pk2(s[6 * 33], s[7 * 33]);
        *(GAS v4u*)(dst + (size_t)n * K + 8 * c) = o; }
    LDS_WAIT(); asm volatile("" ::: "memory");
}
__device__ __forceinline__ void xpose_item(const float* src, size_t ld, const float* scale, bf16* dst, int K, LAS float* scr, int lane) {
#pragma unroll 8
    for (int i = 0; i < 32; ++i) { const int kk = 2 * i + (lane >> 5); float v = src[(size_t)kk * ld + (lane & 31)]; if (scale) v *= scale[kk]; scr[kk * 33 + (lane & 31)] = v; }
    xpose_store(scr, dst, K, lane);
}
constexpr int IT_IN = 496 * 32, IT_BR = 3 * 64 * 16, IT_OUT = 64 * 32, IT_GU = 352 * 32, IT_DN = 64 * 88, IT_L = IT_IN + IT_BR + IT_OUT + IT_GU + IT_DN;
__device__ __forceinline__ void p0_prologue(const Ptrs& P, LAS unsigned char* lds) {
    OPAQUE_TID();
    LAS float* scr = (LAS float*)(lds + wave * 16384);
    const int gw = P.vcu * NWAVES + wave, NGW = P.G * NWAVES;
    for (int it0 = gw; it0 < NL * IT_L; it0 += NGW) {
        const int l = it0 / IT_L; int r = it0 % IT_L;
        unsigned char* wl = P.ws + WS_W + (size_t)l * WL_BYTES;
        if (r < IT_IN) {
            const int kb = r / 496, g = r % 496, k0 = 64 * kb;
            const float* win = P.w_in + (size_t)l * D * NIN; const float* sc = P.norm1_w + l * D + k0;
            bf16* dst = (bf16*)(wl + WL_IN) + (size_t)(32 * g) * D + k0;
            if (g < 480) {
                int c0;
                if (g < 192) c0 = 32 * g;
                else if (g < 224) c0 = 6160 + 32 * (g - 192);
                else if (g < 288) { const int t = (g - 224) >> 3, sub = (g - 224) & 7; c0 = (sub < 4 ? 7184 : 8208) + 128 * t + 32 * (sub & 3); }
                else c0 = 9232 + 32 * (g - 288);
                xpose_item(win + (size_t)k0 * NIN + c0, NIN, sc, dst, D, scr, lane);
            } else {
                const int j0 = 32 * (g - 480); const float* wup = P.gla_w_up + (size_t)l * 16 * 512 + j0 + (lane & 31);
#pragma unroll 4
                for (int i = 0; i < 32; ++i) { const int kk = 2 * i + (lane >> 5); const float* wr = win + (size_t)(k0 + kk) * NIN + 6144; float a = 0.f;
#pragma unroll
                    for (int q = 0; q < 16; ++q) a += wr[q] * wup[q * 512];
                    scr[kk * 33 + (lane & 31)] = a * sc[kk]; }
                xpose_store(scr, dst, D, lane);
            }
            continue;
        }
        r -= IT_IN;
        if (r < 1024) { const int kb = r / 64, g = r % 64, k0 = 64 * kb;
            xpose_item(P.w_br0 + (size_t)l * 1024 * D + (size_t)k0 * D + 32 * g, D, nullptr, (bf16*)(wl + WL_BR) + (size_t)(0 * D + 32 * g) * 1024 + k0, 1024, scr, lane); continue; }
        r -= 1024;
        if (r < 1024) { const int kb = r / 64, g = r % 64, k0 = 64 * kb;
            xpose_item(P.w_br1 + (size_t)l * 1024 * D + (size_t)k0 * D + 32 * g, D, nullptr, (bf16*)(wl + WL_BR) + (size_t)(1 * D + 32 * g) * 1024 + k0, 1024, scr, lane); continue; }
        r -= 1024;
        if (r < 1024) { const int kb = r / 64, g = r % 64, k0 = 64 * kb;
            xpose_item(P.w_br2 + (size_t)l * 1024 * D + (size_t)k0 * D + 32 * g, D, nullptr, (bf16*)(wl + WL_BR) + (size_t)(2 * D + 32 * g) * 1024 + k0, 1024, scr, lane); continue; }
        r -= 1024;
        if (r < IT_OUT) { const int kb = r / 64, g = r % 64, k0 = 64 * kb;
            xpose_item(P.w_out + (size_t)l * D * D + (size_t)k0 * D + 32 * g, D, nullptr, (bf16*)(wl + WL_OUT) + (size_t)(32 * g) * D + k0, D, scr, lane); continue; }
        r -= IT_OUT;
        if (r < IT_GU) { const int kb = r / 352, g = r % 352, k0 = 64 * kb, t = g >> 3, sub = g & 7;
            const float* src = (sub < 4 ? P.w_gate : P.w_up) + (size_t)l * D * DFF + (size_t)k0 * DFF + 128 * t + 32 * (sub & 3);
            xpose_item(src, DFF, P.norm2_w + l * D + k0, (bf16*)(wl + WL_GU) + (size_t)(32 * g) * D + k0, D, scr, lane); continue; }
        r -= IT_GU;
        { const int kb = r / 64, g = r % 64, k0 = 64 * kb;
            xpose_item(P.w_down + (size_t)l * DFF * D + (size_t)k0 * D + 32 * g, D, nullptr, (bf16*)(wl + WL_DN) + (size_t)(32 * g) * DFF + k0, DFF, scr, lane); }
    }
    for (int m = gw; m < S; m += NGW) {
        const GAS f32x4* xr = (const GAS f32x4*)(P.x + (size_t)m * D) + lane; GAS f32x4* xo = (GAS f32x4*)(P.X + (size_t)m * D) + lane;
        GAS unsigned long long* xb = (GAS unsigned long long*)(P.XB + (size_t)m * D) + lane;
        float ss = 0.f;
#pragma unroll
        for (int j = 0; j < 8; ++j) { const f32x4 v = xr[64 * j]; xo[64 * j] = v; ss += (v.x * v.x + v.y * v.y) + (v.z * v.z + v.w * v.w);
            xb[64 * j] = (unsigned long long)pk2(v.x, v.y) | ((unsigned long long)pk2(v.z, v.w) << 32); }
        ss = wave_sum(ss);
        if (lane == 0) P.stats[m] = (u64)(ss * FIX_SCALE + 0.5f);
    }
}
__device__ __forceinline__ void final_norm(const Ptrs& P) {
    OPAQUE_TID();
    const int gw = P.vcu * NWAVES + wave, NGW = P.G * NWAVES;
    for (int m = gw; m < S; m += NGW) {
        GAS f32x4* xr = (GAS f32x4*)(P.X + (size_t)m * D) + lane; const GAS f32x4* wf = (const GAS f32x4*)P.final_w + lane;
        f32x4 v[8]; float ss = 0.f;
#pragma unroll
        for (int j = 0; j < 8; ++j) { v[j] = xr[64 * j]; ss += (v[j].x * v[j].x + v[j].y * v[j].y) + (v[j].z * v[j].z + v[j].w * v[j].w); }
        const float ir = rsqrtf(wave_sum(ss) * (1.0f / D) + RMS_EPS);
#pragma unroll
        for (int j = 0; j < 8; ++j) xr[64 * j] = v[j] * ir * wf[64 * j];
    }
}

__device__ __forceinline__ void unpack8(const v4u w, float (&f)[8]) { f[0] = bflo(w.x); f[1] = bfhi(w.x); f[2] = bflo(w.y); f[3] = bfhi(w.y); f[4] = bflo(w.z); f[5] = bfhi(w.z); f[6] = bflo(w.w); f[7] = bfhi(w.w); }
__device__ __forceinline__ void m1_kmean_conv(const Ptrs& P, int l) {
    OPAQUE_TID();
    const int gt = blockIdx.x * 512 + tid, NT = P.G * 512;
    for (int gid = gt; gid < 32 * 1024; gid += NT) { const int blk = gid >> 10, col = gid & 1023; const bf16* p = P.PROJ + (size_t)(blk * 256) * LDP + PC_KA + col; float s = 0.f;
        for (int r = 0; r < 256; ++r) s += bf2f(p[(size_t)r * LDP]);
        P.KMEAN[gid] = s * (1.0f / 256.0f); }
    const float* cw = P.conv_w + (size_t)l * 3 * 1024;
    for (int gid = gt; gid < S * 128; gid += NT) { const int t = gid >> 7, c8 = (gid & 127) * 8;
        const bf16* pr = P.PROJ + (size_t)t * LDP; const v4u z4 = {0u, 0u, 0u, 0u};
        const v4u a2 = t >= 2 ? *(const v4u*)(pr - 2 * (size_t)LDP + PC_CU + c8) : z4, a1 = t >= 1 ? *(const v4u*)(pr - (size_t)LDP + PC_CU + c8) : z4, a0 = *(const v4u*)(pr + PC_CU + c8), bg = *(const v4u*)(pr + PC_BG + c8);
        float f2[8], f1[8], f0[8], fb[8], y[8]; unpack8(a2, f2); unpack8(a1, f1); unpack8(a0, f0); unpack8(bg, fb);
#pragma unroll
        for (int j = 0; j < 8; ++j) y[j] = fb[j] * (cw[c8 + j] * f2[j] + cw[1024 + c8 + j] * f1[j] + cw[2048 + c8 + j] * f0[j]);
        v4u o; o.x = pk2(y[0], y[1]); o.y = pk2(y[2], y[3]); o.z = pk2(y[4], y[5]); o.w = pk2(y[6], y[7]);
        *(v4u*)(P.A3 + (size_t)2 * S * 1024 + (size_t)t * 1024 + c8) = o; }
}
__device__ __forceinline__ void gla_load_cumsum(const Ptrs& P, LAS float* bc, int h, int t0, int tid) {
#pragma unroll
    for (int i = 0; i < 16; ++i) { const int idx = tid + 512 * i, s = idx >> 7, d = idx & 127; bc[idx] = P.LA[(size_t)(t0 + s) * 512 + h * 128 + d]; }
    __syncthreads();
    if (tid < 128) { float a = 0.f; for (int s = 0; s < 64; ++s) { a += bc[s * 128 + tid]; bc[s * 128 + tid] = a; } }
    __syncthreads();
}
__device__ __forceinline__ void m1_gla_local(const Ptrs& P, LAS unsigned char* lds) {
    OPAQUE_TID();
    LAS float* bc = (LAS float*)lds; LAS float* kd = bc + 8192; LAS float* vf = kd + 8192;
    for (int unit = blockIdx.x; unit < 512; unit += P.G) { const int h = unit >> 7, n = unit & 127, t0 = n * 64;
        gla_load_cumsum(P, bc, h, t0, tid);
#pragma unroll
        for (int i = 0; i < 16; ++i) { const int idx = tid + 512 * i, s = idx >> 7, d = idx & 127;
            kd[idx] = bf2f(P.PROJ[(size_t)(t0 + s) * LDP + PC_KG + h * 128 + d]) * __expf(bc[63 * 128 + d] - bc[idx]); }
        if (tid < 128) P.DECAY[(h * 128 + n) * 128 + tid] = __expf(bc[63 * 128 + tid]);
#pragma unroll
        for (int i = 0; i < 32; ++i) { const int idx = tid + 512 * i, s = idx >> 8, e = idx & 255; vf[idx] = bf2f(P.PROJ[(size_t)(t0 + s) * LDP + PC_VG + h * 256 + e]); }
        __syncthreads();
        const int td = tid >> 5, te = tid & 31; float acc[8][8];
#pragma unroll
        for (int a = 0; a < 8; ++a)
#pragma unroll
            for (int b = 0; b < 8; ++b) acc[a][b] = 0.f;
        for (int s = 0; s < 64; ++s) { const f32x4 k0 = *(const LAS f32x4*)(kd + s * 128 + 8 * td), k1 = *(const LAS f32x4*)(kd + s * 128 + 8 * td + 4), v0 = *(const LAS f32x4*)(vf + s * 256 + 8 * te), v1 = *(const LAS f32x4*)(vf + s * 256 + 8 * te + 4);
            const float kk[8] = {k0.x, k0.y, k0.z, k0.w, k1.x, k1.y, k1.z, k1.w}, vv[8] = {v0.x, v0.y, v0.z, v0.w, v1.x, v1.y, v1.z, v1.w};
#pragma unroll
            for (int a = 0; a < 8; ++a)
#pragma unroll
                for (int b = 0; b < 8; ++b) acc[a][b] += kk[a] * vv[b]; }
#pragma unroll
        for (int a = 0; a < 8; ++a) { float* dst = P.KV + ((size_t)(h * 128 + n) * 128 + 8 * td + a) * 256 + 8 * te;
            *(f32x4*)dst = (f32x4){acc[a][0], acc[a][1], acc[a][2], acc[a][3]}; *(f32x4*)(dst + 4) = (f32x4){acc[a][4], acc[a][5], acc[a][6], acc[a][7]}; }
        __syncthreads();
    }
}
__device__ __forceinline__ void m2_gla_scan(const Ptrs& P) {
    OPAQUE_TID();
    for (int gid = blockIdx.x * 512 + tid; gid < 4 * 32768; gid += P.G * 512) { const int h = gid >> 15, de = gid & 32767, d = de >> 8; float st = 0.f;
#pragma unroll 8
        for (int n = 0; n < 128; ++n) { const size_t idx = ((size_t)(h * 128 + n) << 15) + de; P.SPREV[idx] = st; st = P.DECAY[(h * 128 + n) * 128 + d] * st + P.KV[idx]; } }
}
__device__ __forceinline__ void m2_attn_naive(const Ptrs& P, LAS unsigned char* lds) {
    OPAQUE_TID();
    const float scale = 0.08838834764831845f;
    LAS float* qs = (LAS float*)(lds + wave * 4608); LAS float* ps = qs + 128;
    for (int unit = blockIdx.x; unit < 128 * 8; unit += P.G) { const int c = unit >> 3, h = unit & 7; const float slope = exp2f(-(float)(h + 1));
        for (int i = 0; i < 8; ++i) { const int t = c * 64 + wave * 8 + i, own = t >> 8;
            { const unsigned qw = *(const unsigned*)(P.PROJ + (size_t)t * LDP + PC_QA + h * 128 + 2 * lane); qs[2 * lane] = bflo(qw); qs[2 * lane + 1] = bfhi(qw); }
            LDS_WAIT();
            float gate = -INFINITY;
            if (lane < own) { const float* km = P.KMEAN + lane * 1024 + h * 128; float a = 0.f; for (int d = 0; d < 128; ++d) a += qs[d] * km[d]; gate = a; }
            int sel[3];
#pragma unroll
            for (int k = 0; k < 3; ++k) { const float mg = wave_max(gate); const unsigned long long bal = __ballot(gate == mg && mg > -INFINITY); const int idx = bal ? (__ffsll((long long)bal) - 1) : -1; sel[k] = idx; if (lane == idx) gate = -INFINITY; }
            float sc[4][4]; float mx = -INFINITY;
#pragma unroll
            for (int slot = 0; slot < 4; ++slot) { const int b = slot < 3 ? sel[slot] : own;
#pragma unroll
                for (int i4 = 0; i4 < 4; ++i4) { float sv = -INFINITY;
                    if (b >= 0) { const int key = b * 256 + i4 * 64 + lane; const bf16* kp = P.PROJ + (size_t)key * LDP + PC_KA + h * 128; float a = 0.f;
#pragma unroll 4
                        for (int d8 = 0; d8 < 16; ++d8) { const v4u w = *(const v4u*)(kp + 8 * d8); float f[8]; unpack8(w, f);
#pragma unroll
                            for (int j = 0; j < 8; ++j) a += qs[8 * d8 + j] * f[j]; }
                        sv = a * scale - slope * (float)(t - key); if (key > t) sv = -INFINITY; }
                    sc[slot][i4] = sv; mx = fmaxf(mx, sv); } }
            mx = wave_max(mx); float sum = 0.f;
#pragma unroll
            for (int slot = 0; slot < 4; ++slot)
#pragma unroll
                for (int i4 = 0; i4 < 4; ++i4) { const float p = __expf(sc[slot][i4] - mx); ps[slot * 256 + i4 * 64 + lane] = p; sum += p; }
            sum = wave_sum(sum);
            LDS_WAIT();
            float o0 = 0.f, o1 = 0.f;
#pragma unroll
            for (int slot = 0; slot < 4; ++slot) { const int b = slot < 3 ? sel[slot] : own; if (b < 0) continue; const int nk = slot == 3 ? (t & 255) + 1 : 256;
                const bf16* vp = P.PROJ + (size_t)(b * 256) * LDP + PC_VA + h * 128 + 2 * lane;
#pragma unroll 4
                for (int key = 0; key < nk; ++key) { const float p = ps[slot * 256 + key]; const unsigned w = *(const unsigned*)(vp + (size_t)key * LDP); o0 += p * bflo(w); o1 += p * bfhi(w); } }
            const float inv = 1.0f / sum;
            *(unsigned*)(P.A3 + (size_t)t * 1024 + h * 128 + 2 * lane) = pk2(o0 * inv, o1 * inv);
            LDS_WAIT();
        }
    }
}
__device__ __forceinline__ void m3_gla_out(const Ptrs& P, LAS unsigned char* lds, int l) {
    OPAQUE_TID();
    LAS float* qi = (LAS float*)lds; LAS float* ki = qi + 8192; LAS float* Am = ki + 8192; LAS float* bc = Am + 8192;
    const float* gnw = P.gla_norm_w + l * 256;
    for (int unit = blockIdx.x; unit < 512; unit += P.G) { const int h = unit >> 7, n = unit & 127, t0 = n * 64;
        gla_load_cumsum(P, bc, h, t0, tid);
#pragma unroll
        for (int i = 0; i < 16; ++i) { const int idx = tid + 512 * i, s = idx >> 7, d = idx & 127; const float b = bc[idx]; const bf16* pr = P.PROJ + (size_t)(t0 + s) * LDP + h * 128 + d;
            qi[idx] = bf2f(pr[PC_QG]) * 0.08838834764831845f * __expf(b); ki[idx] = bf2f(pr[PC_KG]) * __expf(-b); }
        __syncthreads();
        { const int c = tid >> 3, s8 = (tid & 7) * 8;
#pragma unroll
            for (int j = 0; j < 8; ++j) { const int s = s8 + j; float a = 0.f; if (s <= c) for (int d = 0; d < 128; ++d) a += qi[c * 128 + d] * ki[s * 128 + d]; Am[c * 64 + s] = a; } }
        __syncthreads();
        const int tc = tid >> 5, te = tid & 31; float o[4][8];
#pragma unroll
        for (int a = 0; a < 4; ++a)
#pragma unroll
            for (int b = 0; b < 8; ++b) o[a][b] = 0.f;
        for (int s = 0; s < 64; ++s) { float v[8]; unpack8(*(const v4u*)(P.PROJ + (size_t)(t0 + s) * LDP + PC_VG + h * 256 + 8 * te), v);
#pragma unroll
            for (int a = 0; a < 4; ++a) { const float am = Am[(4 * tc + a) * 64 + s];
#pragma unroll
                for (int b = 0; b < 8; ++b) o[a][b] += am * v[b]; } }
        for (int d = 0; d < 128; ++d) { const float* sp = P.SPREV + ((size_t)(h * 128 + n) * 128 + d) * 256 + 8 * te; const f32x4 s0 = *(const f32x4*)sp, s1 = *(const f32x4*)(sp + 4);
            const float v[8] = {s0.x, s0.y, s0.z, s0.w, s1.x, s1.y, s1.z, s1.w};
#pragma unroll
            for (int a = 0; a < 4; ++a) { const float q = qi[(4 * tc + a) * 128 + d];
#pragma unroll
                for (int b = 0; b < 8; ++b) o[a][b] += q * v[b]; } }
#pragma unroll
        for (int a = 0; a < 4; ++a) { float ss = 0.f;
#pragma unroll
            for (int b = 0; b < 8; ++b) ss += o[a][b] * o[a][b];
#pragma unroll
            for (int m = 1; m < 32; m <<= 1) ss += __shfl_xor(ss, m);
            const float inv = rsqrtf(ss * (1.0f / 256.0f) + RMS_EPS); const int row = t0 + 4 * tc + a;
            float r[8], y[8]; unpack8(*(const v4u*)(P.PROJ + (size_t)row * LDP + PC_RG + h * 256 + 8 * te), r);
#pragma unroll
            for (int b = 0; b < 8; ++b) y[b] = o[a][b] * inv * gnw[8 * te + b] * (r[b] / (1.0f + __expf(-r[b])));
            v4u w; w.x = pk2(y[0], y[1]); w.y = pk2(y[2], y[3]); w.z = pk2(y[4], y[5]); w.w = pk2(y[6], y[7]);
            *(v4u*)(P.A3 + (size_t)S * 1024 + (size_t)row * 1024 + h * 256 + 8 * te) = w; }
        __syncthreads();
    }
}

__global__ void __launch_bounds__(NWAVES * 64, 2) mk_fwd(Args args) {
    extern __shared__ __attribute__((aligned(16))) unsigned char lds_raw[];
    LAS unsigned char* lds = (LAS unsigned char*)lds_raw;
    Ptrs P;
    P.G = gridDim.x; { const int bx = blockIdx.x; P.vcu = (P.G % 8 == 0) ? (bx % 8) * (P.G / 8) + bx / 8 : bx; }
    P.x = args.in[0]; P.norm1_w = args.in[1]; P.w_in = args.in[2]; P.gla_w_up = args.in[3]; P.gla_b = args.in[4]; P.gla_norm_w = args.in[5]; P.conv_w = args.in[6];
    P.w_br0 = args.in[7]; P.w_br1 = args.in[8]; P.w_br2 = args.in[9]; P.w_out = args.in[10]; P.norm2_w = args.in[11]; P.w_gate = args.in[12]; P.w_up = args.in[13]; P.w_down = args.in[14]; P.final_w = args.in[15];
    P.X = args.out; P.ws = args.ws; unsigned char* ws = args.ws;
    P.stats = (u64*)(ws + WS_CTL + CTL_STATS);
    P.XB = (bf16*)(ws + WS_XB); P.PROJ = (bf16*)(ws + WS_PROJ); P.LA = (float*)(ws + WS_LA); P.A3 = (bf16*)(ws + WS_A3); P.KMEAN = (float*)(ws + WS_KMEAN); P.DECAY = (float*)(ws + WS_DECAY);
    P.KV = (float*)(ws + WS_KV); P.SPREV = (float*)(ws + WS_SPREV); P.T = (float*)(ws + WS_T); P.MIXED = (bf16*)(ws + WS_MIXED); P.ACT = (bf16*)(ws + WS_ACT);
    for (int u = threadIdx.x; u < (LDS_BYTES - LDSCTL_OFF) / 4; u += NWAVES * 64) ((LAS unsigned*)(lds + LDSCTL_OFF))[u] = 0u;
    __syncthreads();
    const int lo = args.ph_lo, hi = args.ph_hi;
    unsigned* barw = (unsigned*)(ws + WS_CTL) + CW_BAR + args.li * XCD_BAR_WORDS;
    XcdBarrier bar; bar.bar = barw; bar.x = 0; bar.st = nullptr;
    if (hi - lo > 1) bar = xcd_barrier_post(barw, (volatile LAS unsigned*)(lds + MISC_OFF) + 8);
#define IN(k) (lo <= (k) && (k) < hi)
#define SEAM(k) do { if ((k) + 1 < hi) xcd_barrier(bar); } while (0)
    if (IN(0)) { p0_prologue(P, lds); SEAM(0); }
    for (int l = 0; l < NL; ++l) {
        const int pb = 1 + 8 * l; unsigned char* wl = ws + WS_W + (size_t)l * WL_BYTES;
        if (IN(pb + 0)) {
            pg8::Gemm g{P.XB, (const bf16*)(wl + WL_IN), S, NPROJ, D}; pg8::StaticOrder So; So.init(S, NPROJ, P.G, (int)blockIdx.x);
            EpiProj E{P.PROJ, P.LA, P.stats + (size_t)(2 * l) * S, P.gla_b + l * 512};
            pg8::gemm_phase<EpiProj, pg8::StaticOrder, true, true>(lds, g, So, E);
            SEAM(pb + 0); }
        if (IN(pb + 1)) { m1_kmean_conv(P, l); m1_gla_local(P, lds); SEAM(pb + 1); }
        if (IN(pb + 2)) { m2_gla_scan(P); m2_attn_naive(P, lds); SEAM(pb + 2); }
        if (IN(pb + 3)) { m3_gla_out(P, lds, l); SEAM(pb + 3); }
        if (IN(pb + 4)) {
            pg8::Gemm g{P.A3, (const bf16*)(wl + WL_BR), 3 * S, 3 * D, 1024}; BranchOrder Bo; Bo.so.init(S, D, P.G, (int)blockIdx.x);
            EpiBranch E{P.PROJ, P.T, P.MIXED};
            pg8::gemm_phase<EpiBranch, BranchOrder, true, true>(lds, g, Bo, E);
            SEAM(pb + 4); }
        if (IN(pb + 5)) {
            pg8::Gemm g{P.MIXED, (const bf16*)(wl + WL_OUT), S, D, D}; pg8::StaticOrder So; So.init(S, D, P.G, (int)blockIdx.x);
            EpiResid E{P.X, P.XB, P.stats + (size_t)(2 * l + 1) * S};
            pg8::gemm_phase<EpiResid, pg8::StaticOrder, true, true>(lds, g, So, E);
            SEAM(pb + 5); }
        if (IN(pb + 6)) {
            pg8::Gemm g{P.XB, (const bf16*)(wl + WL_GU), S, 2 * DFF, D}; pg8::StaticOrder So; So.init(S, 2 * DFF, P.G, (int)blockIdx.x);
            EpiGU E{P.ACT, P.stats + (size_t)(2 * l + 1) * S};
            pg8::gemm_phase<EpiGU, pg8::StaticOrder, true, true>(lds, g, So, E);
            SEAM(pb + 6); }
        if (IN(pb + 7)) {
            pg8::Gemm g{P.ACT, (const bf16*)(wl + WL_DN), S, D, DFF}; pg8::StaticOrder So; So.init(S, D, P.G, (int)blockIdx.x);
            EpiResid E{P.X, P.XB, P.stats + (size_t)(2 * l + 2) * S};
            pg8::gemm_phase<EpiResid, pg8::StaticOrder, true, true>(lds, g, So, E);
            SEAM(pb + 7); }
    }
    if (IN(NPH - 1)) final_norm(P);
#undef IN
#undef SEAM
}

#ifndef MK_SPLIT
#define MK_SPLIT 0
#endif
extern "C" void kernel_launch(void* const* d_in, const int* in_sizes, int n_in, void* d_out, int out_size, void* d_ws, size_t ws_size, hipStream_t stream) {
    static int grid = 0;
    if (grid == 0) {
        if (n_in != 16 || out_size != S * D || ws_size < WS_END) { fprintf(stderr, "kernel_launch: unexpected shapes (n_in %d out %d ws %zu)\n", n_in, out_size, ws_size); grid = -1; return; }
        int dev = 0, cus = 0, per_cu = 0;
        if (hipGetDevice(&dev) != hipSuccess || hipDeviceGetAttribute(&cus, hipDeviceAttributeMultiprocessorCount, dev) != hipSuccess) { grid = -1; return; }
        if (hipFuncSetAttribute((const void*)mk_fwd, hipFuncAttributeMaxDynamicSharedMemorySize, LDS_BYTES) != hipSuccess) { fprintf(stderr, "kernel_launch: hipFuncSetAttribute failed\n"); grid = -1; return; }
        if (hipOccupancyMaxActiveBlocksPerMultiprocessor(&per_cu, (const void*)mk_fwd, NWAVES * 64, LDS_BYTES) != hipSuccess || per_cu < 1) fprintf(stderr, "kernel_launch: occupancy query says %d\n", per_cu);
        (void)hipGetLastError();
        grid = cus;
    }
    if (grid < 0) return;
    if (hipMemsetAsync((char*)d_ws + WS_CTL, 0, CTL_ZERO_BYTES, stream) != hipSuccess) return;
    Args a{};
    for (int i = 0; i < 16; ++i) a.in[i] = (const float*)d_in[i];
    a.out = (float*)d_out; a.ws = (unsigned char*)d_ws; a.pad = 0;
#if MK_SPLIT
    for (int p = 0; p < NPH; ++p) { a.ph_lo = p; a.ph_hi = p + 1; a.li = 0; hipLaunchKernelGGL(mk_fwd, dim3(grid), dim3(NWAVES * 64), LDS_BYTES, stream, a); }
#else
    a.ph_lo = 0; a.ph_hi = NPH; a.li = 0;
    hipLaunchKernelGGL(mk_fwd, dim3(grid), dim3(NWAVES * 64), LDS_BYTES, stream, a);
#endif
}
```

```cpp
#include <hip/hip_runtime.h>
#include <cstdio>
#include <cstdint>
#include <cmath>
namespace pg8 {
#define PG8_LAS __attribute__((address_space(3)))
typedef unsigned short bf16_t;
typedef short bf16x8 __attribute__((ext_vector_type(8)));
typedef float f32x4 __attribute__((ext_vector_type(4)));
typedef unsigned u32x4 __attribute__((ext_vector_type(4)));
constexpr int BM = 256, BK = 64, HALF = 128, HTB = HALF * BK * 2  , STAGE_BYTES = 8 * HTB, NXCD = 8, WGM = 8;

__host__ __device__ __forceinline__ int lds_byte(int r, int c) { const int st = (r >> 4) * 2 + (c >> 5), rr = r & 15, cc = c & 31, ob = rr * 64 + cc * 2; return st * 1024 + (ob ^ (((ob >> 9) & 1) << 5)); }
__host__ __device__ __forceinline__ void stage_rc(int b, int& R, int& C) { const int st = b / 1024, sb = b % 1024, swz = sb ^ (((sb >> 9) & 1) << 5); R = (st >> 1) * 16 + swz / 64; C = (st & 1) * 32 + (swz % 64) / 2; }
__host__ __device__ __forceinline__ int perm32(int rho) { const int n = rho >> 4, i = rho & 15; return 8 * (i >> 2) + 4 * n + (i & 3); }

struct Unit { int pm, pn; };
struct Gemm { const bf16_t* A; const bf16_t* Bt; int M, N, K; };

struct StaticOrder {
    int nM, nN, nwg, G, c;
    __host__ __device__ void init(int M, int N, int G_, int c_) { nM = M / BM; nN = N / BM; nwg = nM * nN; G = G_; c = c_; }
    __host__ __device__ bool next(int i, Unit& u) const {
        const long L = (long)i * G + c; if (L >= nwg) return false;
        int wgid = (int)L; { const int q = nwg / NXCD, r = nwg % NXCD, xcd = wgid % NXCD, off = wgid / NXCD; wgid = (xcd < r ? xcd * (q + 1) : r * (q + 1) + (xcd - r) * q) + off; }
        const int nig = WGM * nN, gid = wgid / nig, fm = gid * WGM, gsz = (nM - fm) < WGM ? (nM - fm) : WGM;
        u.pm = fm + ((wgid % nig) % gsz); u.pn = (wgid % nig) / gsz; return true;
    }
    __device__ __forceinline__ void a_ready(const Unit&) const {}
    __device__ __forceinline__ void done(const Unit&) const {}
};

__device__ __forceinline__ unsigned cvt_pk_bf16(float lo, float hi) { unsigned r; asm volatile("v_cvt_pk_bf16_f32 %0, %1, %2" : "=v"(r) : "v"(lo), "v"(hi)); return r; }
template <class Epi, class Sched, bool ALIGN_EPI = false, bool SP2 = false>
__device__ __forceinline__ void gemm_phase(PG8_LAS unsigned char* lds, const Gemm g, const Sched& S, const Epi& E, int wave_sgpr) {
    int tid_; asm volatile("v_mbcnt_lo_u32_b32 %0, -1, 0\n\tv_mbcnt_hi_u32_b32 %0, -1, %0" : "=v"(tid_)); tid_ += wave_sgpr * 64;
    const int tid = tid_, wid = __builtin_amdgcn_readfirstlane(tid >> 6), lane = tid & 63, wr = wid >> 2, wc = wid & 3, fr = lane & 15, fq = lane >> 4;
    const int K = g.K, nt = K / BK;
    unsigned voffA[2], voffB[2];
#pragma unroll
    for (int i = 0; i < 2; ++i) { int R, C; stage_rc(tid * 16 + i * 8192, R, C); const int Rb = Epi::PERM ? ((R & ~31) + perm32(R & 31)) : R;
        voffA[i] = (unsigned)(R * K + C) * 2u; voffB[i] = (unsigned)(Rb * K + C) * 2u; }
    const size_t kstep = (size_t)(BK * 2);
    const size_t hstep = (size_t)HALF * K * 2;
    const size_t tstep = 2 * hstep;
    const unsigned ldsw = (unsigned)wid * 1024u;
    const int aoff = lds_byte(wr * 64 + fr, fq * 8), boff = lds_byte(wc * 32 + fr, fq * 8);
#define PG8_SA(b, h) (((b) * 2 + (h)) * HTB)
#define PG8_SB(b, h) ((4 + (b) * 2 + (h)) * HTB)
#define PG8_STAGE(bufoff, gbase, voff) do { _Pragma("unroll") for (int _i = 0; _i < 2; ++_i) \
        __builtin_amdgcn_global_load_lds((const unsigned*)((const char*)(gbase) + (voff)[_i]), (PG8_LAS unsigned*)(lds + (bufoff) + ldsw + _i * 8192), 16, 0, 0); } while (0)
#define PG8_LDA(dst, b, h) do { _Pragma("unroll") for (int m = 0; m < 4; ++m) _Pragma("unroll") for (int k = 0; k < 2; ++k) dst[m][k] = *(const PG8_LAS bf16x8*)(lds + PG8_SA(b, h) + aoff + m * 2048 + k * 1024); } while (0)
#define PG8_LDB(dst, b, h) do { _Pragma("unroll") for (int n = 0; n < 2; ++n) _Pragma("unroll") for (int k = 0; k < 2; ++k) dst[n][k] = *(const PG8_LAS bf16x8*)(lds + PG8_SB(b, h) + boff + n * 2048 + k * 1024); } while (0)
#define PG8_MMA(ai, bj, At, Bt) do { __builtin_amdgcn_s_setprio(1); _Pragma("unroll") for (int m = 0; m < 4; ++m) _Pragma("unroll") for (int n = 0; n < 2; ++n) _Pragma("unroll") for (int k = 0; k < 2; ++k) \
        acc[ai][bj][m][n] = __builtin_amdgcn_mfma_f32_16x16x32_bf16(Bt[n][k], At[m][k], acc[ai][bj][m][n], 0, 0, 0); __builtin_amdgcn_s_setprio(0); } while (0)
#define PG8_WAIT_V(n) asm volatile("s_waitcnt vmcnt(" #n ")" ::: "memory")
#define PG8_WAIT_L(n) asm volatile("s_waitcnt lgkmcnt(" #n ")" ::: "memory")
#define PG8_BAR __builtin_amdgcn_s_barrier()
#define PG8_SCHED __builtin_amdgcn_sched_barrier(0)
    Unit cur, nxt; int ui = 0;
    if (!S.next(0, cur)) return;
    f32x4 acc[2][2][4][2];
#pragma unroll
    for (int a = 0; a < 2; ++a)
#pragma unroll
        for (int b = 0; b < 2; ++b)
#pragma unroll
            for (int m = 0; m < 4; ++m)
#pragma unroll
                for (int n = 0; n < 2; ++n) acc[a][b][m][n] = (f32x4){0.f, 0.f, 0.f, 0.f};
    bf16x8 At[4][2], B0[2][2], B1[2][2];
    const char* cA = (const char*)g.A + (size_t)cur.pm * tstep; const char* cB = (const char*)g.Bt + (size_t)cur.pn * tstep;
    S.a_ready(cur);
    if constexpr (SP2) {
        PG8_STAGE(PG8_SB(0, 0), cB, voffB); PG8_STAGE(PG8_SB(0, 1), cB + hstep, voffB); PG8_STAGE(PG8_SA(0, 0), cA, voffA); PG8_STAGE(PG8_SA(0, 1), cA + hstep, voffA);
        if (wr == 1) PG8_BAR;
        PG8_WAIT_V(2); PG8_BAR;
        PG8_STAGE(PG8_SB(1, 0), cB + kstep, voffB); PG8_STAGE(PG8_SA(1, 0), cA + kstep, voffA); PG8_STAGE(PG8_SB(1, 1), cB + hstep + kstep, voffB);
        PG8_WAIT_V(6); PG8_BAR;
    } else {
        PG8_STAGE(PG8_SB(0, 0), cB, voffB); PG8_STAGE(PG8_SA(0, 0), cA, voffA); PG8_STAGE(PG8_SB(0, 1), cB + hstep, voffB); PG8_STAGE(PG8_SA(0, 1), cA + hstep, voffA);
        if (wr == 1) PG8_BAR;
        PG8_WAIT_V(4); PG8_BAR;
        PG8_STAGE(PG8_SB(1, 0), cB + kstep, voffB); PG8_STAGE(PG8_SA(1, 0), cA + kstep, voffA); PG8_STAGE(PG8_SB(1, 1), cB + hstep + kstep, voffB);
        PG8_WAIT_V(6); PG8_BAR;
    }
    for (;;) {
        const bool has_next = S.next(ui + 1, nxt);
        const char* nA = has_next ? (const char*)g.A + (size_t)nxt.pm * tstep : cA; const char* nB = has_next ? (const char*)g.Bt + (size_t)nxt.pn * tstep : cB;
        for (int t = 0; t < nt; t += 2) {
            const bool last = (t == nt - 2);
            const char* a1 = cA + (size_t)(t + 1) * kstep;
            const char* a2 = last ? nA : cA + (size_t)(t + 2) * kstep; const char* b2 = last ? nB : cB + (size_t)(t + 2) * kstep;
            const char* a3 = a2 + kstep; const char* b3 = b2 + kstep;
            if (last && has_next) S.a_ready(nxt);
            if constexpr (SP2) {
            PG8_LDB(B0, 0, 0); PG8_LDB(B1, 0, 1); PG8_SCHED; PG8_LDA(At, 0, 0); PG8_STAGE(PG8_SA(1, 1), a1 + hstep, voffA);
            PG8_WAIT_V(8); PG8_WAIT_L(0); PG8_BAR; PG8_MMA(0, 0, At, B0); PG8_MMA(0, 1, At, B1); PG8_BAR; PG8_SCHED;
            PG8_LDA(At, 0, 1); PG8_STAGE(PG8_SB(0, 0), b2, voffB); PG8_STAGE(PG8_SB(0, 1), b2 + hstep, voffB); PG8_STAGE(PG8_SA(0, 0), a2, voffA);
            PG8_WAIT_V(8); PG8_WAIT_L(0); PG8_BAR; PG8_MMA(1, 0, At, B0); PG8_MMA(1, 1, At, B1); PG8_BAR; PG8_SCHED;
            PG8_LDB(B0, 1, 0); PG8_LDB(B1, 1, 1); PG8_SCHED; PG8_LDA(At, 1, 0); PG8_STAGE(PG8_SA(0, 1), a2 + hstep, voffA);
            PG8_WAIT_V(8); PG8_WAIT_L(0); PG8_BAR; PG8_MMA(0, 0, At, B0); PG8_MMA(0, 1, At, B1); PG8_BAR; PG8_SCHED;
            PG8_LDA(At, 1, 1); PG8_STAGE(PG8_SB(1, 0), b3, voffB); PG8_STAGE(PG8_SB(1, 1), b3 + hstep, voffB); PG8_STAGE(PG8_SA(1, 0), a3, voffA);
            PG8_WAIT_V(8); PG8_WAIT_L(0); PG8_BAR; PG8_MMA(1, 0, At, B0); PG8_MMA(1, 1, At, B1); PG8_BAR; PG8_SCHED;
            } else {
            PG8_LDB(B0, 0, 0); PG8_SCHED; PG8_LDA(At, 0, 0); PG8_STAGE(PG8_SA(1, 1), a1 + hstep, voffA);
            PG8_WAIT_L(8); PG8_BAR; PG8_WAIT_L(0); PG8_MMA(0, 0, At, B0); PG8_BAR; PG8_SCHED;
            PG8_LDB(B1, 0, 1); PG8_STAGE(PG8_SB(0, 0), b2, voffB);
            PG8_BAR; PG8_WAIT_L(0); PG8_MMA(0, 1, At, B1); PG8_BAR;
            PG8_LDA(At, 0, 1); PG8_STAGE(PG8_SA(0, 0), a2, voffA);
            PG8_BAR; PG8_WAIT_L(0); PG8_MMA(1, 0, At, B0); PG8_BAR; PG8_SCHED;
            PG8_STAGE(PG8_SB(0, 1), b2 + hstep, voffB);
            PG8_WAIT_V(6); PG8_BAR; PG8_MMA(1, 1, At, B1); PG8_BAR;
            PG8_LDB(B0, 1, 0); PG8_SCHED; PG8_LDA(At, 1, 0); PG8_STAGE(PG8_SA(0, 1), a2 + hstep, voffA);
            PG8_WAIT_L(8); PG8_BAR; PG8_WAIT_L(0); PG8_MMA(0, 0, At, B0); PG8_BAR; PG8_SCHED;
            PG8_LDB(B1, 1, 1); PG8_STAGE(PG8_SB(1, 0), b3, voffB);
            PG8_BAR; PG8_WAIT_L(0); PG8_MMA(0, 1, At, B1); PG8_BAR;
            PG8_LDA(At, 1, 1); PG8_STAGE(PG8_SA(1, 0), a3, voffA);
            PG8_BAR; PG8_WAIT_L(0); PG8_MMA(1, 0, At, B0); PG8_BAR; PG8_SCHED;
            PG8_STAGE(PG8_SB(1, 1), b3 + hstep, voffB);
            PG8_WAIT_V(6); PG8_BAR; PG8_MMA(1, 1, At, B1); PG8_BAR;
            }
        }
        if constexpr (ALIGN_EPI) { if (wr == 0) PG8_BAR; }
        if constexpr (!Epi::AFTER_DRAIN) { E(acc, cur, wr, wc, fr, fq); S.done(cur); }
        if (!has_next) break;
        bool carry = false; if constexpr (Epi::CARRY) carry = E.carry(cur);
        if (!carry) {
#pragma unroll
        for (int a = 0; a < 2; ++a)
#pragma unroll
            for (int b = 0; b < 2; ++b)
#pragma unroll
                for (int m = 0; m < 4; ++m)
#pragma unroll
                    for (int n = 0; n < 2; ++n) acc[a][b][m][n] = (f32x4){0.f, 0.f, 0.f, 0.f};
        }
        cur = nxt; cA = nA; cB = nB; ++ui;
        if constexpr (ALIGN_EPI) { if (wr == 1) PG8_BAR; }
    }
    PG8_WAIT_V(0);
    if constexpr (!ALIGN_EPI) { if (wr == 0) PG8_BAR; }
    PG8_BAR;
    if constexpr (Epi::AFTER_DRAIN) { E.fused(acc, cur, wr, wc, fr, fq, lds, wid, lane); S.done(cur); }
#undef PG8_SA
#undef PG8_SB
#undef PG8_STAGE
#undef PG8_LDA
#undef PG8_LDB
#undef PG8_MMA
#undef PG8_WAIT_V
#undef PG8_WAIT_L
#undef PG8_BAR
#undef PG8_SCHED
}
}
#define GAS __attribute__((address_space(1)))
#define LAS __attribute__((address_space(3)))
typedef unsigned short bf16;
typedef unsigned v4u __attribute__((ext_vector_type(4)));
typedef float f32x4 __attribute__((ext_vector_type(4)));
typedef short bf16x8 __attribute__((ext_vector_type(8)));
typedef GAS unsigned gu32;
typedef GAS unsigned long long gu64;
#define RLX_AGENT __ATOMIC_RELAXED, __HIP_MEMORY_SCOPE_AGENT
#define LDS_WAIT() asm volatile("s_waitcnt lgkmcnt(0)" ::: "memory")
#define VM_WAIT() asm volatile("s_waitcnt vmcnt(0)" ::: "memory")
__device__ __forceinline__ unsigned long long rt() { return __builtin_amdgcn_s_memrealtime(); }
__device__ __forceinline__ unsigned f2bf(float f) { unsigned u = __builtin_bit_cast(unsigned, f); return (u + 0x7fffu + ((u >> 16) & 1u)) >> 16; }
__device__ __forceinline__ unsigned pk2(float lo, float hi) { return f2bf(lo) | (f2bf(hi) << 16); }
#define XB_TMO      128
#define XB_XCNT(j)  (256  + 64 * (j))
#define XB_XSUB(j)  (1280 + 64 * (j))
#define XB_XGEN(j)  (2304 + 64 * (j))
#define XB_TOP      3328
#define XB_TOPGEN   3392
#define XCD_BAR_WORDS 3456
#define XB_SPIN_CAP (1u << 18)

__device__ __forceinline__ unsigned xb_ld(unsigned* p)              { return __hip_atomic_load(p, __ATOMIC_RELAXED, __HIP_MEMORY_SCOPE_AGENT); }
__device__ __forceinline__ unsigned xb_add(unsigned* p, unsigned v) { return __hip_atomic_fetch_add(p, v, __ATOMIC_RELAXED, __HIP_MEMORY_SCOPE_AGENT); }
__device__ __forceinline__ unsigned xb_xcc_id() { return (unsigned)__builtin_amdgcn_s_getreg((3 << 11) | 20) & 0xFu; }
#define XB_SPIN(cond, bar) do { unsigned _sp = 0; while (cond) { __builtin_amdgcn_s_sleep(1); \
    if ((++_sp & 255u) == 0u) { if (xb_ld(&(bar)[XB_TMO])) break; if (_sp > XB_SPIN_CAP) { atomicAdd(&(bar)[XB_TMO], 1u); break; } } } } while (0)

struct XcdBarrier {
    unsigned* bar; unsigned x;
    volatile LAS unsigned* st;
};

__device__ __forceinline__ XcdBarrier xcd_barrier_post(unsigned* bar, volatile LAS unsigned* st) {
    XcdBarrier b; b.bar = bar; b.x = xb_xcc_id(); b.st = st;
    if (threadIdx.x == 0) (void)xb_add(&bar[XB_XCNT(b.x)], 1u);
    return b;
}
__device__ __forceinline__ void xcd_barrier_complete(unsigned* bar, unsigned x, unsigned& nloc, unsigned& nx) {
    const unsigned G = gridDim.x * gridDim.y * gridDim.z;
    unsigned sum, cnt, mine, sp = 0u;
    for (;;) {
        sum = 0u; cnt = 0u; mine = 0u;
#pragma unroll
        for (unsigned j = 0; j < 16; ++j) { const unsigned c = xb_ld(&bar[XB_XCNT(j)]); sum += c; cnt += (c > 0u) ? 1u : 0u; mine = (j == x) ? c : mine; }
        if (sum == G) break;
        __builtin_amdgcn_s_sleep(1);
        if ((++sp & 255u) == 0u) { if (xb_ld(&bar[XB_TMO])) break; if (sp > XB_SPIN_CAP) { atomicAdd(&bar[XB_TMO], 1u); break; } }
    }
    nloc = mine > 0u ? mine : 1u; nx = cnt > 0u ? cnt : 1u;
}

__device__ __forceinline__ void xcd_barrier(const XcdBarrier& b, const bool is_thread0  ) {
    asm volatile("s_waitcnt vmcnt(0)" ::: "memory");
    __syncthreads();
    if (is_thread0) {
        unsigned* bar = b.bar;
        __builtin_amdgcn_s_waitcnt(0);
        unsigned nloc = b.st[0], nx = b.st[1];
        if (nloc == 0u) { xcd_barrier_complete(bar, b.x, nloc, nx); b.st[0] = nloc; b.st[1] = nx; }
        const unsigned old = xb_add(&bar[XB_XSUB(b.x)], 1u);
        const unsigned gen = old / nloc;
        if (old + 1u == (gen + 1u) * nloc) {
            __builtin_amdgcn_fence(__ATOMIC_RELEASE, "agent");
            asm volatile("s_waitcnt vmcnt(0)" ::: "memory");
            const unsigned og = xb_add(&bar[XB_TOP], 1u);
            const unsigned tg = og / nx;
            if (og + 1u == (tg + 1u) * nx) xb_add(&bar[XB_TOPGEN], 1u);
            else XB_SPIN(xb_ld(&bar[XB_TOPGEN]) == tg, bar);
            __builtin_amdgcn_fence(__ATOMIC_ACQUIRE, "agent");
            xb_add(&bar[XB_XGEN(b.x)], 1u);
            asm volatile("s_waitcnt vmcnt(0)" ::: "memory");
        } else {
            XB_SPIN(xb_ld(&bar[XB_XGEN(b.x)]) == gen, bar);
            __builtin_amdgcn_fence(__ATOMIC_ACQUIRE, "agent");
            asm volatile("s_waitcnt vmcnt(0)" ::: "memory");
        }
    }
    __syncthreads();
}
constexpr int S = 8192, D = 2048, NL = 4, DFF = 5632, NIN = 15376, NPROJ = 15872, LDP = 14336, NWAVES = 8;
constexpr int PC_QA = 0, PC_KA = 1024, PC_VA = 2048, PC_QG = 3072, PC_KG = 3584, PC_VG = 4096, PC_RG = 5120, PC_BG = 6144, PC_CU = 7168, PC_G = 8192;
constexpr float RMS_EPS = 1e-6f;
constexpr float FIX_SCALE = 1048576.0f;
constexpr int NPH = 34;
typedef unsigned long long u64;
#define WT_STORES 0
template <class V> __device__ __forceinline__ void st16_wt(GAS void* p, const V v) {
#if WT_STORES
    asm volatile("global_store_dwordx4 %0, %1, off sc1\n\ts_nop 1" :: "v"(p), "v"(v));
#else
    *(GAS V*)p = v;
#endif
}
#define ST16(p, v) st16_wt((GAS void*)(p), (v))
template <class V> __device__ __forceinline__ void st16_plain(GAS void* p, const V v) { *(GAS V*)p = v; }
#define ST16P(p, v) st16_plain((GAS void*)(p), (v))

constexpr size_t MiB = 1u << 20;
constexpr size_t WS_CTL = 0, CTL_ZERO_BYTES = 2 * MiB;
constexpr int CW_BAR = 4096;
constexpr size_t CTL_QKMAX = 32768;
constexpr size_t CTL_BCNT = 1572864;
constexpr size_t CTL_SELCNT = 36864;
constexpr size_t CTL_PLAN = 34816;
constexpr size_t CTL_STATS = 65536;
constexpr size_t CTL_KSUM = 1 * MiB;
static_assert(CTL_KSUM + (size_t)4 * 32 * 1024 * 4 <= CTL_ZERO_BYTES, "ctl map");
static_assert(CTL_BCNT >= CTL_KSUM + (size_t)4 * 32 * 1024 * 4 && CTL_BCNT + (size_t)NL * 3 * 32 * 32 * 4 <= CTL_ZERO_BYTES, "ctl map");
static_assert(CTL_STATS + (size_t)9 * S * 8 <= CTL_KSUM && (CW_BAR + XCD_BAR_WORDS) * 4 <= (int)CTL_STATS, "ctl map");
constexpr size_t W_IN_B = (size_t)NPROJ * D * 2, W_BR_B = (size_t)3 * D * 1024 * 2, W_OUT_B = (size_t)D * D * 2, W_GU_B = (size_t)2 * DFF * D * 2, W_DN_B = (size_t)D * DFF * 2;
constexpr size_t WL_IN = 0, WL_BR = WL_IN + W_IN_B, WL_OUT = WL_BR + W_BR_B, WL_GU = WL_OUT + W_OUT_B, WL_DN = WL_GU + W_GU_B, WL_BYTES = WL_DN + W_DN_B;
constexpr size_t WS_W = 2 * MiB;
constexpr size_t WS_XB = WS_W + NL * WL_BYTES;
constexpr size_t WS_PROJ = WS_XB + (size_t)S * D * 2;
constexpr size_t WS_LA = WS_PROJ + (size_t)S * LDP * 2;
constexpr size_t WS_A3 = WS_LA + (size_t)S * 512 * 4;
constexpr size_t WS_PML = WS_A3 + (size_t)3 * S * 1024 * 2;
constexpr size_t WS_DECAY = WS_PML + (size_t)(512 + 96) * 256 * 2 * 4;
constexpr size_t WS_KV = WS_DECAY + (size_t)4 * 128 * 128 * 4;
constexpr size_t WS_SPREV = WS_KV + (size_t)4 * 128 * 128 * 256 * 4;
constexpr size_t WS_T = WS_SPREV + (size_t)4 * 128 * 128 * 256 * 4;
constexpr int ATT_NSLOT = 512 + 96;
constexpr size_t WS_MIXED = WS_T + (size_t)ATT_NSLOT * 256 * 128 * 4;
constexpr size_t WS_ACT = WS_MIXED + (size_t)S * D * 2;
constexpr size_t WS_QKVH = WS_ACT + (size_t)S * DFF * 2;
constexpr size_t WS_SEL = WS_QKVH + (size_t)3 * 8 * S * 128 * 2;
constexpr size_t WS_RP = WS_SEL + (size_t)3 * S * 4;
constexpr size_t WS_RPML = WS_RP + (size_t)3 * S * 3 * 128 * 4;
constexpr size_t WS_END = WS_RPML + (size_t)3 * S * 3 * 2 * 4;
static_assert(WS_END < (size_t)1900 * MiB, "workspace");
static_assert(WL_BYTES % 256 == 0 && WS_XB % 256 == 0 && WS_PROJ % 256 == 0 && WS_LA % 256 == 0 && WS_A3 % 256 == 0 && WS_KV % 256 == 0 && WS_T % 256 == 0 && WS_ACT % 256 == 0, "alignment");

constexpr int RING_BYTES = 131072, LDSCTL_OFF = RING_BYTES, MISC_OFF = LDSCTL_OFF + 320, LDS_BYTES = 147456;

__device__ __forceinline__ float bflo(unsigned w) { return __uint_as_float(w << 16); }
__device__ __forceinline__ float bfhi(unsigned w) { return __uint_as_float(w & 0xffff0000u); }
__device__ __forceinline__ float bf2f(bf16 b) { return __uint_as_float(((unsigned)b) << 16); }
template <int M> __device__ __forceinline__ float xshfl(float v) {
    return __int_as_float(__builtin_amdgcn_ds_swizzle(__float_as_int(v), (M << 10) | 0x1f)); }
template <int M> __device__ __forceinline__ int xshfl_i(int v) { return __builtin_amdgcn_ds_swizzle(v, (M << 10) | 0x1f); }
__device__ __forceinline__ float swap32_sum(float v) { auto rr = __builtin_amdgcn_permlane32_swap(__float_as_uint(v), __float_as_uint(v), false, false); return __uint_as_float(rr[0]) + __uint_as_float(rr[1]); }
__device__ __forceinline__ float swap32_max(float v) { auto rr = __builtin_amdgcn_permlane32_swap(__float_as_uint(v), __float_as_uint(v), false, false); return fmaxf(__uint_as_float(rr[0]), __uint_as_float(rr[1])); }
__device__ __forceinline__ float wave_sum(float v) { v += xshfl<1>(v); v += xshfl<2>(v); v += xshfl<4>(v); v += xshfl<8>(v); v += xshfl<16>(v); return swap32_sum(v); }
__device__ __forceinline__ float wave_max(float v) { v = fmaxf(v, xshfl<1>(v)); v = fmaxf(v, xshfl<2>(v)); v = fmaxf(v, xshfl<4>(v)); v = fmaxf(v, xshfl<8>(v)); v = fmaxf(v, xshfl<16>(v)); return swap32_max(v); }
__device__ __forceinline__ float inv_rms_of(const u64* st, int row) { return rsqrtf((float)st[row] * (1.0f / (FIX_SCALE * (float)D)) + RMS_EPS); }

__device__ __forceinline__ void unpack8(const v4u w, float (&f)[8]) { f[0] = bflo(w.x); f[1] = bfhi(w.x); f[2] = bflo(w.y); f[3] = bfhi(w.y); f[4] = bflo(w.z); f[5] = bfhi(w.z); f[6] = bflo(w.w); f[7] = bfhi(w.w); }
struct EpiProj {
    static constexpr bool PERM = true, AFTER_DRAIN = false, CARRY = false;
    bf16* proj; bf16* qkvh; float* la; const u64* st; const float* glab; float* ksum; unsigned* qkmax;
    __device__ __forceinline__ void operator()(const pg8::f32x4 (&acc)[2][2][4][2], const pg8::Unit& u, int wr, int wc, int fr, int fq) const {
        const int row0 = u.pm * 256 + wr * 64 + fr, pn = u.pn, cw = wc * 32 + 8 * fq;
        const bool ksumt = pn >= 4 && pn < 8; pg8::f32x4 cs[2][2]; float nmx[2] = {0.f, 0.f};
        pg8::f32x4 glv[2][2];
#pragma unroll
        for (int bj = 0; bj < 2; ++bj)
#pragma unroll
            for (int n = 0; n < 2; ++n) glv[bj][n] = pn >= 60 ? *(const pg8::f32x4*)(glab + (pn - 60) * 256 + bj * 128 + cw + 4 * n) : (pg8::f32x4){0.f, 0.f, 0.f, 0.f};
        float irs[2][4];
#pragma unroll
        for (int ai = 0; ai < 2; ++ai)
#pragma unroll
            for (int m = 0; m < 4; ++m) irs[ai][m] = inv_rms_of(st, row0 + ai * 128 + m * 16);
#pragma unroll
        for (int bj = 0; bj < 2; ++bj) { cs[bj][0] = (pg8::f32x4){0.f, 0.f, 0.f, 0.f}; cs[bj][1] = cs[bj][0]; }
#pragma unroll
        for (int ai = 0; ai < 2; ++ai)
#pragma unroll
            for (int m = 0; m < 4; ++m) {
                const int row = row0 + ai * 128 + m * 16; const float ir = irs[ai][m];
                if (pn < 28 || (pn >= 36 && pn < 60)) {
                    const bool sig = pn >= 36;
                    bf16* rowp = pn < 12 ? qkvh + ((size_t)((pn >> 2) * 8 + 2 * (pn & 3)) * S + row) * 128 + cw
                                         : proj + (size_t)row * LDP + (sig ? PC_G + (pn - 36) * 256 : pn * 256) + cw;
                    const size_t bjstep = pn < 12 ? (size_t)S * 128 : (size_t)128;
#pragma unroll
                    for (int bj = 0; bj < 2; ++bj) { pg8::f32x4 v0 = acc[ai][bj][m][0] * ir, v1 = acc[ai][bj][m][1] * ir;
                        if (ksumt) { cs[bj][0] += v0; cs[bj][1] += v1; }
                        if (pn < 8) { float ss = (v0[0] * v0[0] + v0[1] * v0[1]) + (v0[2] * v0[2] + v0[3] * v0[3]) + (v1[0] * v1[0] + v1[1] * v1[1]) + (v1[2] * v1[2] + v1[3] * v1[3]);
                            ss += xshfl<16>(ss); ss = swap32_sum(ss); nmx[bj] = fmaxf(nmx[bj], ss); }
                        if (sig) {
#pragma unroll
                            for (int j = 0; j < 4; ++j) { v0[j] = fmaxf(__builtin_amdgcn_rcpf(1.0f + __builtin_amdgcn_exp2f(-1.4426950408889634f * v0[j])), 1e-18f); v1[j] = fmaxf(__builtin_amdgcn_rcpf(1.0f + __builtin_amdgcn_exp2f(-1.4426950408889634f * v1[j])), 1e-18f); } }
                        pg8::u32x4 w; w.x = pg8::cvt_pk_bf16(v0[0], v0[1]); w.y = pg8::cvt_pk_bf16(v0[2], v0[3]); w.z = pg8::cvt_pk_bf16(v1[0], v1[1]); w.w = pg8::cvt_pk_bf16(v1[2], v1[3]);
                        ST16P((rowp + bj * bjstep), w); }
                } else if (pn < 36) {
                    bf16* rowp = proj + (size_t)row * LDP + PC_CU + (pn - 28) * 128 + cw;
                    const pg8::f32x4 v0 = (acc[ai][0][m][0] * ir) * (acc[ai][1][m][0] * ir), v1 = (acc[ai][0][m][1] * ir) * (acc[ai][1][m][1] * ir);
                    pg8::u32x4 w; w.x = pg8::cvt_pk_bf16(v0[0], v0[1]); w.y = pg8::cvt_pk_bf16(v0[2], v0[3]); w.z = pg8::cvt_pk_bf16(v1[0], v1[1]); w.w = pg8::cvt_pk_bf16(v1[2], v1[3]);
                    ST16P(rowp, w);
                } else {
#pragma unroll
                    for (int bj = 0; bj < 2; ++bj) { const int col = (pn - 60) * 256 + bj * 128 + cw; float* rowp = la + (size_t)row * 512 + col;
#pragma unroll
                        for (int n = 0; n < 2; ++n) { const pg8::f32x4 bv = glv[bj][n]; pg8::f32x4 z = acc[ai][bj][m][n] * ir + bv, o;
#pragma unroll
                            for (int j = 0; j < 4; ++j) o[j] = (fminf(z[j], 0.f) - 0.6931471805599453f * __builtin_amdgcn_logf(1.0f + __builtin_amdgcn_exp2f(-1.4426950408889634f * fabsf(z[j])))) * 0.0625f;
                            ST16P((rowp + 4 * n), o); } }
                }
            }
        if (pn < 8) {
#pragma unroll
            for (int bj = 0; bj < 2; ++bj) { float s = nmx[bj]; s = fmaxf(s, xshfl<1>(s)); s = fmaxf(s, xshfl<2>(s)); s = fmaxf(s, xshfl<4>(s)); s = fmaxf(s, xshfl<8>(s));
                if (fr == 0 && fq == 0) atomicMax(qkmax + ((pn >> 2) * 8 + 2 * (pn & 3) + bj) * 4 + wc, __float_as_uint(s)); }
        }
        if (ksumt) {
#pragma unroll
            for (int bj = 0; bj < 2; ++bj)
#pragma unroll
                for (int n = 0; n < 2; ++n)
#pragma unroll
                    for (int j = 0; j < 4; ++j) { float s = cs[bj][n][j]; s += xshfl<1>(s); s += xshfl<2>(s); s += xshfl<4>(s); s += xshfl<8>(s);
                        if (fr == 0) atomicAdd(ksum + u.pm * 1024 + (pn - 4) * 256 + bj * 128 + cw + 4 * n + j, s); }
        }
    }
};
struct EpiBranch {
    static constexpr bool PERM = true, AFTER_DRAIN = false, CARRY = true;
    const bf16* proj; bf16* mixed;
    __device__ __forceinline__ bool carry(const pg8::Unit& u) const { return (u.pm >> 5) < 2; }
    __device__ __forceinline__ void operator()(pg8::f32x4 (&acc)[2][2][4][2], const pg8::Unit& u, int wr, int wc, int fr, int fq) const {
        const int b = u.pm >> 5, pm = u.pm & 31, pn = u.pn & 7;
        const int row0 = pm * 256 + wr * 64 + fr, col0 = pn * 256 + wc * 32 + 8 * fq;
#pragma unroll
        for (int ai = 0; ai < 2; ++ai) {
            v4u ga[4][2], gb[4][2];
#pragma unroll
            for (int m = 0; m < 4; ++m)
#pragma unroll
                for (int bj = 0; bj < 2; ++bj) { const GAS bf16* gp = (const GAS bf16*)proj + (size_t)(row0 + ai * 128 + m * 16) * LDP + PC_G + b * D + col0 + bj * 128;
                    ga[m][bj] = *(const GAS v4u*)gp; gb[m][bj] = (b < 2) ? *(const GAS v4u*)(gp + D) : ga[m][bj]; }
#pragma unroll
            for (int m = 0; m < 4; ++m) { const int row = row0 + ai * 128 + m * 16;
#pragma unroll
                for (int bj = 0; bj < 2; ++bj) { const int col = col0 + bj * 128;
                    float f[8]; unpack8(ga[m][bj], f);
                    if (b < 2) { float f2[8]; unpack8(gb[m][bj], f2);
#pragma unroll
                        for (int j = 0; j < 8; ++j) f[j] *= __builtin_amdgcn_rcpf(f2[j]); }
                    pg8::f32x4 v0 = acc[ai][bj][m][0], v1 = acc[ai][bj][m][1];
                    v0[0] *= f[0]; v0[1] *= f[1]; v0[2] *= f[2]; v0[3] *= f[3]; v1[0] *= f[4]; v1[1] *= f[5]; v1[2] *= f[6]; v1[3] *= f[7];
                    if (b < 2) { acc[ai][bj][m][0] = v0; acc[ai][bj][m][1] = v1; }
                    else { pg8::u32x4 w; w.x = pg8::cvt_pk_bf16(v0[0], v0[1]); w.y = pg8::cvt_pk_bf16(v0[2], v0[3]); w.z = pg8::cvt_pk_bf16(v1[0], v1[1]); w.w = pg8::cvt_pk_bf16(v1[2], v1[3]);
                        ST16(((GAS bf16*)mixed + (size_t)row * D + col), w); } } }
            asm volatile("" ::: "memory"); }
    }
};
struct BranchOrder {
    pg8::StaticOrder so;
    __device__ bool next(int i, pg8::Unit& u) const { pg8::Unit t; if (!so.next(i / 3, t)) return false; const int b = i % 3; u.pm = b * 32 + t.pm; u.pn = b * 8 + t.pn; return true; }
    __device__ __forceinline__ void a_ready(const pg8::Unit&) const {}
    __device__ __forceinline__ void done(const pg8::Unit&) const {}
};
struct EpiResid {
    static constexpr bool PERM = true, AFTER_DRAIN = false, CARRY = false;
    bf16* XB; u64* st;
    __device__ __forceinline__ void operator()(const pg8::f32x4 (&acc)[2][2][4][2], const pg8::Unit& u, int wr, int wc, int fr, int fq) const {
        const int row0 = u.pm * 256 + wr * 64 + fr, col0 = u.pn * 256 + wc * 32 + 8 * fq;
#pragma unroll
        for (int ai = 0; ai < 2; ++ai) {
            v4u xv[4][2];
#pragma unroll
            for (int m = 0; m < 4; ++m)
#pragma unroll
                for (int bj = 0; bj < 2; ++bj) xv[m][bj] = *(const GAS v4u*)((const GAS bf16*)XB + (size_t)(row0 + ai * 128 + m * 16) * D + col0 + bj * 128);
#pragma unroll
            for (int m = 0; m < 4; ++m) { const int row = row0 + ai * 128 + m * 16; float ss = 0.f;
#pragma unroll
                for (int bj = 0; bj < 2; ++bj) { const int col = col0 + bj * 128; float x[8]; unpack8(xv[m][bj], x);
                    const pg8::f32x4 a0 = acc[ai][bj][m][0], a1 = acc[ai][bj][m][1];
                    const float v[8] = {x[0] + a0[0], x[1] + a0[1], x[2] + a0[2], x[3] + a0[3], x[4] + a1[0], x[5] + a1[1], x[6] + a1[2], x[7] + a1[3]};
                    ss += (v[0] * v[0] + v[1] * v[1]) + (v[2] * v[2] + v[3] * v[3]) + (v[4] * v[4] + v[5] * v[5]) + (v[6] * v[6] + v[7] * v[7]);
                    pg8::u32x4 w; w.x = pg8::cvt_pk_bf16(v[0], v[1]); w.y = pg8::cvt_pk_bf16(v[2], v[3]); w.z = pg8::cvt_pk_bf16(v[4], v[5]); w.w = pg8::cvt_pk_bf16(v[6], v[7]);
                    ST16(((GAS bf16*)XB + (size_t)row * D + col), w); }
                ss += xshfl<16>(ss); ss = swap32_sum(ss);
                if (fq == 0) __hip_atomic_fetch_add(st + row, (u64)(ss * FIX_SCALE + 0.5f), __ATOMIC_RELAXED, __HIP_MEMORY_SCOPE_AGENT); }
            asm volatile("" ::: "memory"); }
    }
};
struct EpiGU {
    static constexpr bool PERM = true, AFTER_DRAIN = false, CARRY = false;
    bf16* act; const u64* st;
    __device__ __forceinline__ void operator()(const pg8::f32x4 (&acc)[2][2][4][2], const pg8::Unit& u, int wr, int wc, int fr, int fq) const {
        const int row0 = u.pm * 256 + wr * 64 + fr, col0 = u.pn * 128 + wc * 32 + 8 * fq;
        float irs[2][4];
#pragma unroll
        for (int ai = 0; ai < 2; ++ai)
#pragma unroll
            for (int m = 0; m < 4; ++m) irs[ai][m] = inv_rms_of(st, row0 + ai * 128 + m * 16);
#pragma unroll
        for (int ai = 0; ai < 2; ++ai)
#pragma unroll
            for (int m = 0; m < 4; ++m) { const int row = row0 + ai * 128 + m * 16; const float ir = irs[ai][m];
                pg8::f32x4 o[2];
#pragma unroll
                for (int n = 0; n < 2; ++n) { const pg8::f32x4 g = acc[ai][0][m][n] * ir, uu = acc[ai][1][m][n] * ir;
#pragma unroll
                    for (int j = 0; j < 4; ++j) o[n][j] = g[j] * __builtin_amdgcn_rcpf(1.0f + __builtin_amdgcn_exp2f(-1.4426950408889634f * g[j])) * uu[j]; }
                pg8::u32x4 w; w.x = pg8::cvt_pk_bf16(o[0][0], o[0][1]); w.y = pg8::cvt_pk_bf16(o[0][2], o[0][3]); w.z = pg8::cvt_pk_bf16(o[1][0], o[1][1]); w.w = pg8::cvt_pk_bf16(o[1][2], o[1][3]);
                ST16P((act + (size_t)row * DFF + col0), w); }
    }
};


struct Args { const float* in[16]; float* out; unsigned char* ws; int ph_lo, ph_hi, li, pad; };
struct Ptrs {
    const float *x, *norm1_w, *w_in, *gla_w_up, *gla_b, *gla_norm_w, *conv_w, *w_br0, *w_br1, *w_br2, *w_out, *norm2_w, *w_gate, *w_up, *w_down, *final_w;
    float* X; unsigned char* ws; u64* stats;
    bf16 *XB, *PROJ, *A3, *MIXED, *ACT, *QKVH; float *LA, *KSUM, *DECAY, *T, *PML; bf16 *KVT, *SPT; unsigned* QKMAX; int* PLAN; int* SELCNT; int* BCNT; unsigned* SEL; float *RP, *RPML;
    int G, vcu, wv;
};
#define OPAQUE_TID() int lane_v_; asm volatile("v_mbcnt_lo_u32_b32 %0, -1, 0\n\tv_mbcnt_hi_u32_b32 %0, -1, %0" : "=v"(lane_v_)); const int lane = lane_v_, wave = P.wv, tid = wave * 64 + lane; (void)lane; (void)wave; (void)tid

typedef const __attribute__((address_space(4))) unsigned char* KPTR;
__device__ __forceinline__ void fill_ptrs(Ptrs& P, KPTR kp, int wv) {
    const __attribute__((address_space(4))) Args* a = (const __attribute__((address_space(4))) Args*)kp;
    P.wv = wv; P.G = gridDim.x; { const int bx = blockIdx.x; P.vcu = (P.G % 8 == 0) ? (bx % 8) * (P.G / 8) + bx / 8 : bx; }
    P.x = a->in[0]; P.norm1_w = a->in[1]; P.w_in = a->in[2]; P.gla_w_up = a->in[3]; P.gla_b = a->in[4]; P.gla_norm_w = a->in[5]; P.conv_w = a->in[6];
    P.w_br0 = a->in[7]; P.w_br1 = a->in[8]; P.w_br2 = a->in[9]; P.w_out = a->in[10]; P.norm2_w = a->in[11]; P.w_gate = a->in[12]; P.w_up = a->in[13]; P.w_down = a->in[14]; P.final_w = a->in[15];
    P.X = a->out; unsigned char* ws = a->ws; P.ws = ws;
    P.stats = (u64*)(ws + WS_CTL + CTL_STATS);
    P.XB = (bf16*)(ws + WS_XB); P.PROJ = (bf16*)(ws + WS_PROJ); P.LA = (float*)(ws + WS_LA); P.A3 = (bf16*)(ws + WS_A3); P.KSUM = (float*)(ws + WS_CTL + CTL_KSUM); P.QKMAX = (unsigned*)(ws + WS_CTL + CTL_QKMAX); P.PLAN = (int*)(ws + WS_CTL + CTL_PLAN); P.SELCNT = (int*)(ws + WS_CTL + CTL_SELCNT); P.BCNT = (int*)(ws + WS_CTL + CTL_BCNT); P.SEL = (unsigned*)(ws + WS_SEL); P.RP = (float*)(ws + WS_RP); P.RPML = (float*)(ws + WS_RPML); P.PML = (float*)(ws + WS_PML); P.DECAY = (float*)(ws + WS_DECAY);
    P.KVT = (bf16*)(ws + WS_KV); P.SPT = (bf16*)(ws + WS_SPREV); P.T = (float*)(ws + WS_T); P.MIXED = (bf16*)(ws + WS_MIXED); P.ACT = (bf16*)(ws + WS_ACT); P.QKVH = (bf16*)(ws + WS_QKVH);
}
__device__ __forceinline__ void xpose_store(LAS float* scr, bf16* dst, int K, int lane, const f32x4 s0, const f32x4 s1) {
    LDS_WAIT(); asm volatile("" ::: "memory");
    const int c = lane & 7;
#pragma unroll
    for (int j = 0; j < 4; ++j) { const int n = (lane >> 3) + 8 * j; const LAS float* s = scr + (8 * c) * 33 + n;
        v4u o; o.x = pk2(s[0 * 33] * s0.x, s[1 * 33] * s0.y); o.y = pk2(s[2 * 33] * s0.z, s[3 * 33] * s0.w); o.z = pk2(s[4 * 33] * s1.x, s[5 * 33] * s1.y); o.w = pk2(s[6 * 33] * s1.z, s[7 * 33] * s1.w);
        *(GAS v4u*)(dst + (size_t)n * K + 8 * c) = o; }
    LDS_WAIT(); asm volatile("" ::: "memory");
}
constexpr int IT_IN = 496 * 32, IT_BR = 3 * 64 * 16, IT_OUT = 64 * 32, IT_GU = 352 * 32, IT_DN = 64 * 88, IT_L = IT_IN + IT_BR + IT_OUT + IT_GU + IT_DN;
constexpr int R_T1 = 4096, R_TAIL = 4096 + 9216;
struct CvtD { const float* b0; const float* b1; const float* scale; bf16* dst; unsigned st0, st1, hs0, ls0, hs1, ls1; int K; int z; bool hs; };
__device__ __forceinline__ void cvt_copy(CvtD& d, const float* src, unsigned ld, const float* scale, bf16* dst, int K) {
    d.b0 = src; d.b1 = src + (size_t)32 * ld; d.st0 = d.st1 = 2 * ld; d.hs0 = d.hs1 = ld; d.ls0 = d.ls1 = 1; d.dst = dst; d.K = K; d.z = -1; d.hs = scale != nullptr; if (scale) d.scale = scale;
}
__device__ __forceinline__ void cvt_decode(const Ptrs& P, int it0, int nA, int lA, int rA0, int nB, int lB0, int rB0, CvtD& d) {
    int l, r; if (it0 < nA) { l = lA; r = rA0 + it0; } else { const int q = it0 - nA; l = lB0 + q / nB; r = rB0 + q % nB; }
    unsigned char* wl = P.ws + WS_W + (size_t)l * WL_BYTES;
    d.scale = P.norm1_w;
    if (r < IT_IN) {
        const int kb = r / 496, g = r % 496, k0 = 64 * kb;
        const float* win = P.w_in + (size_t)l * D * NIN; const float* sc = P.norm1_w + l * D + k0;
        bf16* dst = (bf16*)(wl + WL_IN) + (size_t)(32 * g) * D + k0;
        int c0;
        if (g < 192) c0 = 32 * g;
        else if (g < 224) c0 = 6160 + 32 * (g - 192);
        else if (g < 288) { const int t = (g - 224) >> 3, sub = (g - 224) & 7; c0 = (sub < 4 ? 7184 : 8208) + 128 * t + 32 * (sub & 3); }
        else if (g < 480) c0 = 9232 + 32 * (g - 288);
        else c0 = 6144;
        cvt_copy(d, win + (size_t)k0 * NIN + c0, NIN, sc, dst, D);
        if (g >= 480) { d.z = 32 * (g - 480); d.st0 = 1; d.hs0 = 32 * NIN; d.ls0 = NIN; d.b1 = P.gla_w_up + (size_t)l * 16 * 512 + 32 * (g - 480); d.st1 = 512; d.hs1 = 0; d.ls1 = 1; }
        return;
    }
    r -= IT_IN;
    if (r < 1024) { const int kb = r / 64, g = r % 64, k0 = 64 * kb;
        cvt_copy(d, P.w_br0 + (size_t)l * 1024 * D + (size_t)k0 * D + 32 * g, D, nullptr, (bf16*)(wl + WL_BR) + (size_t)(0 * D + 32 * g) * 1024 + k0, 1024); return; }
    r -= 1024;
    if (r < 1024) { const int kb = r / 64, g = r % 64, k0 = 64 * kb;
        cvt_copy(d, P.w_br1 + (size_t)l * 1024 * D + (size_t)k0 * D + 32 * g, D, nullptr, (bf16*)(wl + WL_BR) + (size_t)(1 * D + 32 * g) * 1024 + k0, 1024); return; }
    r -= 1024;
    if (r < 1024) { const int kb = r / 64, g = r % 64, k0 = 64 * kb;
        cvt_copy(d, P.w_br2 + (size_t)l * 1024 * D + (size_t)k0 * D + 32 * g, D, nullptr, (bf16*)(wl + WL_BR) + (size_t)(2 * D + 32 * g) * 1024 + k0, 1024); return; }
    r -= 1024;
    if (r < IT_OUT) { const int kb = r / 64, g = r % 64, k0 = 64 * kb;
        cvt_copy(d, P.w_out + (size_t)l * D * D + (size_t)k0 * D + 32 * g, D, nullptr, (bf16*)(wl + WL_OUT) + (size_t)(32 * g) * D + k0, D); return; }
    r -= IT_OUT;
    if (r < IT_GU) { const int kb = r / 352, g = r % 352, k0 = 64 * kb, t = g >> 3, sub = g & 7;
        cvt_copy(d, (sub < 4 ? P.w_gate : P.w_up) + (size_t)l * D * DFF + (size_t)k0 * DFF + 128 * t + 32 * (sub & 3), DFF, P.norm2_w + l * D + k0, (bf16*)(wl + WL_GU) + (size_t)(32 * g) * D + k0, D); return; }
    r -= IT_GU;
    { const int kb = r / 64, g = r % 64, k0 = 64 * kb;
        cvt_copy(d, P.w_down + (size_t)l * DFF * D + (size_t)k0 * D + 32 * g, D, nullptr, (bf16*)(wl + WL_DN) + (size_t)(32 * g) * DFF + k0, DFF); }
}
#define CVT_ISSUE(d, v, s0, s1) do { \
    { const GAS float* p_ = (const GAS float*)(d).b0 + ((lane >> 5) * (d).hs0 + (lane & 31) * (d).ls0); \
      _Pragma("unroll") for (int i_ = 0; i_ < 16; ++i_) { v[i_] = *p_; p_ += (d).st0; asm volatile("" : "+v"(p_)); } } \
    { const GAS float* p_ = (const GAS float*)(d).b1 + ((lane >> 5) * (d).hs1 + (lane & 31) * (d).ls1); \
      _Pragma("unroll") for (int i_ = 0; i_ < 16; ++i_) { v[16 + i_] = *p_; p_ += (d).st1; asm volatile("" : "+v"(p_)); } } \
    s0 = *(const GAS f32x4*)((const GAS float*)(d).scale + 8 * (lane & 7)); s1 = *(const GAS f32x4*)((const GAS float*)(d).scale + 8 * (lane & 7) + 4); } while (0)
#define CVT_FINISH(d, v, s0, s1) do { \
    const f32x4 one_ = {1.f, 1.f, 1.f, 1.f}; const f32x4 t0_ = (d).hs ? s0 : one_, t1_ = (d).hs ? s1 : one_; \
    if ((d).z < 0) { _Pragma("unroll") for (int i_ = 0; i_ < 32; ++i_) scr[(2 * i_ + (lane >> 5)) * 33 + (lane & 31)] = v[i_]; } \
    else { LAS f32x4* st_ = (LAS f32x4*)(scr + 64 * 33 + 16); \
        _Pragma("unroll") for (int q_ = 0; q_ < 4; ++q_) st_[lane * 4 + q_] = f32x4{v[4 * q_], v[4 * q_ + 1], v[4 * q_ + 2], v[4 * q_ + 3]}; \
        LDS_WAIT(); asm volatile("" ::: "memory"); \
        _Pragma("unroll 4") for (int i_ = 0; i_ < 32; ++i_) { const int kk_ = 2 * i_ + (lane >> 5); const f32x4 a0 = st_[kk_ * 4], a1 = st_[kk_ * 4 + 1], a2 = st_[kk_ * 4 + 2], a3 = st_[kk_ * 4 + 3]; \
            scr[kk_ * 33 + (lane & 31)] = ((a0.x * v[16] + a0.y * v[17]) + (a0.z * v[18] + a0.w * v[19])) + ((a1.x * v[20] + a1.y * v[21]) + (a1.z * v[22] + a1.w * v[23])) \
                                        + ((a2.x * v[24] + a2.y * v[25]) + (a2.z * v[26] + a2.w * v[27])) + ((a3.x * v[28] + a3.y * v[29]) + (a3.z * v[30] + a3.w * v[31])); } } \
    xpose_store(scr, (d).dst, (d).K, lane, t0_, t1_); } while (0)
__device__ __forceinline__ void convert_items(const Ptrs& P, LAS unsigned char* lds, int nA, int lA, int rA0, int nB, int nrep, int lB0, int rB0, int worker0, int nworkers) {
    OPAQUE_TID();
    LAS float* scr = (LAS float*)(lds + wave * 16384);
    const int tot = nA + nrep * nB, stride = nworkers * NWAVES;
    int it = worker0 * NWAVES + wave;
    if (it >= tot) return;
    CvtD a, b; float va[32], vb[32]; f32x4 sa0, sa1, sb0, sb1;
    cvt_decode(P, it, nA, lA, rA0, nB, lB0, rB0, a); CVT_ISSUE(a, va, sa0, sa1);
    for (;;) {
        const int itb = it + stride; const bool hb = itb < tot;
        cvt_decode(P, hb ? itb : it, nA, lA, rA0, nB, lB0, rB0, b); CVT_ISSUE(b, vb, sb0, sb1);
        CVT_FINISH(a, va, sa0, sa1);
        if (!hb) break;
        it = itb + stride; const bool ha = it < tot;
        cvt_decode(P, ha ? it : itb, nA, lA, rA0, nB, lB0, rB0, a); CVT_ISSUE(a, va, sa0, sa1);
        CVT_FINISH(b, vb, sb0, sb1);
        if (!ha) break;
    }
}
__device__ __forceinline__ void p0_prologue(const Ptrs& P, LAS unsigned char* lds) {
    convert_items(P, lds, IT_L, 0, 0, IT_L - R_TAIL, NL - 1, 1, R_TAIL, P.vcu, P.G);
    OPAQUE_TID();
    const int gw = P.vcu * NWAVES + wave, NGW = P.G * NWAVES;
    for (int m = gw; m < S; m += NGW) {
        const GAS f32x4* xr = (const GAS f32x4*)(P.x + (size_t)m * D) + lane;
        GAS unsigned long long* xb = (GAS unsigned long long*)(P.XB + (size_t)m * D) + lane;
        float ss = 0.f;
#pragma unroll
        for (int j = 0; j < 8; ++j) { const f32x4 v = xr[64 * j]; ss += (v.x * v.x + v.y * v.y) + (v.z * v.z + v.w * v.w);
            xb[64 * j] = (unsigned long long)pk2(v.x, v.y) | ((unsigned long long)pk2(v.z, v.w) << 32); }
        ss = wave_sum(ss);
        if (lane == 0) P.stats[m] = (u64)(ss * FIX_SCALE + 0.5f);
    }
}
__device__ __forceinline__ void final_norm(const Ptrs& P) {
    OPAQUE_TID();
    const int gw = P.vcu * NWAVES + wave, NGW = P.G * NWAVES;
    for (int m = gw; m < S; m += NGW) {
        const GAS v4u* xr = (const GAS v4u*)(P.XB + (size_t)m * D) + lane; float x[4][8]; float ss = 0.f;
#pragma unroll
        for (int j = 0; j < 4; ++j) { unpack8(xr[64 * j], x[j]);
#pragma unroll
            for (int q = 0; q < 8; ++q) ss += x[j][q] * x[j][q]; }
        const float ir = rsqrtf(wave_sum(ss) * (1.0f / D) + RMS_EPS);
#pragma unroll
        for (int j = 0; j < 4; ++j) { const GAS f32x4* wf = (const GAS f32x4*)(P.final_w + 512 * j + 8 * lane); GAS f32x4* op = (GAS f32x4*)(P.X + (size_t)m * D + 512 * j + 8 * lane);
            const f32x4 w0 = wf[0], w1 = wf[1];
            op[0] = (f32x4){x[j][0] * ir * w0.x, x[j][1] * ir * w0.y, x[j][2] * ir * w0.z, x[j][3] * ir * w0.w};
            op[1] = (f32x4){x[j][4] * ir * w1.x, x[j][5] * ir * w1.y, x[j][6] * ir * w1.z, x[j][7] * ir * w1.w}; }
    }
}

__device__ __forceinline__ void att_plan_write(const unsigned* qkmax, int* plan, int lane);
__device__ __forceinline__ void m1_kmean_conv(const Ptrs& P, int l) {
    OPAQUE_TID();
    if ((int)blockIdx.x == P.G - 97 && wave == 0) att_plan_write(P.QKMAX + l * 64, P.PLAN + l * 32, lane);
    const GAS float* cw = (const GAS float*)P.conv_w + (size_t)l * 3 * 1024;
    if ((int)blockIdx.x >= P.G - 96) return;
    for (int item = blockIdx.x * 512 + tid; item < (S / 8) * 128; item += (P.G - 96) * 512) { const int c8 = (item & 127) * 8, t0 = (item >> 7) * 8;
        const GAS bf16* pr = (const GAS bf16*)P.PROJ + c8;
        v4u x[10], bgv[8]; f32x4 w[3][2];
#pragma unroll
        for (int i = 0; i < 10; ++i) { const int t = t0 + i - 2; x[i] = *(const GAS v4u*)(pr + (size_t)(t < 0 ? 0 : t) * LDP + PC_CU); }
#pragma unroll
        for (int i = 0; i < 8; ++i) bgv[i] = *(const GAS v4u*)(pr + (size_t)(t0 + i) * LDP + PC_BG);
#pragma unroll
        for (int k = 0; k < 3; ++k) { w[k][0] = *(const GAS f32x4*)(cw + k * 1024 + c8); w[k][1] = *(const GAS f32x4*)(cw + k * 1024 + c8 + 4); }
        if (t0 == 0) { x[0] = v4u{0u, 0u, 0u, 0u}; x[1] = x[0]; }
#pragma unroll
        for (int i = 0; i < 8; ++i) {
            float f2[8], f1[8], f0[8], fb[8], y[8]; unpack8(x[i], f2); unpack8(x[i + 1], f1); unpack8(x[i + 2], f0); unpack8(bgv[i], fb);
#pragma unroll
            for (int j = 0; j < 8; ++j) y[j] = fb[j] * (w[0][j >> 2][j & 3] * f2[j] + w[1][j >> 2][j & 3] * f1[j] + w[2][j >> 2][j & 3] * f0[j]);
            v4u o; o.x = pk2(y[0], y[1]); o.y = pk2(y[2], y[3]); o.z = pk2(y[4], y[5]); o.w = pk2(y[6], y[7]);
            ST16P((P.A3 + (size_t)2 * S * 1024 + (size_t)(t0 + i) * 1024 + c8), o); } }
}
typedef short s16x4 __attribute__((ext_vector_type(4)));
typedef float f32x16 __attribute__((ext_vector_type(16)));
__device__ __forceinline__ int crow(int r, int h) { return (r & 3) + 8 * (r >> 2) + 4 * h; }
__device__ __forceinline__ bf16x8 tr_frag(LAS const unsigned char* tile, int stride, int k0, int col0, int lane) {
    const int h = lane >> 5, blk = (lane >> 4) & 1, q = (lane & 15) >> 2, p = lane & 3;
    LAS const unsigned char* a = tile + (k0 + 8 * h + q) * stride + (col0 + 16 * blk + 4 * p) * 2;
    const s16x4 lo = __builtin_amdgcn_ds_read_tr16_b64_v4i16((LAS s16x4*)a);
    const s16x4 hi = __builtin_amdgcn_ds_read_tr16_b64_v4i16((LAS s16x4*)(a + 4 * stride));
    return (bf16x8){lo[0], lo[1], lo[2], lo[3], hi[0], hi[1], hi[2], hi[3]};
}
__device__ __forceinline__ bf16x8 row_frag(LAS const unsigned char* tile, int stride, int row0, int k0, int lane) {
    return *(LAS const bf16x8*)(tile + (row0 + (lane & 31)) * stride + (k0 + 8 * (lane >> 5)) * 2);
}
constexpr int GL_VL_STRIDE = 576, GL_QK_STRIDE = 272, GL_KD_STRIDE = 320, GL_XS_STRIDE = 144, GL_OL_STRIDE = 1040;
__device__ __forceinline__ void gla_cumsum(float (&la)[16], int tid, LAS float* tot, LAS float* bcum) {
    const int d = tid & 127, g = tid >> 7; float a = 0.f;
#pragma unroll
    for (int i = 0; i < 16; ++i) { a += la[i]; la[i] = a; }
    tot[g * 128 + d] = a;
    __syncthreads();
    const float t0v = tot[d], t1v = tot[128 + d], t2v = tot[256 + d];
    const float off = (g > 0 ? t0v : 0.f) + (g > 1 ? t1v : 0.f) + (g > 2 ? t2v : 0.f);
#pragma unroll
    for (int i = 0; i < 16; ++i) bcum[(16 * g + i) * 128 + d] = la[i] + off;
    __syncthreads();
}
__device__ __forceinline__ void m1_gla_local(const Ptrs& P, LAS unsigned char* lds) {
    OPAQUE_TID();
    LAS float* bcum = (LAS float*)lds; LAS unsigned char* KD = lds + 32768; LAS unsigned char* VL = lds + 65536; LAS float* tot = (LAS float*)(lds + 102400);
    LAS unsigned char* stg = lds + wave * 8192;
    for (int unit = blockIdx.x; unit < 512; unit += P.G) { const int h = unit >> 7, n = unit & 127, t0 = n * 64;
        float la[16]; { const GAS float* p = (const GAS float*)P.LA + (size_t)(t0 + 16 * (tid >> 7)) * 512 + h * 128 + (tid & 127);
#pragma unroll
            for (int i = 0; i < 16; ++i) la[i] = p[(size_t)i * 512]; }
        v4u kq[2], vv[4];
#pragma unroll
        for (int i = 0; i < 2; ++i) { const int idx = tid + 512 * i, s = idx >> 4, ch = idx & 15; kq[i] = *(const GAS v4u*)((const GAS bf16*)P.PROJ + (size_t)(t0 + s) * LDP + PC_KG + h * 128 + 8 * ch); }
#pragma unroll
        for (int j = 0; j < 4; ++j) { const int idx = tid + 512 * j, s = idx >> 5, ch = idx & 31; vv[j] = *(const GAS v4u*)((const GAS bf16*)P.PROJ + (size_t)(t0 + s) * LDP + PC_VG + h * 256 + 8 * ch); }
        gla_cumsum(la, tid, tot, bcum);
        if (tid < 128) P.DECAY[(h * 128 + n) * 128 + tid] = __expf(bcum[63 * 128 + tid]);
#pragma unroll
        for (int i = 0; i < 2; ++i) { const int idx = tid + 512 * i, s = idx >> 4, ch = idx & 15;
            const f32x4 b0 = *(const LAS f32x4*)(bcum + s * 128 + 8 * ch), b1 = *(const LAS f32x4*)(bcum + s * 128 + 8 * ch + 4), l0 = *(const LAS f32x4*)(bcum + 63 * 128 + 8 * ch), l1 = *(const LAS f32x4*)(bcum + 63 * 128 + 8 * ch + 4);
            float k[8]; unpack8(kq[i], k);
            v4u w; w.x = pk2(k[0] * __expf(l0.x - b0.x), k[1] * __expf(l0.y - b0.y)); w.y = pk2(k[2] * __expf(l0.z - b0.z), k[3] * __expf(l0.w - b0.w));
            w.z = pk2(k[4] * __expf(l1.x - b1.x), k[5] * __expf(l1.y - b1.y)); w.w = pk2(k[6] * __expf(l1.z - b1.z), k[7] * __expf(l1.w - b1.w));
            *(LAS v4u*)(KD + s * GL_KD_STRIDE + ch * 16) = w; }
#pragma unroll
        for (int j = 0; j < 4; ++j) { const int idx = tid + 512 * j, s = idx >> 5, ch = idx & 31; *(LAS v4u*)(VL + s * GL_VL_STRIDE + ch * 16) = vv[j]; }
        __syncthreads();
        f32x16 acc[4];
#pragma unroll
        for (int dt = 0; dt < 4; ++dt)
#pragma unroll
            for (int r = 0; r < 16; ++r) acc[dt][r] = 0.f;
#pragma unroll
        for (int ks = 0; ks < 4; ++ks) { const bf16x8 a = tr_frag(VL, GL_VL_STRIDE, 16 * ks, 32 * wave, lane);
#pragma unroll
            for (int dt = 0; dt < 4; ++dt) { const bf16x8 bb = tr_frag(KD, GL_KD_STRIDE, 16 * ks, 32 * dt, lane); acc[dt] = __builtin_amdgcn_mfma_f32_32x32x16_bf16(a, bb, acc[dt], 0, 0, 0); } }
        __syncthreads();
#pragma unroll
        for (int r = 0; r < 16; ++r) { LAS unsigned char* rowp = stg + crow(r, lane >> 5) * 256 + (lane & 31) * 2;
#pragma unroll
            for (int dt = 0; dt < 4; ++dt) *(LAS bf16*)(rowp + dt * 64) = (bf16)f2bf(acc[dt][r]); }
        LDS_WAIT();
        { GAS bf16* kvt = (GAS bf16*)P.KVT + ((size_t)(h * 128 + n) * 256 + 32 * wave) * 128;
#pragma unroll
            for (int i = 0; i < 8; ++i) { const int row = 4 * i + (lane >> 4); ST16((kvt + (size_t)row * 128 + 8 * (lane & 15)), *(const LAS v4u*)(stg + row * 256 + (lane & 15) * 16)); } }
        __syncthreads();
    }
}
typedef float f32x2v __attribute__((ext_vector_type(2)));
__device__ __forceinline__ void m2_gla_scan(const Ptrs& P) {
    OPAQUE_TID();
    if (tid < 256) for (int gid = blockIdx.x * 256 + tid; gid < 4 * 16384; gid += P.G * 256) { const int h = gid >> 14, rem = gid & 16383, e = rem >> 6, d = (rem & 63) * 2; float s0 = 0.f, s1 = 0.f;
        const GAS bf16* kp = (const GAS bf16*)P.KVT + ((size_t)(h * 128) * 256 + e) * 128 + d; GAS bf16* sp = (GAS bf16*)P.SPT + ((size_t)(h * 128) * 256 + e) * 128 + d; const GAS float* dp = (const GAS float*)P.DECAY + (h * 128) * 128 + d;
        unsigned kvA[16], kvB[16]; f32x2v dA[16], dB[16];
#define SCAN_LOAD(KV, DD, N0) do { _Pragma("unroll") for (int j = 0; j < 16; ++j) { KV[j] = *(const GAS unsigned*)(kp + (size_t)((N0) + j) * 32768); DD[j] = *(const GAS f32x2v*)(dp + ((N0) + j) * 128); } } while (0)
#define SCAN_STEP(KV, DD, N0) do { _Pragma("unroll") for (int j = 0; j < 16; ++j) { *(GAS unsigned*)(sp + (size_t)((N0) + j) * 32768) = pk2(s0, s1); s0 = DD[j].x * s0 + bflo(KV[j]); s1 = DD[j].y * s1 + bfhi(KV[j]); } } while (0)
        SCAN_LOAD(kvA, dA, 0);
#pragma unroll 1
        for (int n0 = 0; n0 < 128; n0 += 32) { SCAN_LOAD(kvB, dB, n0 + 16); SCAN_STEP(kvA, dA, n0); if (n0 + 32 < 128) SCAN_LOAD(kvA, dA, n0 + 32); SCAN_STEP(kvB, dB, n0 + 16); }
#undef SCAN_LOAD
#undef SCAN_STEP
    }
}
namespace mo {
constexpr float SCALE = 0.08838834764831845f, THR = 8.f;
constexpr int NW = 8, QBLK = 32, KVBLK = 64, QB = 256, DH = 128, LDQ = 128, LDO = 1024;
constexpr int SHM_V = KVBLK * DH * 2, SHM_K = KVBLK * DH * 2, ATT_STG = 2 * SHM_V + 2 * SHM_K  , ATT_WS = RING_BYTES + 1024  ;
constexpr int ATT_RL = RING_BYTES + 4096  , ATT_SL = RING_BYTES + 5120  ;
static_assert(ATT_STG + NW * 8192 <= RING_BYTES && ATT_WS + NW * 256 <= ATT_RL && ATT_SL + 1024 <= LDS_BYTES && ATT_WS >= MISC_OFF + 128, "attention LDS");
typedef short s16x4 __attribute__((ext_vector_type(4)));
typedef float f32x16 __attribute__((ext_vector_type(16)));
typedef unsigned u32x4 __attribute__((ext_vector_type(4)));
#define KSWZ(row, colB) ((row) * 256 + ((colB) ^ (((row) & 7) << 4)))
#define SBAR() __builtin_amdgcn_sched_barrier(0)
__device__ __forceinline__ int v_st(int k, int c) { const int kk = (k & ~0xC) | ((k & 4) << 1) | ((k & 8) >> 1); return ((kk >> 3) * 4 + (c >> 5)) * 512 + ((kk & 7) * 32 + (c & 31)) * 2; }
__device__ __forceinline__ int v_rd_base(int lane) { return ((lane & 3) << 3) | (((lane >> 2) & 3) << 6) | (((lane >> 4) & 1) << 5) | (((lane >> 5) & 1) << 8); }
constexpr int v_rd_off(int d0, int ks, int half) { return d0 * 512 + ks * 4096 + half * 2048; }
__device__ __forceinline__ int crow(int r, int hi) { return (r & 3) + 8 * (r >> 2) + 4 * hi; }
__device__ __forceinline__ unsigned cvtpk(float lo, float hi) { unsigned r; asm volatile("v_cvt_pk_bf16_f32 %0, %1, %2" : "=v"(r) : "v"(lo), "v"(hi)); return r; }
__device__ __forceinline__ bf16x8 pack8(f32x4 a, f32x4 b) { u32x4 w = {cvtpk(a[0], a[1]), cvtpk(a[2], a[3]), cvtpk(b[0], b[1]), cvtpk(b[2], b[3])}; return *reinterpret_cast<bf16x8*>(&w); }
__device__ __forceinline__ bf16x8 load8(const GAS bf16* p) { return *reinterpret_cast<const GAS bf16x8*>(p); }
__device__ __forceinline__ void mask_tile(f32x16& p0, f32x16& p1, int dq) {
    const float NEG = -__builtin_inff();
#pragma unroll
    for (int r = 0; r < 16; ++r) { const int c = (r & 3) + 8 * (r >> 2); if (dq - c < 0) p0[r] = NEG; if (dq - c - 32 < 0) p1[r] = NEG; }
}
__device__ __forceinline__ void partialSM(f32x16& p0, f32x16& p1, float& m_reg, float& mn, float& alpha) {
    float pmax = p0[0]; for (int r = 1; r < 16; ++r) pmax = fmaxf(pmax, p0[r]); for (int r = 0; r < 16; ++r) pmax = fmaxf(pmax, p1[r]);
    { auto rr = __builtin_amdgcn_permlane32_swap(__float_as_uint(pmax), __float_as_uint(pmax), false, false);
      pmax = fmaxf(__uint_as_float(rr[0]), __uint_as_float(rr[1])); }
    constexpr float C2 = 1.4426950408889634f * SCALE;
    if (__builtin_expect(__all((pmax - m_reg) * SCALE <= THR), 1)) { mn = m_reg; alpha = 1.f; }
    else { mn = fmaxf(m_reg, pmax); alpha = __builtin_amdgcn_exp2f((m_reg - mn) * C2); m_reg = mn; }
    const float mnL = -mn * C2;
    for (int r = 0; r < 16; ++r) p0[r] = fmaf(p0[r], C2, mnL); for (int r = 0; r < 16; ++r) p1[r] = fmaf(p1[r], C2, mnL);
    for (int r = 0; r < 16; ++r) p0[r] = __builtin_amdgcn_exp2f(p0[r]);
}
__device__ __forceinline__ void finishSM(f32x16& p0, f32x16& p1, float alpha, float& l_reg, bf16x8& pa0, bf16x8& pa1, bf16x8& pa2, bf16x8& pa3) {
    for (int r = 0; r < 16; ++r) p1[r] = __builtin_amdgcn_exp2f(p1[r]);
    float ps = 0; for (int r = 0; r < 16; ++r) ps += p0[r]; for (int r = 0; r < 16; ++r) ps += p1[r];
    { auto rr = __builtin_amdgcn_permlane32_swap(__float_as_uint(ps), __float_as_uint(ps), false, false);
      ps = __uint_as_float(rr[0]) + __uint_as_float(rr[1]); }
    l_reg = l_reg * alpha + ps;
#define PK4(P, B_, OUT) do { unsigned a0 = cvtpk(P[B_+0], P[B_+1]), a1 = cvtpk(P[B_+2], P[B_+3]);                          \
        unsigned b0 = cvtpk(P[B_+4], P[B_+5]), b1 = cvtpk(P[B_+6], P[B_+7]);                                             \
        auto r0 = __builtin_amdgcn_permlane32_swap(a0, b0, false, false); auto r1 = __builtin_amdgcn_permlane32_swap(a1, b1, false, false); \
        u32x4 w = {r0[0], r1[0], r0[1], r1[1]}; OUT = *reinterpret_cast<bf16x8*>(&w); } while (0)
    PK4(p0, 0, pa0); PK4(p0, 8, pa1); PK4(p1, 0, pa2); PK4(p1, 8, pa3);
#undef PK4
}
template <int KB>
__device__ __forceinline__ void qkt(f32x16& p0, f32x16& p1, const char* K_lds, int r32, int hi, const bf16x8* qr, float base, float sl) {
    { const float sl8 = 8.f * sl, sl32 = 32.f * sl; float gb = base;
#pragma unroll
        for (int g4 = 0; g4 < 4; ++g4) { float t = gb;
#pragma unroll
            for (int i = 0; i < 4; ++i) { p0[4 * g4 + i] = t; p1[4 * g4 + i] = t + sl32; t += sl; }
            gb += sl8; } }
    const char* kb[4];
#pragma unroll
    for (int dd = 0; dd < 4; ++dd) kb[dd] = K_lds + KB * SHM_K + KSWZ(r32, (dd * 16 + hi * 8) * 2);
#pragma unroll
    for (int d0 = 0; d0 < 8; ++d0) { const char* a = kb[d0 & 3] + (d0 >> 2) * 128;
        bf16x8 b0 = *reinterpret_cast<const bf16x8*>(a);
        bf16x8 b1 = *reinterpret_cast<const bf16x8*>(a + 32 * 256);
        p0 = __builtin_amdgcn_mfma_f32_32x32x16_bf16(b0, qr[d0], p0, 0, 0, 0);
        p1 = __builtin_amdgcn_mfma_f32_32x32x16_bf16(b1, qr[d0], p1, 0, 0, 0); }
}
template <int VB>
__device__ __forceinline__ void pv_tile(f32x16* o, int vb0, bf16x8 pa0, bf16x8 pa1, bf16x8 pa2, bf16x8 pa3) {
#define TRRD(dst, off) asm volatile("ds_read_b64_tr_b16 %0, %1 offset:%2" : "=&v"(dst) : "v"(vb0), "i"(off) : "memory")
#define PV_D0(d0) do { s16x4 l0, l1, l2, l3, h0, h1, h2, h3; constexpr int b_ = VB * SHM_V + v_rd_off(d0, 0, 0); \
        TRRD(l0, b_); TRRD(h0, b_ + 2048); TRRD(l1, b_ + 4096); TRRD(h1, b_ + 6144); TRRD(l2, b_ + 8192); TRRD(h2, b_ + 10240); TRRD(l3, b_ + 12288); TRRD(h3, b_ + 14336); \
        asm volatile("s_waitcnt lgkmcnt(0)" ::: "memory"); SBAR();   \
        o[d0] = __builtin_amdgcn_mfma_f32_32x32x16_bf16(pa0, (bf16x8){l0[0], l0[1], l0[2], l0[3], h0[0], h0[1], h0[2], h0[3]}, o[d0], 0, 0, 0);   \
        o[d0] = __builtin_amdgcn_mfma_f32_32x32x16_bf16(pa1, (bf16x8){l1[0], l1[1], l1[2], l1[3], h1[0], h1[1], h1[2], h1[3]}, o[d0], 0, 0, 0);   \
        o[d0] = __builtin_amdgcn_mfma_f32_32x32x16_bf16(pa2, (bf16x8){l2[0], l2[1], l2[2], l2[3], h2[0], h2[1], h2[2], h2[3]}, o[d0], 0, 0, 0);   \
        o[d0] = __builtin_amdgcn_mfma_f32_32x32x16_bf16(pa3, (bf16x8){l3[0], l3[1], l3[2], l3[3], h3[0], h3[1], h3[2], h3[3]}, o[d0], 0, 0, 0); } while (0)
    PV_D0(0); PV_D0(1); PV_D0(2); PV_D0(3);
#undef PV_D0
#undef TRRD
}
struct Seg { int P0, jb, je, slot; };
struct Head { unsigned char* ws; int h, l; float sl;
    __device__ __forceinline__ const GAS bf16* HB(int type) const { return (const GAS bf16*)(ws + WS_QKVH) + (size_t)(type * 8 + h) * S * 128; }
    __device__ __forceinline__ const GAS float* KM() const { unsigned char* w = ws; asm volatile("" : "+s"(w)); return (const GAS float*)(w + WS_CTL + CTL_KSUM) + (size_t)l * 32 * 1024 + h * 128; }
    __device__ __forceinline__ GAS bf16* OB() const { unsigned char* w = ws; asm volatile("" : "+s"(w)); return (GAS bf16*)(w + WS_A3) + h * 128; }
    __device__ __forceinline__ GAS float* PO() const { unsigned char* w = ws; asm volatile("" : "+s"(w)); return (GAS float*)(w + WS_T); }
    __device__ __forceinline__ GAS float* PML() const { unsigned char* w = ws; asm volatile("" : "+s"(w)); return (GAS float*)(w + WS_PML); }
    __device__ __forceinline__ GAS float* RP() const { unsigned char* w = ws; asm volatile("" : "+s"(w)); return (GAS float*)(w + WS_RP) + (size_t)(h - 5) * S * 3 * 128; }
    __device__ __forceinline__ GAS float* RPML() const { unsigned char* w = ws; asm volatile("" : "+s"(w)); return (GAS float*)(w + WS_RPML) + (size_t)(h - 5) * S * 3 * 2; }
};
struct Seam { bf16x8 qr[8]; bf16x8 st_v0, st_v1, st_k0, st_k1; };
#define ROW(p, k0, rr) ((const GAS bf16*)((const GAS char*)(p) + (unsigned)((((k0) + (rr)) * LDQ + sc) * 2)))
#define VMW() asm volatile("s_waitcnt vmcnt(0)" ::: "memory")
#define VMWN(n) asm volatile("s_waitcnt vmcnt(%0)" :: "i"(n) : "memory")
#define SLOAD_H(Kp, Vp, k0) do { S.st_v0 = load8(ROW(Vp, k0, sr)); S.st_v1 = load8(ROW(Vp, k0, 32 + sr)); S.st_k0 = load8(ROW(Kp, k0, sr)); S.st_k1 = load8(ROW(Kp, k0, 32 + sr)); } while (0)
#define SWRITE_HK(bf) do { *(bf16x8*)(K_lds + (bf) * SHM_K + kws) = S.st_k0; *(bf16x8*)(K_lds + (bf) * SHM_K + kws + 32 * 256) = S.st_k1; } while (0)
#define SWRITE_HV(bf) do { *(bf16x8*)(V_lds + (bf) * SHM_V + vst0) = S.st_v0; *(bf16x8*)(V_lds + (bf) * SHM_V + vst1) = S.st_v1; } while (0)
#define SWRITE_H(bf) do { SWRITE_HV(bf); SWRITE_HK(bf); } while (0)
template <bool G> __device__ __forceinline__ void att_prime(const Head& H, const Seg& cur, char* lds, LAS unsigned char* lds3, Seam& S, int wave_sgpr) {
    int tid; asm volatile("v_mbcnt_lo_u32_b32 %0, -1, 0\n\tv_mbcnt_hi_u32_b32 %0, -1, %0" : "=v"(tid)); tid += wave_sgpr * 64;
    const int wid = __builtin_amdgcn_readfirstlane(tid >> 6), lane = tid & 63, r32 = lane & 31, hi = lane >> 5;
    const int sr = tid >> 4, sc = (tid & 15) * 8, kws = KSWZ(sr, sc * 2); char* K_lds = lds + 2 * SHM_V;
    const int kb0 = cur.jb * KVBLK;
    const int qrow = G ? ((const LAS int*)(lds3 + ATT_RL))[wid * QBLK + r32] : cur.P0 + wid * QBLK + r32;
#pragma unroll
    for (int d0 = 0; d0 < 8; ++d0) S.qr[d0] = load8(H.HB(0) + (size_t)qrow * LDQ + d0 * 16 + hi * 8);
    SLOAD_H(H.HB(1), H.HB(2), kb0); VMW(); SWRITE_HK(0);
    __syncthreads();
}
template <bool G> __device__ __forceinline__ void att_block(const Head& H, const Seg& cur, const Seg& nxt, char* lds, LAS unsigned char* lds3, Seam& S, int tid_in) {
    int tid; asm volatile("v_mbcnt_lo_u32_b32 %0, -1, 0\n\tv_mbcnt_hi_u32_b32 %0, -1, %0" : "=v"(tid)); tid += tid_in * 64;
    const int wid = __builtin_amdgcn_readfirstlane(tid >> 6), lane = tid & 63, r32 = lane & 31, hi = lane >> 5;
    const int NT = cur.je - cur.jb, kbn = nxt.jb * KVBLK;
    const int qlo = G ? (1 << 28) : cur.P0 + wid * QBLK, qm = qlo + r32 - 4 * hi, own = cur.P0 >> 8;
    const int tl = G ? ((const LAS int*)(lds3 + ATT_RL))[wid * QBLK + r32] : 0;
    char* V_lds = lds; char* K_lds = lds + 2 * SHM_V;
    float* ws = (float*)(lds + ATT_WS) + wid * 64; float* li_l = ws, * al_l = ws + 32;
    float m_reg = -1e30f, l_reg = 0; f32x16 o[4] = {};
    const int sr = tid >> 4, sc = (tid & 15) * 8, vst0 = v_st(sr, sc), vst1 = v_st(32 + sr, sc), kws = KSWZ(sr, sc * 2);
    const int vb0 = (int)(uintptr_t)V_lds + v_rd_base(lane);
    const GAS bf16* Kh = H.HB(1); const GAS bf16* Vh = H.HB(2); const float sl = H.sl;
    unsigned selm = 0u;
    if constexpr (!G) { f32x16 g = {};
#pragma unroll
        for (int d0 = 0; d0 < 8; ++d0) { const GAS float* kp = H.KM() + (size_t)r32 * 1024 + d0 * 16 + hi * 8; const f32x4 a = *(const GAS f32x4*)kp, b = *(const GAS f32x4*)(kp + 4);
            const bf16x8 kh = pack8(a, b); const unsigned short* khs = reinterpret_cast<const unsigned short*>(&kh);
            f32x4 ra, rb; ra[0] = a[0] - bf2f(khs[0]); ra[1] = a[1] - bf2f(khs[1]); ra[2] = a[2] - bf2f(khs[2]); ra[3] = a[3] - bf2f(khs[3]);
            rb[0] = b[0] - bf2f(khs[4]); rb[1] = b[1] - bf2f(khs[5]); rb[2] = b[2] - bf2f(khs[6]); rb[3] = b[3] - bf2f(khs[7]);
            g = __builtin_amdgcn_mfma_f32_32x32x16_bf16(kh, S.qr[d0], g, 0, 0, 0); g = __builtin_amdgcn_mfma_f32_32x32x16_bf16(pack8(ra, rb), S.qr[d0], g, 0, 0, 0); }
        const float NEG = -__builtin_inff();
#pragma unroll
        for (int k = 0; k < 3; ++k) { float bv = NEG; int bi = 64;
#pragma unroll
            for (int r = 0; r < 16; ++r) { const int n = crow(r, hi); const float v = (n < own && !((selm >> n) & 1u)) ? g[r] : NEG; if (v > bv) { bv = v; bi = n; } }
            float ov; int oi; { auto rv = __builtin_amdgcn_permlane32_swap(__float_as_uint(bv), __float_as_uint(bv), false, false); auto ri = __builtin_amdgcn_permlane32_swap((unsigned)bi, (unsigned)bi, false, false);
                ov = __uint_as_float(hi ? rv[0] : rv[1]); oi = (int)(hi ? ri[0] : ri[1]); }
            if (ov > bv || (ov == bv && oi < bi)) { bv = ov; bi = oi; }
            if (bv > NEG) selm |= 1u << bi; } }
#define RESC(a) do { if (__any((a) < 1.f)) { if (hi == 0) al_l[r32] = (a); asm volatile("s_waitcnt lgkmcnt(0)" ::: "memory");              \
                     for (int d_ = 0; d_ < 4; ++d_) for (int r = 0; r < 16; ++r) o[d_][r] *= al_l[crow(r, hi)]; } } while (0)
#define KBASE(t) ((cur.jb + (t)) * KVBLK)
#define TBASE(t) (G ? sl * (float)(KBASE(t) + 4 * hi - (tl & ~255))   : (((KBASE(t) >> 8) == own || ((selm >> (KBASE(t) >> 8)) & 1u)) ? sl * (float)(KBASE(t) - cur.P0 + 4 * hi) : -__builtin_inff()))
#define MASKT(P0_, P1_, t) do { const int kb_ = KBASE(t); if (kb_ + KVBLK - 1 > qlo) mask_tile(P0_, P1_, qm - kb_); } while (0)
#define SEAM_K0() do { if constexpr (!G) { VMWN(8); SWRITE_HK(0); } SBAR(); } while (0)
    f32x16 pA0, pA1, pB0, pB1; float mnA, mnB, alA, alB; bf16x8 pa0, pa1, pa2, pa3;
    SWRITE_HV(0); SBAR();
    if (NT > 1) SLOAD_H(Kh, Vh, KBASE(1));
    SBAR(); qkt<0>(pA0, pA1, K_lds, r32, hi, S.qr, TBASE(0), sl);
    MASKT(pA0, pA1, 0); partialSM(pA0, pA1, m_reg, mnA, alA);
    if (NT > 1) { VMW(); SWRITE_H(1); }
    __syncthreads();
#define HALF_STEP(PX0, PX1, mnX, alX, PY0, PY1, alY, t, KB, VB, SB) do {                                                      \
        SBAR(); qkt<KB>(PX0, PX1, K_lds, r32, hi, S.qr, TBASE(t), sl);                                                        \
        finishSM(PY0, PY1, alY, l_reg, pa0, pa1, pa2, pa3); SBAR();                                                           \
        if ((t) + 1 < NT) { SLOAD_H(Kh, Vh, KBASE((t) + 1)); SBAR(); }                                                        \
        pv_tile<VB>(o, vb0, pa0, pa1, pa2, pa3); MASKT(PX0, PX1, (t)); partialSM(PX0, PX1, m_reg, mnX, alX);                  \
        __syncthreads();                                                                                                      \
        if ((t) + 1 < NT) { VMW(); SWRITE_H(SB); }                                                                            \
        RESC(alX); __syncthreads(); } while (0)
    for (int t = 1; t + 1 < NT; t += 2) {
        HALF_STEP(pB0, pB1, mnB, alB, pA0, pA1, alA, t, 1, 0, 0);
        HALF_STEP(pA0, pA1, mnA, alA, pB0, pB1, alB, t + 1, 0, 1, 1);
    }
    const bool even = (NT & 1) == 0;
    if (even) { SBAR(); qkt<1>(pB0, pB1, K_lds, r32, hi, S.qr, TBASE(NT - 1), sl); SBAR(); }
    if constexpr (!G) { SLOAD_H(Kh, Vh, kbn); } SBAR();
    int r32_t = r32, hi_t = hi; asm volatile("" : "+v"(r32_t), "+v"(hi_t));
#pragma unroll
    for (int d0 = 0; d0 < 8; ++d0) if constexpr (!G) S.qr[d0] = load8(H.HB(0) + (size_t)(nxt.P0 + wid * QBLK + r32_t) * LDQ + d0 * 16 + hi_t * 8);
    SBAR();
    finishSM(pA0, pA1, alA, l_reg, pa0, pa1, pa2, pa3); SBAR();
    pv_tile<0>(o, vb0, pa0, pa1, pa2, pa3);
    if (even) { MASKT(pB0, pB1, NT - 1); partialSM(pB0, pB1, m_reg, mnB, alB); __syncthreads(); RESC(alB);
        finishSM(pB0, pB1, alB, l_reg, pa0, pa1, pa2, pa3); SBAR(); pv_tile<1>(o, vb0, pa0, pa1, pa2, pa3); }
    SBAR(); SEAM_K0();
    int hi_e = hi, r32_e = r32; asm volatile("" : "+v"(hi_e), "+v"(r32_e));
    LAS unsigned char* stg = lds3 + ATT_STG + wid * 8192;
    if constexpr (G) {
        const LAS int* rl = (const LAS int*)(lds3 + ATT_RL); const LAS int* sll = (const LAS int*)(lds3 + ATT_SL);
        GAS float* rp = H.RP();
#pragma unroll
        for (int ps = 0; ps < 2; ++ps) {
#pragma unroll
            for (int r = 0; r < 16; ++r) { LAS unsigned char* rowp = stg + crow(r, hi_e) * 256 + r32_e * 4; *(LAS float*)rowp = o[2 * ps][r]; *(LAS float*)(rowp + 128) = o[2 * ps + 1][r]; }
            asm volatile("s_waitcnt lgkmcnt(0)" ::: "memory");
#pragma unroll
            for (int i = 0; i < 8; ++i) { const int row = 4 * i + (lane >> 4), rr = wid * QBLK + row, t = rl[rr], sq = sll[rr];
                if (sq >= 0) ST16((rp + ((size_t)t * 3 + sq) * 128 + 64 * ps + 4 * (lane & 15)), *(const LAS f32x4*)(stg + row * 256 + (lane & 15) * 16)); }
            asm volatile("s_waitcnt lgkmcnt(0)" ::: "memory"); }
        if (hi_e == 0) { const int rr = wid * QBLK + r32_e, t = rl[rr], sq = sll[rr]; if (sq >= 0) { GAS float* ml = H.RPML() + ((size_t)t * 3 + sq) * 2; ml[0] = m_reg; ml[1] = l_reg; } }
    } else
    if (cur.slot < 0) {
        if (hi_e == 0) li_l[r32_e] = l_reg; asm volatile("s_waitcnt lgkmcnt(0)" ::: "memory");
        float rli[16];
#pragma unroll
        for (int r = 0; r < 16; ++r) rli[r] = __builtin_amdgcn_rcpf(li_l[crow(r, hi_e)]);
#pragma unroll
        for (int r = 0; r < 16; ++r) { LAS unsigned char* rowp = stg + crow(r, hi_e) * 256 + r32_e * 2;
#pragma unroll
            for (int d0 = 0; d0 < 4; ++d0) *(LAS bf16*)(rowp + d0 * 64) = (bf16)f2bf(o[d0][r] * rli[r]); }
        asm volatile("s_waitcnt lgkmcnt(0)" ::: "memory");
        GAS bf16* Ow = H.OB() + (size_t)(cur.P0 + wid * QBLK) * LDO;
#pragma unroll
        for (int i = 0; i < 8; ++i) { const int row = 4 * i + (lane >> 4); ST16((Ow + (size_t)row * LDO + 8 * (lane & 15)), *(const LAS u32x4*)(stg + row * 256 + (lane & 15) * 16)); }
    } else {
        GAS float* Pw = H.PO() + ((size_t)cur.slot * 256 + wid * QBLK) * DH;
#pragma unroll
        for (int ps = 0; ps < 2; ++ps) {
#pragma unroll
            for (int r = 0; r < 16; ++r) { LAS unsigned char* rowp = stg + crow(r, hi_e) * 256 + r32_e * 4; *(LAS float*)rowp = o[2 * ps][r]; *(LAS float*)(rowp + 128) = o[2 * ps + 1][r]; }
            asm volatile("s_waitcnt lgkmcnt(0)" ::: "memory");
#pragma unroll
            for (int i = 0; i < 8; ++i) { const int row = 4 * i + (lane >> 4); ST16((Pw + (size_t)row * DH + 64 * ps + 4 * (lane & 15)), *(const LAS f32x4*)(stg + row * 256 + (lane & 15) * 16)); }
            asm volatile("s_waitcnt lgkmcnt(0)" ::: "memory"); }
        if (hi_e == 0) { GAS float* ml = H.PML() + ((size_t)cur.slot * 256 + wid * QBLK + r32_e) * 2; ml[0] = m_reg; ml[1] = l_reg; }
    }
    __syncthreads();
#undef RESC
#undef KBASE
#undef TBASE
#undef MASKT
#undef SEAM_K0
#undef HALF_STEP
}
#undef ROW
#undef VMW
#undef VMWN
#undef SLOAD_H
#undef SWRITE_HK
#undef SWRITE_HV
#undef SWRITE_H
#undef KSWZ
#undef SBAR
}

constexpr float ATT_CUT = 26.f;
constexpr int ATT_BLK_COST = 2, ATT_MAXP = 8;
constexpr int ATT_NG = 99, ATT_ND = 256 - ATT_NG;
struct AttPlan { int rt, T, W, w, h, vbase; };
__device__ __forceinline__ int att_rt(const unsigned qk, int h) {
    float q2 = 0.f, k2 = 0.f;
#pragma unroll
    for (int j = 0; j < 4; ++j) { q2 += __uint_as_float(__builtin_amdgcn_readlane(qk, h * 4 + j)); k2 += __uint_as_float(__builtin_amdgcn_readlane(qk, 32 + h * 4 + j)); }
    const float B = sqrtf(q2 * k2) * mo::SCALE * 1.02f;
    const float R = (2.f * B + ATT_CUT) * exp2f((float)(h + 1));
    const float rtf = floorf((R + 63.f) * (1.0f / 64.f));
    return rtf >= 128.f ? 128 : (int)rtf;
}
__device__ __forceinline__ int att_tiles(int rt) { int t = 0; for (int b = 0; b < 32; ++b) { const int jl = 4 * b - rt; t += 4 * (b + 1) - (jl > 0 ? jl : 0); } return t; }
__device__ __forceinline__ void att_plan_write(const unsigned* qkmax, int* plan, int lane) {
    int rt[8], T[8], cum[9]; cum[0] = 0; const unsigned qk = __hip_atomic_load(qkmax + lane, __ATOMIC_RELAXED, __HIP_MEMORY_SCOPE_AGENT);
#pragma unroll
    for (int h = 0; h < 8; ++h) { rt[h] = h >= 5 ? 0 : __builtin_amdgcn_readfirstlane(att_rt(qk, h)); T[h] = att_tiles(rt[h]); cum[h + 1] = cum[h] + T[h] + 32 * ATT_BLK_COST; }
    int prev = 0;
#pragma unroll
    for (int h = 0; h < 8; ++h) { int bnd = (ATT_ND * cum[h + 1] + cum[8] / 2) / cum[8]; if (bnd <= prev) bnd = prev + 1; if (h == 7) bnd = ATT_ND;
        if (lane == 0) { __hip_atomic_store(plan + 4 * h, rt[h], RLX_AGENT); __hip_atomic_store(plan + 4 * h + 1, T[h], RLX_AGENT); __hip_atomic_store(plan + 4 * h + 2, prev, RLX_AGENT); __hip_atomic_store(plan + 4 * h + 3, bnd - prev, RLX_AGENT); }
        prev = bnd; }
}
__device__ __forceinline__ AttPlan att_plan(const int* plan, int v, int lane) {
    const int val = __hip_atomic_load(plan + (lane & 31), RLX_AGENT);
    AttPlan p; p.h = 0; p.vbase = 0; p.rt = 0; p.T = 1; p.W = 1; p.w = 0;
#pragma unroll
    for (int h = 0; h < 8; ++h) { const int rt = __builtin_amdgcn_readlane(val, 4 * h), T = __builtin_amdgcn_readlane(val, 4 * h + 1), vb = __builtin_amdgcn_readlane(val, 4 * h + 2), W = __builtin_amdgcn_readlane(val, 4 * h + 3);
        if (v >= vb && v < vb + W) { p.h = h; p.vbase = vb; p.rt = rt; p.T = T; p.W = W; p.w = v - vb; } }
    return p;
}
struct SegIter { int b, pre, lo, hi, rt, v, h;
    __device__ __forceinline__ bool next(mo::Seg& s) {
        while (b < 32) { const int jl0 = 4 * b - rt, jl = jl0 > 0 ? jl0 : 0, nb = 4 * (b + 1) - jl, pb = pre, bb = b; pre += nb; ++b;
            const int s0 = lo > pb ? lo : pb, e0 = hi < pb + nb ? hi : pb + nb;
            if (e0 > s0) { s.P0 = bb * 256; s.jb = jl + (s0 - pb); s.je = jl + (e0 - pb); s.slot = (s0 == pb && e0 == pb + nb) ? (h >= 5 ? 512 + (h - 5) * 32 + bb : -1) : (pb < lo ? 2 * v : 2 * v + 1); return true; }
            if (pb + nb >= hi) b = 32; }
        return false; }
};
__device__ __forceinline__ void m1_att_select(const Ptrs& P, int l) {
    OPAQUE_TID();
    const int u = (int)blockIdx.x - (P.G - 96); if (u < 0) return;
    const int hs = u >> 5, b = u & 31, h = 5 + hs, r32 = lane & 31, hi = lane >> 5, row = b * 256 + wave * 32 + r32;
    const GAS bf16* qp = (const GAS bf16*)P.QKVH + ((size_t)h * S + row) * 128 + hi * 8; const GAS float* km = (const GAS float*)P.KSUM + (size_t)l * 32 * 1024 + h * 128 + (size_t)r32 * 1024 + hi * 8;
    mo::f32x16 g = {};
#pragma unroll
    for (int d0 = 0; d0 < 8; ++d0) { const bf16x8 q = *(const GAS bf16x8*)(qp + d0 * 16); const f32x4 a = *(const GAS f32x4*)(km + d0 * 16), c = *(const GAS f32x4*)(km + d0 * 16 + 4);
        const bf16x8 kh = mo::pack8(a, c); const unsigned short* khs = reinterpret_cast<const unsigned short*>(&kh);
        f32x4 ra, rb; ra[0] = a[0] - bf2f(khs[0]); ra[1] = a[1] - bf2f(khs[1]); ra[2] = a[2] - bf2f(khs[2]); ra[3] = a[3] - bf2f(khs[3]);
        rb[0] = c[0] - bf2f(khs[4]); rb[1] = c[1] - bf2f(khs[5]); rb[2] = c[2] - bf2f(khs[6]); rb[3] = c[3] - bf2f(khs[7]);
        g = __builtin_amdgcn_mfma_f32_32x32x16_bf16(kh, q, g, 0, 0, 0); g = __builtin_amdgcn_mfma_f32_32x32x16_bf16(mo::pack8(ra, rb), q, g, 0, 0, 0); }
    unsigned selm = 0u; const float NEG = -__builtin_inff();
#pragma unroll
    for (int k = 0; k < 3; ++k) { float bv = NEG; int bi = 64;
#pragma unroll
        for (int r = 0; r < 16; ++r) { const int n = mo::crow(r, hi); const float v = (n < b && !((selm >> n) & 1u)) ? g[r] : NEG; if (v > bv) { bv = v; bi = n; } }
        float ov; int oi; { auto rv = __builtin_amdgcn_permlane32_swap(__float_as_uint(bv), __float_as_uint(bv), false, false); auto ri = __builtin_amdgcn_permlane32_swap((unsigned)bi, (unsigned)bi, false, false);
            ov = __uint_as_float(hi ? rv[0] : rv[1]); oi = (int)(hi ? ri[0] : ri[1]); }
        if (ov > bv || (ov == bv && oi < bi)) { bv = ov; bi = oi; }
        if (bv > NEG) selm |= 1u << bi; }
    if (hi == 0) P.SEL[hs * S + row] = selm;
    int mine = 0;
    for (int n = 0; n < 31; ++n) { const int c = __popcll(__ballot(hi == 0 && ((selm >> n) & 1u))); if (lane == n) mine = c; }
    if (lane < 31 && mine) { atomicAdd(P.SELCNT + (l * 3 + hs) * 32 + lane, mine); atomicAdd(P.BCNT + ((l * 3 + hs) * 32 + lane) * 32 + b, mine); }
}
__device__ __forceinline__ void att_rowlist(const Ptrs& P, LAS unsigned char* lds3, int l, int hs, int n, int j, int tid) {
    const int lane = tid & 63, wave = tid >> 6;
    LAS int* rl = (LAS int*)(lds3 + mo::ATT_RL); LAS int* sll = (LAS int*)(lds3 + mo::ATT_SL); LAS int* wtot = (LAS int*)(lds3 + mo::ATT_WS);
    if (tid < 256) { rl[tid] = S - 1; sll[tid] = -1; }
    const int bc = __hip_atomic_load(P.BCNT + ((l * 3 + hs) * 32 + n) * 32 + (lane & 31), RLX_AGENT);
    int pre = 0, b0 = -1, b1 = 0, skip = 0;
    for (int bq = 0; bq < 32; ++bq) { const int c = __builtin_amdgcn_readlane(bc, bq); const int lo = pre, hi = pre + c; pre = hi;
        if (c > 0 && hi > 256 * j && lo < 256 * j + 256) { if (b0 < 0) { b0 = bq; skip = lo; } b1 = bq + 1; } }
    if (b0 < 0) { b0 = 31; b1 = 32; skip = 0; }
    const int base = 256 * b0, R = 256 * (b1 - b0), per = (R + 511) / 512;
    const GAS char* selp = (const GAS char*)((const GAS unsigned*)P.SEL + hs * S);
#define SELLD(r_) (*(const GAS unsigned*)(selp + (unsigned)(((r_) < S ? (r_) : S - 1) * 4)))
    int cnt = 0;
#pragma unroll 4
    for (int i = 0; i < 16; ++i) { const int r = base + tid * per + i; const unsigned x = SELLD(r); cnt += (i < per && tid * per + i < R) ? ((x >> n) & 1u) : 0u; }
    int inc = cnt;
#pragma unroll
    for (int o = 1; o < 64; o <<= 1) { const int t = __builtin_amdgcn_ds_bpermute(((lane - o) & 63) << 2, inc); if (lane >= o) inc += t; }
    if (lane == 63) wtot[wave] = inc;
    __syncthreads();
    int woff = 0;
#pragma unroll
    for (int w = 0; w < 8; ++w) { const int a = wtot[w]; if (w < wave) woff += a; }
    int rank = skip + woff + inc - cnt - 256 * j;
    int tid2 = tid; asm volatile("" : "+v"(tid2));
#pragma unroll 4
    for (int i = 0; i < 16; ++i) { const int r = base + tid2 * per + i; const unsigned x = SELLD(r);
        if (i < per && tid2 * per + i < R && ((x >> n) & 1u)) { if (rank >= 0 && rank < 256) { rl[rank] = r; sll[rank] = __popc(x & ((1u << n) - 1u)); } ++rank; } }
    __syncthreads();
#undef SELLD
}
__device__ __forceinline__ void m2_attn(const Ptrs& P, char* lds, LAS unsigned char* lds3, int l) {
    { const int v0 = blockIdx.x; if (v0 >= 256) return;
        const int v = (v0 & 7) * 32 + (v0 >> 3);
        int lane_p_; asm volatile("v_mbcnt_lo_u32_b32 %0, -1, 0\n\tv_mbcnt_hi_u32_b32 %0, -1, %0" : "=v"(lane_p_));
        if (v >= ATT_ND) {
            const int g = v - ATT_ND;
            LAS int* cntl = (LAS int*)(lds3 + RING_BYTES + 6144);
            { const int c0 = __hip_atomic_load(P.SELCNT + l * 96 + lane_p_, RLX_AGENT), c1 = __hip_atomic_load(P.SELCNT + l * 96 + 64 + (lane_p_ & 31), RLX_AGENT);
              if (P.wv == 0) { cntl[lane_p_] = c0; if (lane_p_ < 32) cntl[64 + lane_p_] = c1; } }
            __syncthreads();
            int ui = 0;
            for (int e = 0; e < 96; ++e) { if ((e & 31) == 31) continue; const int c = __builtin_amdgcn_readfirstlane(cntl[e]); const int nu = (c + 255) >> 8;
                int j = (g - ui % ATT_NG + ATT_NG) % ATT_NG;
                for (; j < nu; j += ATT_NG) {
                    const int hs = e >> 5, n = e & 31;
                    att_rowlist(P, lds3, l, hs, n, j, P.wv * 64 + lane_p_);
                    mo::Head H; H.ws = P.ws; H.h = 5 + hs; H.l = l; H.sl = exp2f(-(float)(6 + hs)) * (1.0f / mo::SCALE);
                    mo::Seg sg; sg.P0 = 0; sg.jb = 4 * n; sg.je = 4 * n + 4; sg.slot = 0;
                    mo::Seam Sm;
                    mo::att_prime<true>(H, sg, lds, lds3, Sm, P.wv);
                    mo::att_block<true>(H, sg, sg, lds, lds3, Sm, P.wv); }
                ui += nu; }
            return; }
        const AttPlan pl = att_plan(P.PLAN + l * 32, v, lane_p_); const int h = pl.h;
        mo::Head H; H.ws = P.ws; H.h = h; H.l = l; H.sl = exp2f(-(float)(h + 1)) * (1.0f / mo::SCALE);
        SegIter it; it.b = 0; it.pre = 0; it.lo = (pl.w * pl.T) / pl.W; it.hi = ((pl.w + 1) * pl.T) / pl.W; it.rt = pl.rt; it.v = v; it.h = h;
        mo::Seg cur, nxt; if (!it.next(cur)) return;
        bool more = it.next(nxt);
        mo::Seam Sm;
        mo::att_prime<false>(H, cur, lds, lds3, Sm, P.wv);
        for (;;) { const mo::Seg nx = more ? nxt : cur; mo::att_block<false>(H, cur, nx, lds, lds3, Sm, P.wv); if (!more) break; cur = nxt; more = it.next(nxt); }
    }
}
__device__ __forceinline__ void m3_attn_merge(const Ptrs& P, int l) {
    OPAQUE_TID();
    constexpr float C2 = 1.4426950408889634f * mo::SCALE;
    for (int s = blockIdx.x; s < 1024; s += P.G) { const int hb = s < 384 ? 160 + (s >> 2) : ((s - 384) >> 2), qt = s & 3; const int h = hb >> 5, b = hb & 31;
        int rt = 0, T = 1, W = 1, vbase = 0;
        { const int val = __hip_atomic_load(P.PLAN + l * 32 + (lane & 31), RLX_AGENT);
#pragma unroll
            for (int hh = 0; hh < 8; ++hh) if (hh == h) { rt = __builtin_amdgcn_readlane(val, 4 * hh); T = __builtin_amdgcn_readlane(val, 4 * hh + 1); vbase = __builtin_amdgcn_readlane(val, 4 * hh + 2); W = __builtin_amdgcn_readlane(val, 4 * hh + 3); } }
        int pb = 0; for (int bb = 0; bb < b; ++bb) { const int jl = 4 * bb - rt; pb += 4 * (bb + 1) - (jl > 0 ? jl : 0); }
        const int jl0 = 4 * b - rt, nb = 4 * (b + 1) - (jl0 > 0 ? jl0 : 0);
        int w1 = (pb * W) / T; while (w1 > 0 && (w1 * T) / W > pb) --w1; while (((w1 + 1) * T) / W <= pb) ++w1;
        const bool whole = (w1 * T) / W <= pb && ((w1 + 1) * T) / W >= pb + nb;
        if (whole && h < 5) continue;
        int slots[ATT_MAXP]; int np = 0;
#pragma unroll
        for (int k = 0; k < ATT_MAXP; ++k) { const int w = w1 + k, lo = (w * T) / W; const bool on = w < W && lo < pb + nb; slots[k] = on ? ((pb < lo) ? 2 * (vbase + w) : 2 * (vbase + w) + 1) : 0; np += on ? 1 : 0; }
        if (whole) { slots[0] = 512 + (h - 5) * 32 + b; np = 1; }
        const int c8 = (tid & 15) * 8, rbase = 64 * qt + (tid >> 4);
        if (np <= 2) {
            const bool two = np == 2, gath = h >= 5; const int s0 = slots[0], s1 = two ? slots[1] : slots[0];
            f32x2v mlA[2], mlB[2]; f32x4 oA[2][2], oB[2][2]; f32x2v gml[2][3]; f32x4 go[2][3][2]; unsigned selw[2] = {0u, 0u};
#pragma unroll
            for (int r = 0; r < 2; ++r) { const int row = rbase + 32 * r;
                mlA[r] = *(const GAS f32x2v*)((const GAS float*)P.PML + ((size_t)s0 * 256 + row) * 2); mlB[r] = *(const GAS f32x2v*)((const GAS float*)P.PML + ((size_t)s1 * 256 + row) * 2);
                const GAS float* o0 = (const GAS float*)P.T + ((size_t)s0 * 256 + row) * 128 + c8; const GAS float* o1 = (const GAS float*)P.T + ((size_t)s1 * 256 + row) * 128 + c8;
                oA[r][0] = *(const GAS f32x4*)o0; oA[r][1] = *(const GAS f32x4*)(o0 + 4); oB[r][0] = *(const GAS f32x4*)o1; oB[r][1] = *(const GAS f32x4*)(o1 + 4); }
            if (gath) {
#pragma unroll
                for (int r = 0; r < 2; ++r) { const int qrow = b * 256 + rbase + 32 * r; selw[r] = ((const GAS unsigned*)P.SEL)[(h - 5) * S + qrow];
                    const GAS float* gp = (const GAS float*)P.RPML + ((size_t)(h - 5) * S + qrow) * 6; const GAS float* rp = (const GAS float*)P.RP + ((size_t)(h - 5) * S + qrow) * 384 + c8;
#pragma unroll
                    for (int k = 0; k < 3; ++k) { gml[r][k] = *(const GAS f32x2v*)(gp + 2 * k); go[r][k][0] = *(const GAS f32x4*)(rp + k * 128); go[r][k][1] = *(const GAS f32x4*)(rp + k * 128 + 4); } } }
#pragma unroll
            for (int r = 0; r < 2; ++r) { const int row = rbase + 32 * r; const int ng = gath ? __popc(selw[r]) : 0;
                float M = mlA[r].x; if (two) M = fmaxf(M, mlB[r].x);
                if (gath) {
#pragma unroll
                    for (int k = 0; k < 3; ++k) M = fmaxf(M, k < ng ? gml[r][k].x : -3.0e38f); }
                const float wA = __builtin_amdgcn_exp2f((mlA[r].x - M) * C2), wB = two ? __builtin_amdgcn_exp2f((mlB[r].x - M) * C2) : 0.f;
                float den = wA * mlA[r].y + wB * mlB[r].y; f32x4 a0 = oA[r][0] * wA + oB[r][0] * wB, a1 = oA[r][1] * wA + oB[r][1] * wB;
                if (gath) {
#pragma unroll
                    for (int k = 0; k < 3; ++k) { const float wgt = k < ng ? __builtin_amdgcn_exp2f((gml[r][k].x - M) * C2) : 0.f; den += wgt * (k < ng ? gml[r][k].y : 0.f);
                        a0 += (k < ng ? go[r][k][0] : f32x4{0.f, 0.f, 0.f, 0.f}) * wgt; a1 += (k < ng ? go[r][k][1] : f32x4{0.f, 0.f, 0.f, 0.f}) * wgt; } }
                const float inv = 1.0f / den; a0 = a0 * inv; a1 = a1 * inv;
                v4u wv; wv.x = pk2(a0.x, a0.y); wv.y = pk2(a0.z, a0.w); wv.z = pk2(a1.x, a1.y); wv.w = pk2(a1.z, a1.w);
                ST16P((P.A3 + (size_t)(b * 256 + row) * 1024 + h * 128 + c8), wv); }
            continue;
        }
        for (int rr = 0; rr < 2; ++rr) { const int row = rbase + 32 * rr;
            float m[ATT_MAXP], lsum[ATT_MAXP]; float M = -3.0e38f;
#pragma unroll
            for (int k = 0; k < ATT_MAXP; ++k) if (k < np) { const float* ml = P.PML + ((size_t)slots[k] * 256 + row) * 2; m[k] = ml[0]; lsum[k] = ml[1]; M = fmaxf(M, m[k]); }
            f32x4 a0 = {0.f, 0.f, 0.f, 0.f}, a1 = a0; float den = 0.f;
#pragma unroll
            for (int k = 0; k < ATT_MAXP; ++k) if (k < np) { const float wgt = __builtin_amdgcn_exp2f((m[k] - M) * C2); den += wgt * lsum[k];
                const float* o = P.T + ((size_t)slots[k] * 256 + row) * 128 + c8; a0 += *(const f32x4*)o * wgt; a1 += *(const f32x4*)(o + 4) * wgt; }
            const float inv = 1.0f / den; a0 = a0 * inv; a1 = a1 * inv;
            v4u wv; wv.x = pk2(a0.x, a0.y); wv.y = pk2(a0.z, a0.w); wv.z = pk2(a1.x, a1.y); wv.w = pk2(a1.z, a1.w);
            ST16P((P.A3 + (size_t)(b * 256 + row) * 1024 + h * 128 + c8), wv); }
    }
}
__device__ __forceinline__ void m3_gla_out(const Ptrs& P, LAS unsigned char* lds, int l) {
    OPAQUE_TID();
    LAS float* bcum = (LAS float*)lds; LAS unsigned char* QI = lds + 32768; LAS unsigned char* KI = lds + 50176; LAS unsigned char* VL = lds + 67584; LAS unsigned char* XS = lds + 104448; LAS float* tot = (LAS float*)(lds + 113664);
    LAS unsigned char* OL = lds;
    const int hl = lane >> 5, fc = tid >> 3, fpart = tid & 7;
    f32x4 gw[8]; { const GAS f32x4* gp = (const GAS f32x4*)(P.gla_norm_w + l * 256 + 32 * fpart);
#pragma unroll
        for (int j = 0; j < 8; ++j) gw[j] = gp[j]; }
    for (int unit = blockIdx.x; unit < 512; unit += P.G) { const int h = unit >> 7, n = unit & 127, t0 = n * 64;

        float la[16]; { const GAS float* p = (const GAS float*)P.LA + (size_t)(t0 + 16 * (tid >> 7)) * 512 + h * 128 + (tid & 127);
#pragma unroll
            for (int i = 0; i < 16; ++i) la[i] = p[(size_t)i * 512]; }
        v4u qq[2], kq[2], vv[4], rv[4]; bf16x8 spf[8];
#pragma unroll
        for (int i = 0; i < 2; ++i) { const int idx = tid + 512 * i, s = idx >> 4, ch = idx & 15; const GAS bf16* pr = (const GAS bf16*)P.PROJ + (size_t)(t0 + s) * LDP + h * 128 + 8 * ch;
            qq[i] = *(const GAS v4u*)(pr + PC_QG); kq[i] = *(const GAS v4u*)(pr + PC_KG); }
#pragma unroll
        for (int j = 0; j < 4; ++j) { const int idx = tid + 512 * j, s = idx >> 5, ch = idx & 31; vv[j] = *(const GAS v4u*)((const GAS bf16*)P.PROJ + (size_t)(t0 + s) * LDP + PC_VG + h * 256 + 8 * ch); }
        { const GAS bf16* spt = (const GAS bf16*)P.SPT + ((size_t)(h * 128 + n) * 256 + 32 * wave + (lane & 31)) * 128 + 8 * hl;
#pragma unroll
            for (int kk = 0; kk < 8; ++kk) spf[kk] = *(const GAS bf16x8*)(spt + 16 * kk); }
        { const GAS bf16* rp = (const GAS bf16*)P.PROJ + (size_t)(t0 + fc) * LDP + PC_RG + h * 256 + 32 * fpart;
#pragma unroll
            for (int j = 0; j < 4; ++j) rv[j] = *(const GAS v4u*)(rp + 8 * j); }
        gla_cumsum(la, tid, tot, bcum);

#pragma unroll
        for (int i = 0; i < 2; ++i) { const int idx = tid + 512 * i, s = idx >> 4, ch = idx & 15;
            const f32x4 b0 = *(const LAS f32x4*)(bcum + s * 128 + 8 * ch), b1 = *(const LAS f32x4*)(bcum + s * 128 + 8 * ch + 4);
            const float bb[8] = {b0.x, b0.y, b0.z, b0.w, b1.x, b1.y, b1.z, b1.w}; float q[8], k[8], qi[8], ki[8]; unpack8(qq[i], q); unpack8(kq[i], k);
#pragma unroll
            for (int j = 0; j < 8; ++j) { qi[j] = q[j] * 0.08838834764831845f * __expf(bb[j]); ki[j] = k[j] * __expf(-bb[j]); }
            v4u w; w.x = pk2(qi[0], qi[1]); w.y = pk2(qi[2], qi[3]); w.z = pk2(qi[4], qi[5]); w.w = pk2(qi[6], qi[7]); *(LAS v4u*)(QI + s * GL_QK_STRIDE + ch * 16) = w;
            w.x = pk2(ki[0], ki[1]); w.y = pk2(ki[2], ki[3]); w.z = pk2(ki[4], ki[5]); w.w = pk2(ki[6], ki[7]); *(LAS v4u*)(KI + s * GL_QK_STRIDE + ch * 16) = w; }
#pragma unroll
        for (int j = 0; j < 4; ++j) { const int idx = tid + 512 * j, s = idx >> 5, ch = idx & 31; *(LAS v4u*)(VL + s * GL_VL_STRIDE + ch * 16) = vv[j]; }
        __syncthreads();

        if (wave < 3) {
            const int ct = wave > 0 ? 1 : 0, st = wave > 1 ? 1 : 0; f32x16 x;
#pragma unroll
            for (int r = 0; r < 16; ++r) x[r] = 0.f;
#pragma unroll
            for (int kk = 0; kk < 8; ++kk) x = __builtin_amdgcn_mfma_f32_32x32x16_bf16(row_frag(QI, GL_QK_STRIDE, 32 * ct, 16 * kk, lane), row_frag(KI, GL_QK_STRIDE, 32 * st, 16 * kk, lane), x, 0, 0, 0);
#pragma unroll
            for (int r = 0; r < 16; ++r) { const int c = 32 * ct + crow(r, hl), sidx = 32 * st + (lane & 31); *(LAS bf16*)(XS + c * GL_XS_STRIDE + sidx * 2) = (bf16)f2bf(sidx <= c ? x[r] : 0.f); }
        } else if (wave == 3) {
#pragma unroll
            for (int r = 0; r < 16; ++r) *(LAS bf16*)(XS + crow(r, hl) * GL_XS_STRIDE + (32 + (lane & 31)) * 2) = (bf16)0;
        }
        f32x16 acc0, acc1;
#pragma unroll
        for (int r = 0; r < 16; ++r) { acc0[r] = 0.f; acc1[r] = 0.f; }
#pragma unroll
        for (int kk = 0; kk < 8; ++kk) {
            acc0 = __builtin_amdgcn_mfma_f32_32x32x16_bf16(row_frag(QI, GL_QK_STRIDE, 0, 16 * kk, lane), spf[kk], acc0, 0, 0, 0);
            acc1 = __builtin_amdgcn_mfma_f32_32x32x16_bf16(row_frag(QI, GL_QK_STRIDE, 32, 16 * kk, lane), spf[kk], acc1, 0, 0, 0); }
        __syncthreads();
#pragma unroll
        for (int ks = 0; ks < 4; ++ks) { const bf16x8 bfr = tr_frag(VL, GL_VL_STRIDE, 16 * ks, 32 * wave, lane);
            acc0 = __builtin_amdgcn_mfma_f32_32x32x16_bf16(row_frag(XS, GL_XS_STRIDE, 0, 16 * ks, lane), bfr, acc0, 0, 0, 0);
            acc1 = __builtin_amdgcn_mfma_f32_32x32x16_bf16(row_frag(XS, GL_XS_STRIDE, 32, 16 * ks, lane), bfr, acc1, 0, 0, 0); }
        __syncthreads();

#pragma unroll
        for (int r = 0; r < 16; ++r) { *(LAS float*)(OL + crow(r, hl) * GL_OL_STRIDE + (32 * wave + (lane & 31)) * 4) = acc0[r]; *(LAS float*)(OL + (32 + crow(r, hl)) * GL_OL_STRIDE + (32 * wave + (lane & 31)) * 4) = acc1[r]; }
        __syncthreads();
        { const int row = t0 + fc; float o[32]; float ss = 0.f;
#pragma unroll
            for (int j = 0; j < 8; ++j) { const f32x4 v = *(const LAS f32x4*)(OL + fc * GL_OL_STRIDE + (32 * fpart + 4 * j) * 4); o[4 * j] = v.x; o[4 * j + 1] = v.y; o[4 * j + 2] = v.z; o[4 * j + 3] = v.w; ss += (v.x * v.x + v.y * v.y) + (v.z * v.z + v.w * v.w); }
            ss += xshfl<1>(ss); ss += xshfl<2>(ss); ss += xshfl<4>(ss);
            const float inv = rsqrtf(ss * (1.0f / 256.0f) + RMS_EPS);
            GAS bf16* op = (GAS bf16*)P.A3 + (size_t)S * 1024 + (size_t)row * 1024 + h * 256 + 32 * fpart;
#pragma unroll
            for (int j = 0; j < 4; ++j) { float r[8], y[8]; unpack8(rv[j], r); const f32x4 g0 = gw[2 * j], g1 = gw[2 * j + 1]; const float gg[8] = {g0.x, g0.y, g0.z, g0.w, g1.x, g1.y, g1.z, g1.w};
#pragma unroll
                for (int bq = 0; bq < 8; ++bq) y[bq] = o[8 * j + bq] * inv * gg[bq] * (r[bq] / (1.0f + __expf(-r[bq])));
                v4u w; w.x = pk2(y[0], y[1]); w.y = pk2(y[2], y[3]); w.z = pk2(y[4], y[5]); w.w = pk2(y[6], y[7]);
                ST16((op + 8 * j), w); } }
        __syncthreads();

    }
}

__global__ void __launch_bounds__(NWAVES * 64, 2) mk_fwd(Args args) {
    extern __shared__ __attribute__((aligned(16))) unsigned char lds_raw[];
    LAS unsigned char* lds = (LAS unsigned char*)lds_raw;
    const int wv = __builtin_amdgcn_readfirstlane((int)threadIdx.x >> 6);
#define LOAD_PTRS() Ptrs P; do { KPTR kp_ = (KPTR)__builtin_amdgcn_kernarg_segment_ptr(); asm volatile("" : "+s"(kp_)); fill_ptrs(P, kp_, wv); } while (0)
    for (int u = threadIdx.x; u < (LDS_BYTES - LDSCTL_OFF) / 4; u += NWAVES * 64) ((LAS unsigned*)(lds + LDSCTL_OFF))[u] = 0u;
    __syncthreads();
    const int lo = args.ph_lo, hi = args.ph_hi;
    unsigned* barw = (unsigned*)(args.ws + WS_CTL) + CW_BAR + args.li * XCD_BAR_WORDS;
    XcdBarrier bar; bar.bar = barw; bar.x = 0; bar.st = nullptr;
    if (hi - lo > 1) bar = xcd_barrier_post(barw, (volatile LAS unsigned*)(lds + MISC_OFF) + 8);
#define IN(k) (lo <= (k) && (k) < hi)
#define SEAM(k) do { if ((k) + 1 < hi) { int l0_; asm volatile("v_mbcnt_lo_u32_b32 %0, -1, 0\n\tv_mbcnt_hi_u32_b32 %0, -1, %0" : "=v"(l0_)); xcd_barrier(bar, wv == 0 && l0_ == 0); } } while (0)
 if (IN(0)) { LOAD_PTRS(); p0_prologue(P, lds); SEAM(0); }
    for (int l = 0; l < NL; ++l) {
        const int pb = 1 + 8 * l;

        if (IN(pb + 0)) {
            LOAD_PTRS(); unsigned char* wl = P.ws + WS_W + (size_t)l * WL_BYTES;
            pg8::Gemm g{P.XB, (const bf16*)(wl + WL_IN), S, NPROJ, D}; pg8::StaticOrder So; So.init(S, NPROJ, P.G, (int)blockIdx.x);
            EpiProj E{P.PROJ, P.QKVH, P.LA, P.stats + (size_t)(2 * l) * S, P.gla_b + l * 512, P.KSUM + (size_t)l * 32 * 1024, P.QKMAX + l * 64};
            pg8::gemm_phase<EpiProj, pg8::StaticOrder, true, true>(lds, g, So, E, P.wv);
            if (l + 1 < NL && (int)blockIdx.x >= 192) convert_items(P, lds, R_T1, l + 1, 0, 1, 0, 0, 0, (int)blockIdx.x - 192, 64);
            SEAM(pb + 0); }

        if (IN(pb + 1)) { LOAD_PTRS(); { m1_att_select(P, l); m1_kmean_conv(P, l);  m1_gla_local(P, lds); } SEAM(pb + 1); }

        if (IN(pb + 2)) { LOAD_PTRS(); m2_gla_scan(P);  m2_attn(P, (char*)lds_raw, lds, l);  SEAM(pb + 2); }

        if (IN(pb + 3)) { LOAD_PTRS(); { m3_attn_merge(P, l);  m3_gla_out(P, lds, l); } SEAM(pb + 3); }

        if (IN(pb + 4)) {
            LOAD_PTRS(); unsigned char* wl = P.ws + WS_W + (size_t)l * WL_BYTES;
            pg8::Gemm g{P.A3, (const bf16*)(wl + WL_BR), 3 * S, 3 * D, 1024}; BranchOrder Bo; Bo.so.init(S, D, P.G, (int)blockIdx.x);
            EpiBranch E{P.PROJ, P.MIXED};
            pg8::gemm_phase<EpiBranch, BranchOrder, true, true>(lds, g, Bo, E, P.wv);
            SEAM(pb + 4); }

        if (IN(pb + 5)) {
            LOAD_PTRS(); unsigned char* wl = P.ws + WS_W + (size_t)l * WL_BYTES;
            pg8::Gemm g{P.MIXED, (const bf16*)(wl + WL_OUT), S, D, D}; pg8::StaticOrder So; So.init(S, D, P.G, (int)blockIdx.x);
            EpiResid E{P.XB, P.stats + (size_t)(2 * l + 1) * S};
            pg8::gemm_phase<EpiResid, pg8::StaticOrder, true, true>(lds, g, So, E, P.wv);
            SEAM(pb + 5); }

        if (IN(pb + 6)) {
            LOAD_PTRS(); unsigned char* wl = P.ws + WS_W + (size_t)l * WL_BYTES;
            pg8::Gemm g{P.XB, (const bf16*)(wl + WL_GU), S, 2 * DFF, D}; pg8::StaticOrder So; So.init(S, 2 * DFF, P.G, (int)blockIdx.x);
            EpiGU E{P.ACT, P.stats + (size_t)(2 * l + 1) * S};
            pg8::gemm_phase<EpiGU, pg8::StaticOrder, true, true>(lds, g, So, E, P.wv);
            if (l + 1 < NL && (int)blockIdx.x >= 128) convert_items(P, lds, R_TAIL - R_T1, l + 1, R_T1, 1, 0, 0, 0, (int)blockIdx.x - 128, 128);
            SEAM(pb + 6); }

        if (IN(pb + 7)) {
            LOAD_PTRS(); unsigned char* wl = P.ws + WS_W + (size_t)l * WL_BYTES;
            pg8::Gemm g{P.ACT, (const bf16*)(wl + WL_DN), S, D, DFF}; pg8::StaticOrder So; So.init(S, D, P.G, (int)blockIdx.x);
            EpiResid E{P.XB, P.stats + (size_t)(2 * l + 2) * S};
            pg8::gemm_phase<EpiResid, pg8::StaticOrder, true, true>(lds, g, So, E, P.wv);
            SEAM(pb + 7); }

    }
    if (IN(NPH - 1)) { LOAD_PTRS(); final_norm(P); }
#undef IN
#undef SEAM
}

#ifndef MK_SPLIT
#define MK_SPLIT 0
#endif
extern "C" void kernel_launch(void* const* d_in, const int* in_sizes, int n_in, void* d_out, int out_size, void* d_ws, size_t ws_size, hipStream_t stream) {
    static int grid = 0;
    if (grid == 0) {
        if (n_in != 16 || out_size != S * D || ws_size < WS_END) { fprintf(stderr, "kernel_launch: unexpected shapes (n_in %d out %d ws %zu)\n", n_in, out_size, ws_size); grid = -1; return; }
        int dev = 0, cus = 0, per_cu = 0;
        if (hipGetDevice(&dev) != hipSuccess || hipDeviceGetAttribute(&cus, hipDeviceAttributeMultiprocessorCount, dev) != hipSuccess) { grid = -1; return; }
        if (hipFuncSetAttribute((const void*)mk_fwd, hipFuncAttributeMaxDynamicSharedMemorySize, LDS_BYTES) != hipSuccess) { fprintf(stderr, "kernel_launch: hipFuncSetAttribute failed\n"); grid = -1; return; }
        if (hipOccupancyMaxActiveBlocksPerMultiprocessor(&per_cu, (const void*)mk_fwd, NWAVES * 64, LDS_BYTES) != hipSuccess || per_cu < 1) fprintf(stderr, "kernel_launch: occupancy query says %d\n", per_cu);
        (void)hipGetLastError();
        grid = cus;
        if (cus != 256) { fprintf(stderr, "kernel_launch: built for 256 CUs, found %d\n", cus); grid = -1; return; }
    }
    if (grid < 0) return;
    if (hipMemsetAsync((char*)d_ws + WS_CTL, 0, CTL_ZERO_BYTES, stream) != hipSuccess) return;
    Args a{};
    for (int i = 0; i < 16; ++i) a.in[i] = (const float*)d_in[i];
    a.out = (float*)d_out; a.ws = (unsigned char*)d_ws; a.pad = 0;
#if MK_SPLIT
    for (int p = 0; p < NPH; ++p) { a.ph_lo = p; a.ph_hi = p + 1; a.li = 0; hipLaunchKernelGGL(mk_fwd, dim3(grid), dim3(NWAVES * 64), LDS_BYTES, stream, a); }
#else
    a.ph_lo = 0; a.ph_hi = NPH; a.li = 0;
    hipLaunchKernelGGL(mk_fwd, dim3(grid), dim3(NWAVES * 64), LDS_BYTES, stream, a);
#endif
}
```

```cpp
#include <hip/hip_runtime.h>
#include <cstdio>
#include <cstdint>
#include <cmath>
namespace pg8 {
#define PG8_LAS __attribute__((address_space(3)))
typedef unsigned short bf16_t;
typedef short bf16x8 __attribute__((ext_vector_type(8)));
typedef float f32x4 __attribute__((ext_vector_type(4)));
typedef unsigned u32x4 __attribute__((ext_vector_type(4)));
constexpr int BM = 256, BK = 64, HALF = 128, HTB = HALF * BK * 2  , STAGE_BYTES = 8 * HTB, NXCD = 8, WGM = 8;

__host__ __device__ __forceinline__ int lds_byte(int r, int c) { const int st = (r >> 4) * 2 + (c >> 5), rr = r & 15, cc = c & 31, ob = rr * 64 + cc * 2; return st * 1024 + (ob ^ (((ob >> 9) & 1) << 5)); }
__host__ __device__ __forceinline__ void stage_rc(int b, int& R, int& C) { const int st = b / 1024, sb = b % 1024, swz = sb ^ (((sb >> 9) & 1) << 5); R = (st >> 1) * 16 + swz / 64; C = (st & 1) * 32 + (swz % 64) / 2; }
__host__ __device__ __forceinline__ int perm32(int rho) { const int n = rho >> 4, i = rho & 15; return 8 * (i >> 2) + 4 * n + (i & 3); }

struct Unit { int pm, pn; };
struct Gemm { const bf16_t* A; const bf16_t* Bt; int M, N, K; };

struct StaticOrder {
    int nM, nN, nwg, G, c;
    __host__ __device__ void init(int M, int N, int G_, int c_) { nM = M / BM; nN = N / BM; nwg = nM * nN; G = G_; c = c_; }
    __host__ __device__ bool next(int i, Unit& u) const {
        const long L = (long)i * G + c; if (L >= nwg) return false;
        int wgid = (int)L; { const int q = nwg / NXCD, r = nwg % NXCD, xcd = wgid % NXCD, off = wgid / NXCD; wgid = (xcd < r ? xcd * (q + 1) : r * (q + 1) + (xcd - r) * q) + off; }
        const int nig = WGM * nN, gid = wgid / nig, fm = gid * WGM, gsz = (nM - fm) < WGM ? (nM - fm) : WGM;
        u.pm = fm + ((wgid % nig) % gsz); u.pn = (wgid % nig) / gsz; return true;
    }
    __device__ __forceinline__ void a_ready(const Unit&) const {}
    __device__ __forceinline__ void done(const Unit&) const {}
};

__device__ __forceinline__ unsigned cvt_pk_bf16(float lo, float hi) { unsigned r; asm volatile("v_cvt_pk_bf16_f32 %0, %1, %2" : "=v"(r) : "v"(lo), "v"(hi)); return r; }
template <class Epi, class Sched, bool ALIGN_EPI = false, bool SP2 = false>
__device__ __forceinline__ void gemm_phase(PG8_LAS unsigned char* lds, const Gemm g, const Sched& S, const Epi& E, int wave_sgpr) {
    int tid_; asm volatile("v_mbcnt_lo_u32_b32 %0, -1, 0\n\tv_mbcnt_hi_u32_b32 %0, -1, %0" : "=v"(tid_)); tid_ += wave_sgpr * 64;
    const int tid = tid_, wid = __builtin_amdgcn_readfirstlane(tid >> 6), lane = tid & 63, wr = wid >> 2, wc = wid & 3, fr = lane & 15, fq = lane >> 4;
    const int K = g.K, nt = K / BK;
    unsigned voffA[2], voffB[2];
#pragma unroll
    for (int i = 0; i < 2; ++i) { int R, C; stage_rc(tid * 16 + i * 8192, R, C); const int Rb = Epi::PERM ? ((R & ~31) + perm32(R & 31)) : R;
        voffA[i] = (unsigned)(R * K + C) * 2u; voffB[i] = (unsigned)(Rb * K + C) * 2u; }
    const size_t kstep = (size_t)(BK * 2);
    const size_t hstep = (size_t)HALF * K * 2;
    const size_t tstep = 2 * hstep;
    const unsigned ldsw = (unsigned)wid * 1024u;
    const int aoff = lds_byte(wr * 64 + fr, fq * 8), boff = lds_byte(wc * 32 + fr, fq * 8);
#define PG8_SA(b, h) (((b) * 2 + (h)) * HTB)
#define PG8_SB(b, h) ((4 + (b) * 2 + (h)) * HTB)
#define PG8_STAGE(bufoff, gbase, voff) do { _Pragma("unroll") for (int _i = 0; _i < 2; ++_i) \
        __builtin_amdgcn_global_load_lds((const unsigned*)((const char*)(gbase) + (voff)[_i]), (PG8_LAS unsigned*)(lds + (bufoff) + ldsw + _i * 8192), 16, 0, 0); } while (0)
#define PG8_LDA(dst, b, h) do { _Pragma("unroll") for (int m = 0; m < 4; ++m) _Pragma("unroll") for (int k = 0; k < 2; ++k) dst[m][k] = *(const PG8_LAS bf16x8*)(lds + PG8_SA(b, h) + aoff + m * 2048 + k * 1024); } while (0)
#define PG8_LDB(dst, b, h) do { _Pragma("unroll") for (int n = 0; n < 2; ++n) _Pragma("unroll") for (int k = 0; k < 2; ++k) dst[n][k] = *(const PG8_LAS bf16x8*)(lds + PG8_SB(b, h) + boff + n * 2048 + k * 1024); } while (0)
#define PG8_MMA(ai, bj, At, Bt) do { __builtin_amdgcn_s_setprio(1); _Pragma("unroll") for (int m = 0; m < 4; ++m) _Pragma("unroll") for (int n = 0; n < 2; ++n) _Pragma("unroll") for (int k = 0; k < 2; ++k) \
        acc[ai][bj][m][n] = __builtin_amdgcn_mfma_f32_16x16x32_bf16(Bt[n][k], At[m][k], acc[ai][bj][m][n], 0, 0, 0); __builtin_amdgcn_s_setprio(0); } while (0)
#define PG8_WAIT_V(n) asm volatile("s_waitcnt vmcnt(" #n ")" ::: "memory")
#define PG8_WAIT_L(n) asm volatile("s_waitcnt lgkmcnt(" #n ")" ::: "memory")
#define PG8_BAR __builtin_amdgcn_s_barrier()
#define PG8_SCHED __builtin_amdgcn_sched_barrier(0)
    Unit cur, nxt; int ui = 0;
    if (!S.next(0, cur)) return;
    f32x4 acc[2][2][4][2];
#pragma unroll
    for (int a = 0; a < 2; ++a)
#pragma unroll
        for (int b = 0; b < 2; ++b)
#pragma unroll
            for (int m = 0; m < 4; ++m)
#pragma unroll
                for (int n = 0; n < 2; ++n) acc[a][b][m][n] = (f32x4){0.f, 0.f, 0.f, 0.f};
    bf16x8 At[4][2], B0[2][2], B1[2][2];
    const char* cA = (const char*)g.A + (size_t)cur.pm * tstep; const char* cB = (const char*)g.Bt + (size_t)cur.pn * tstep;
    S.a_ready(cur);
    if constexpr (SP2) {
        PG8_STAGE(PG8_SB(0, 0), cB, voffB); PG8_STAGE(PG8_SB(0, 1), cB + hstep, voffB); PG8_STAGE(PG8_SA(0, 0), cA, voffA); PG8_STAGE(PG8_SA(0, 1), cA + hstep, voffA);
        if (wr == 1) PG8_BAR;
        PG8_WAIT_V(2); PG8_BAR;
        PG8_STAGE(PG8_SB(1, 0), cB + kstep, voffB); PG8_STAGE(PG8_SA(1, 0), cA + kstep, voffA); PG8_STAGE(PG8_SB(1, 1), cB + hstep + kstep, voffB);
        PG8_WAIT_V(6); PG8_BAR;
    } else {
        PG8_STAGE(PG8_SB(0, 0), cB, voffB); PG8_STAGE(PG8_SA(0, 0), cA, voffA); PG8_STAGE(PG8_SB(0, 1), cB + hstep, voffB); PG8_STAGE(PG8_SA(0, 1), cA + hstep, voffA);
        if (wr == 1) PG8_BAR;
        PG8_WAIT_V(4); PG8_BAR;
        PG8_STAGE(PG8_SB(1, 0), cB + kstep, voffB); PG8_STAGE(PG8_SA(1, 0), cA + kstep, voffA); PG8_STAGE(PG8_SB(1, 1), cB + hstep + kstep, voffB);
        PG8_WAIT_V(6); PG8_BAR;
    }
    for (;;) {
        const bool has_next = S.next(ui + 1, nxt);
        const char* nA = has_next ? (const char*)g.A + (size_t)nxt.pm * tstep : cA; const char* nB = has_next ? (const char*)g.Bt + (size_t)nxt.pn * tstep : cB;
        for (int t = 0; t < nt; t += 2) {
            const bool last = (t == nt - 2);
            const char* a1 = cA + (size_t)(t + 1) * kstep;
            const char* a2 = last ? nA : cA + (size_t)(t + 2) * kstep; const char* b2 = last ? nB : cB + (size_t)(t + 2) * kstep;
            const char* a3 = a2 + kstep; const char* b3 = b2 + kstep;
            if (last && has_next) S.a_ready(nxt);
            if constexpr (SP2) {
            PG8_LDB(B0, 0, 0); PG8_LDB(B1, 0, 1); PG8_SCHED; PG8_LDA(At, 0, 0); PG8_STAGE(PG8_SA(1, 1), a1 + hstep, voffA);
            PG8_WAIT_V(8); PG8_WAIT_L(0); PG8_BAR; PG8_MMA(0, 0, At, B0); PG8_MMA(0, 1, At, B1); PG8_BAR; PG8_SCHED;
            PG8_LDA(At, 0, 1); PG8_STAGE(PG8_SB(0, 0), b2, voffB); PG8_STAGE(PG8_SB(0, 1), b2 + hstep, voffB); PG8_STAGE(PG8_SA(0, 0), a2, voffA);
            PG8_WAIT_V(8); PG8_WAIT_L(0); PG8_BAR; PG8_MMA(1, 0, At, B0); PG8_MMA(1, 1, At, B1); PG8_BAR; PG8_SCHED;
            PG8_LDB(B0, 1, 0); PG8_LDB(B1, 1, 1); PG8_SCHED; PG8_LDA(At, 1, 0); PG8_STAGE(PG8_SA(0, 1), a2 + hstep, voffA);
            PG8_WAIT_V(8); PG8_WAIT_L(0); PG8_BAR; PG8_MMA(0, 0, At, B0); PG8_MMA(0, 1, At, B1); PG8_BAR; PG8_SCHED;
            PG8_LDA(At, 1, 1); PG8_STAGE(PG8_SB(1, 0), b3, voffB); PG8_STAGE(PG8_SB(1, 1), b3 + hstep, voffB); PG8_STAGE(PG8_SA(1, 0), a3, voffA);
            PG8_WAIT_V(8); PG8_WAIT_L(0); PG8_BAR; PG8_MMA(1, 0, At, B0); PG8_MMA(1, 1, At, B1); PG8_BAR; PG8_SCHED;
            } else {
            PG8_LDB(B0, 0, 0); PG8_SCHED; PG8_LDA(At, 0, 0); PG8_STAGE(PG8_SA(1, 1), a1 + hstep, voffA);
            PG8_WAIT_L(8); PG8_BAR; PG8_WAIT_L(0); PG8_MMA(0, 0, At, B0); PG8_BAR; PG8_SCHED;
            PG8_LDB(B1, 0, 1); PG8_STAGE(PG8_SB(0, 0), b2, voffB);
            PG8_BAR; PG8_WAIT_L(0); PG8_MMA(0, 1, At, B1); PG8_BAR;
            PG8_LDA(At, 0, 1); PG8_STAGE(PG8_SA(0, 0), a2, voffA);
            PG8_BAR; PG8_WAIT_L(0); PG8_MMA(1, 0, At, B0); PG8_BAR; PG8_SCHED;
            PG8_STAGE(PG8_SB(0, 1), b2 + hstep, voffB);
            PG8_WAIT_V(6); PG8_BAR; PG8_MMA(1, 1, At, B1); PG8_BAR;
            PG8_LDB(B0, 1, 0); PG8_SCHED; PG8_LDA(At, 1, 0); PG8_STAGE(PG8_SA(0, 1), a2 + hstep, voffA);
            PG8_WAIT_L(8); PG8_BAR; PG8_WAIT_L(0); PG8_MMA(0, 0, At, B0); PG8_BAR; PG8_SCHED;
            PG8_LDB(B1, 1, 1); PG8_STAGE(PG8_SB(1, 0), b3, voffB);
            PG8_BAR; PG8_WAIT_L(0); PG8_MMA(0, 1, At, B1); PG8_BAR;
            PG8_LDA(At, 1, 1); PG8_STAGE(PG8_SA(1, 0), a3, voffA);
            PG8_BAR; PG8_WAIT_L(0); PG8_MMA(1, 0, At, B0); PG8_BAR; PG8_SCHED;
            PG8_STAGE(PG8_SB(1, 1), b3 + hstep, voffB);
            PG8_WAIT_V(6); PG8_BAR; PG8_MMA(1, 1, At, B1); PG8_BAR;
            }
        }
        if constexpr (ALIGN_EPI) { if (wr == 0) PG8_BAR; }
        if constexpr (!Epi::AFTER_DRAIN) { E(acc, cur, wr, wc, fr, fq); S.done(cur); }
        if (!has_next) break;
        bool carry = false; if constexpr (Epi::CARRY) carry = E.carry(cur);
        if (!carry) {
#pragma unroll
        for (int a = 0; a < 2; ++a)
#pragma unroll
            for (int b = 0; b < 2; ++b)
#pragma unroll
                for (int m = 0; m < 4; ++m)
#pragma unroll
                    for (int n = 0; n < 2; ++n) acc[a][b][m][n] = (f32x4){0.f, 0.f, 0.f, 0.f};
        }
        cur = nxt; cA = nA; cB = nB; ++ui;
        if constexpr (ALIGN_EPI) { if (wr == 1) PG8_BAR; }
    }
    PG8_WAIT_V(0);
    if constexpr (!ALIGN_EPI) { if (wr == 0) PG8_BAR; }
    PG8_BAR;
    if constexpr (Epi::AFTER_DRAIN) { E.fused(acc, cur, wr, wc, fr, fq, lds, wid, lane); S.done(cur); }
#undef PG8_SA
#undef PG8_SB
#undef PG8_STAGE
#undef PG8_LDA
#undef PG8_LDB
#undef PG8_MMA
#undef PG8_WAIT_V
#undef PG8_WAIT_L
#undef PG8_BAR
#undef PG8_SCHED
}
}
#define GAS __attribute__((address_space(1)))
#define LAS __attribute__((address_space(3)))
typedef unsigned short bf16;
typedef unsigned v4u __attribute__((ext_vector_type(4)));
typedef float f32x4 __attribute__((ext_vector_type(4)));
typedef short bf16x8 __attribute__((ext_vector_type(8)));
typedef GAS unsigned gu32;
typedef GAS unsigned long long gu64;
#define RLX_AGENT __ATOMIC_RELAXED, __HIP_MEMORY_SCOPE_AGENT
#define LDS_WAIT() asm volatile("s_waitcnt lgkmcnt(0)" ::: "memory")
#define VM_WAIT() asm volatile("s_waitcnt vmcnt(0)" ::: "memory")
__device__ __forceinline__ unsigned long long rt() { return __builtin_amdgcn_s_memrealtime(); }
__device__ __forceinline__ unsigned f2bf(float f) { unsigned u = __builtin_bit_cast(unsigned, f); return (u + 0x7fffu + ((u >> 16) & 1u)) >> 16; }
__device__ __forceinline__ unsigned pk2(float lo, float hi) { return f2bf(lo) | (f2bf(hi) << 16); }
#define XB_TMO      128
#define XB_XCNT(j)  (256  + 64 * (j))
#define XB_XSUB(j)  (1280 + 64 * (j))
#define XB_XGEN(j)  (2304 + 64 * (j))
#define XB_TOP      3328
#define XB_TOPGEN   3392
#define XCD_BAR_WORDS 3456
#define XB_SPIN_CAP (1u << 18)

__device__ __forceinline__ unsigned xb_ld(unsigned* p)              { return __hip_atomic_load(p, __ATOMIC_RELAXED, __HIP_MEMORY_SCOPE_AGENT); }
__device__ __forceinline__ unsigned xb_add(unsigned* p, unsigned v) { return __hip_atomic_fetch_add(p, v, __ATOMIC_RELAXED, __HIP_MEMORY_SCOPE_AGENT); }
__device__ __forceinline__ unsigned xb_xcc_id() { return (unsigned)__builtin_amdgcn_s_getreg((3 << 11) | 20) & 0xFu; }
#define XB_SPIN(cond, bar) do { unsigned _sp = 0; while (cond) { __builtin_amdgcn_s_sleep(1); \
    if ((++_sp & 255u) == 0u) { if (xb_ld(&(bar)[XB_TMO])) break; if (_sp > XB_SPIN_CAP) { atomicAdd(&(bar)[XB_TMO], 1u); break; } } } } while (0)

struct XcdBarrier {
    unsigned* bar; unsigned x;
    volatile LAS unsigned* st;
};

__device__ __forceinline__ XcdBarrier xcd_barrier_post(unsigned* bar, volatile LAS unsigned* st) {
    XcdBarrier b; b.bar = bar; b.x = xb_xcc_id(); b.st = st;
    if (threadIdx.x == 0) (void)xb_add(&bar[XB_XCNT(b.x)], 1u);
    return b;
}
__device__ __forceinline__ void xcd_barrier_complete(unsigned* bar, unsigned x, unsigned& nloc, unsigned& nx) {
    const unsigned G = gridDim.x * gridDim.y * gridDim.z;
    unsigned sum, cnt, mine, sp = 0u;
    for (;;) {
        sum = 0u; cnt = 0u; mine = 0u;
#pragma unroll
        for (unsigned j = 0; j < 16; ++j) { const unsigned c = xb_ld(&bar[XB_XCNT(j)]); sum += c; cnt += (c > 0u) ? 1u : 0u; mine = (j == x) ? c : mine; }
        if (sum == G) break;
        __builtin_amdgcn_s_sleep(1);
        if ((++sp & 255u) == 0u) { if (xb_ld(&bar[XB_TMO])) break; if (sp > XB_SPIN_CAP) { atomicAdd(&bar[XB_TMO], 1u); break; } }
    }
    nloc = mine > 0u ? mine : 1u; nx = cnt > 0u ? cnt : 1u;
}

__device__ __forceinline__ void xcd_barrier(const XcdBarrier& b, const bool is_thread0  ) {
    asm volatile("s_waitcnt vmcnt(0)" ::: "memory");
    __syncthreads();
    if (is_thread0) {
        unsigned* bar = b.bar;
        __builtin_amdgcn_s_waitcnt(0);
        unsigned nloc = b.st[0], nx = b.st[1];
        if (nloc == 0u) { xcd_barrier_complete(bar, b.x, nloc, nx); b.st[0] = nloc; b.st[1] = nx; }
        const unsigned old = xb_add(&bar[XB_XSUB(b.x)], 1u);
        const unsigned gen = old / nloc;
        if (old + 1u == (gen + 1u) * nloc) {
            __builtin_amdgcn_fence(__ATOMIC_RELEASE, "agent");
            asm volatile("s_waitcnt vmcnt(0)" ::: "memory");
            const unsigned og = xb_add(&bar[XB_TOP], 1u);
            const unsigned tg = og / nx;
            if (og + 1u == (tg + 1u) * nx) xb_add(&bar[XB_TOPGEN], 1u);
            else XB_SPIN(xb_ld(&bar[XB_TOPGEN]) == tg, bar);
            __builtin_amdgcn_fence(__ATOMIC_ACQUIRE, "agent");
            xb_add(&bar[XB_XGEN(b.x)], 1u);
            asm volatile("s_waitcnt vmcnt(0)" ::: "memory");
        } else {
            XB_SPIN(xb_ld(&bar[XB_XGEN(b.x)]) == gen, bar);
            __builtin_amdgcn_fence(__ATOMIC_ACQUIRE, "agent");
            asm volatile("s_waitcnt vmcnt(0)" ::: "memory");
        }
    }
    __syncthreads();
}
constexpr int S = 8192, D = 2048, NL = 4, DFF = 5632, NIN = 15376, NPROJ = 15872, LDP = 14336, NWAVES = 8;
constexpr int PC_QA = 0, PC_KA = 1024, PC_VA = 2048, PC_QG = 3072, PC_KG = 3584, PC_VG = 4096, PC_RG = 5120, PC_BG = 6144, PC_CU = 7168, PC_G = 8192;
constexpr float RMS_EPS = 1e-6f;
constexpr float FIX_SCALE = 1048576.0f;
constexpr int NPH = 34;
typedef unsigned long long u64;
#define WT_STORES 0
template <class V> __device__ __forceinline__ void st16_wt(GAS void* p, const V v) {
#if WT_STORES
    asm volatile("global_store_dwordx4 %0, %1, off sc1\n\ts_nop 1" :: "v"(p), "v"(v));
#else
    *(GAS V*)p = v;
#endif
}
#define ST16(p, v) st16_wt((GAS void*)(p), (v))
template <class V> __device__ __forceinline__ void st16_plain(GAS void* p, const V v) { *(GAS V*)p = v; }
#define ST16P(p, v) st16_plain((GAS void*)(p), (v))

constexpr size_t MiB = 1u << 20;
constexpr size_t WS_CTL = 0, CTL_ZERO_BYTES = 2 * MiB;
constexpr int CW_BAR = 4096;
constexpr size_t CTL_QKMAX = 32768;
constexpr size_t CTL_BCNT = 1572864;
constexpr size_t CTL_SELCNT = 36864;
constexpr size_t CTL_PLAN = 34816;
constexpr size_t CTL_STATS = 65536;
constexpr size_t CTL_KSUM = 1 * MiB;
static_assert(CTL_KSUM + (size_t)4 * 32 * 1024 * 4 <= CTL_ZERO_BYTES, "ctl map");
static_assert(CTL_BCNT >= CTL_KSUM + (size_t)4 * 32 * 1024 * 4 && CTL_BCNT + (size_t)NL * 3 * 32 * 32 * 4 <= CTL_ZERO_BYTES, "ctl map");
static_assert(CTL_STATS + (size_t)9 * S * 8 <= CTL_KSUM && (CW_BAR + XCD_BAR_WORDS) * 4 <= (int)CTL_STATS, "ctl map");
constexpr size_t W_IN_B = (size_t)NPROJ * D * 2, W_BR_B = (size_t)3 * D * 1024 * 2, W_OUT_B = (size_t)D * D * 2, W_GU_B = (size_t)2 * DFF * D * 2, W_DN_B = (size_t)D * DFF * 2;
constexpr size_t WL_IN = 0, WL_BR = WL_IN + W_IN_B, WL_OUT = WL_BR + W_BR_B, WL_GU = WL_OUT + W_OUT_B, WL_DN = WL_GU + W_GU_B, WL_BYTES = WL_DN + W_DN_B;
constexpr size_t WS_W = 2 * MiB;
constexpr size_t WS_XB = WS_W + NL * WL_BYTES;
constexpr size_t WS_PROJ = WS_XB + (size_t)S * D * 2;
constexpr size_t WS_LA = WS_PROJ + (size_t)S * LDP * 2;
constexpr size_t WS_A3 = WS_LA + (size_t)S * 512 * 4;
constexpr size_t WS_PML = WS_A3 + (size_t)3 * S * 1024 * 2;
constexpr size_t WS_DECAY = WS_PML + (size_t)(512 + 96) * 256 * 2 * 4;
constexpr size_t WS_KV = WS_DECAY + (size_t)4 * 128 * 128 * 4;
constexpr size_t WS_SPREV = WS_KV + (size_t)4 * 128 * 128 * 256 * 4;
constexpr size_t WS_T = WS_SPREV + (size_t)4 * 128 * 128 * 256 * 4;
constexpr int ATT_NSLOT = 512 + 96;
constexpr size_t WS_MIXED = WS_T + (size_t)ATT_NSLOT * 256 * 128 * 4;
constexpr size_t WS_ACT = WS_MIXED + (size_t)S * D * 2;
constexpr size_t WS_QKVH = WS_ACT + (size_t)S * DFF * 2;
constexpr size_t WS_SEL = WS_QKVH + (size_t)3 * 8 * S * 128 * 2;
constexpr size_t WS_RP = WS_SEL + (size_t)3 * S * 4;
constexpr size_t WS_RPML = WS_RP + (size_t)3 * S * 3 * 128 * 4;
constexpr size_t WS_END = WS_RPML + (size_t)3 * S * 3 * 2 * 4;
static_assert(WS_END < (size_t)1900 * MiB, "workspace");
static_assert(WL_BYTES % 256 == 0 && WS_XB % 256 == 0 && WS_PROJ % 256 == 0 && WS_LA % 256 == 0 && WS_A3 % 256 == 0 && WS_KV % 256 == 0 && WS_T % 256 == 0 && WS_ACT % 256 == 0, "alignment");

constexpr int RING_BYTES = 131072, LDSCTL_OFF = RING_BYTES, MISC_OFF = LDSCTL_OFF + 320, LDS_BYTES = 147456;

__device__ __forceinline__ float bflo(unsigned w) { return __uint_as_float(w << 16); }
__device__ __forceinline__ float bfhi(unsigned w) { return __uint_as_float(w & 0xffff0000u); }
__device__ __forceinline__ float bf2f(bf16 b) { return __uint_as_float(((unsigned)b) << 16); }
template <int M> __device__ __forceinline__ float xshfl(float v) {
    return __int_as_float(__builtin_amdgcn_ds_swizzle(__float_as_int(v), (M << 10) | 0x1f)); }
template <int M> __device__ __forceinline__ int xshfl_i(int v) { return __builtin_amdgcn_ds_swizzle(v, (M << 10) | 0x1f); }
__device__ __forceinline__ float swap32_sum(float v) { auto rr = __builtin_amdgcn_permlane32_swap(__float_as_uint(v), __float_as_uint(v), false, false); return __uint_as_float(rr[0]) + __uint_as_float(rr[1]); }
__device__ __forceinline__ float swap32_max(float v) { auto rr = __builtin_amdgcn_permlane32_swap(__float_as_uint(v), __float_as_uint(v), false, false); return fmaxf(__uint_as_float(rr[0]), __uint_as_float(rr[1])); }
__device__ __forceinline__ float wave_sum(float v) { v += xshfl<1>(v); v += xshfl<2>(v); v += xshfl<4>(v); v += xshfl<8>(v); v += xshfl<16>(v); return swap32_sum(v); }
__device__ __forceinline__ float wave_max(float v) { v = fmaxf(v, xshfl<1>(v)); v = fmaxf(v, xshfl<2>(v)); v = fmaxf(v, xshfl<4>(v)); v = fmaxf(v, xshfl<8>(v)); v = fmaxf(v, xshfl<16>(v)); return swap32_max(v); }
__device__ __forceinline__ float inv_rms_of(const u64* st, int row) { return rsqrtf((float)st[row] * (1.0f / (FIX_SCALE * (float)D)) + RMS_EPS); }

__device__ __forceinline__ void unpack8(const v4u w, float (&f)[8]) { f[0] = bflo(w.x); f[1] = bfhi(w.x); f[2] = bflo(w.y); f[3] = bfhi(w.y); f[4] = bflo(w.z); f[5] = bfhi(w.z); f[6] = bflo(w.w); f[7] = bfhi(w.w); }
struct EpiProj {
    static constexpr bool PERM = true, AFTER_DRAIN = false, CARRY = false;
    bf16* proj; bf16* qkvh; float* la; const u64* st; const float* glab; float* ksum; unsigned* qkmax;
    __device__ __forceinline__ void operator()(const pg8::f32x4 (&acc)[2][2][4][2], const pg8::Unit& u, int wr, int wc, int fr, int fq) const {
        const int row0 = u.pm * 256 + wr * 64 + fr, pn = u.pn, cw = wc * 32 + 8 * fq;
        const bool ksumt = pn >= 4 && pn < 8; pg8::f32x4 cs[2][2]; float nmx[2] = {0.f, 0.f};
        pg8::f32x4 glv[2][2];
#pragma unroll
        for (int bj = 0; bj < 2; ++bj)
#pragma unroll
            for (int n = 0; n < 2; ++n) glv[bj][n] = pn >= 60 ? *(const pg8::f32x4*)(glab + (pn - 60) * 256 + bj * 128 + cw + 4 * n) : (pg8::f32x4){0.f, 0.f, 0.f, 0.f};
        float irs[2][4];
#pragma unroll
        for (int ai = 0; ai < 2; ++ai)
#pragma unroll
            for (int m = 0; m < 4; ++m) irs[ai][m] = inv_rms_of(st, row0 + ai * 128 + m * 16);
#pragma unroll
        for (int bj = 0; bj < 2; ++bj) { cs[bj][0] = (pg8::f32x4){0.f, 0.f, 0.f, 0.f}; cs[bj][1] = cs[bj][0]; }
#pragma unroll
        for (int ai = 0; ai < 2; ++ai)
#pragma unroll
            for (int m = 0; m < 4; ++m) {
                const int row = row0 + ai * 128 + m * 16; const float ir = irs[ai][m];
                if (pn < 28 || (pn >= 36 && pn < 60)) {
                    const bool sig = pn >= 36;
                    bf16* rowp = pn < 12 ? qkvh + ((size_t)((pn >> 2) * 8 + 2 * (pn & 3)) * S + row) * 128 + cw
                                         : proj + (size_t)row * LDP + (sig ? PC_G + (pn - 36) * 256 : pn * 256) + cw;
                    const size_t bjstep = pn < 12 ? (size_t)S * 128 : (size_t)128;
#pragma unroll
                    for (int bj = 0; bj < 2; ++bj) { pg8::f32x4 v0 = acc[ai][bj][m][0] * ir, v1 = acc[ai][bj][m][1] * ir;
                        if (ksumt) { cs[bj][0] += v0; cs[bj][1] += v1; }
                        if (pn < 8) { float ss = (v0[0] * v0[0] + v0[1] * v0[1]) + (v0[2] * v0[2] + v0[3] * v0[3]) + (v1[0] * v1[0] + v1[1] * v1[1]) + (v1[2] * v1[2] + v1[3] * v1[3]);
                            ss += xshfl<16>(ss); ss = swap32_sum(ss); nmx[bj] = fmaxf(nmx[bj], ss); }
                        if (sig) {
#pragma unroll
                            for (int j = 0; j < 4; ++j) { v0[j] = fmaxf(__builtin_amdgcn_rcpf(1.0f + __builtin_amdgcn_exp2f(-1.4426950408889634f * v0[j])), 1e-18f); v1[j] = fmaxf(__builtin_amdgcn_rcpf(1.0f + __builtin_amdgcn_exp2f(-1.4426950408889634f * v1[j])), 1e-18f); } }
                        pg8::u32x4 w; w.x = pg8::cvt_pk_bf16(v0[0], v0[1]); w.y = pg8::cvt_pk_bf16(v0[2], v0[3]); w.z = pg8::cvt_pk_bf16(v1[0], v1[1]); w.w = pg8::cvt_pk_bf16(v1[2], v1[3]);
                        ST16P((rowp + bj * bjstep), w); }
                } else if (pn < 36) {
                    bf16* rowp = proj + (size_t)row * LDP + PC_CU + (pn - 28) * 128 + cw;
                    const pg8::f32x4 v0 = (acc[ai][0][m][0] * ir) * (acc[ai][1][m][0] * ir), v1 = (acc[ai][0][m][1] * ir) * (acc[ai][1][m][1] * ir);
                    pg8::u32x4 w; w.x = pg8::cvt_pk_bf16(v0[0], v0[1]); w.y = pg8::cvt_pk_bf16(v0[2], v0[3]); w.z = pg8::cvt_pk_bf16(v1[0], v1[1]); w.w = pg8::cvt_pk_bf16(v1[2], v1[3]);
                    ST16P(rowp, w);
                } else {
#pragma unroll
                    for (int bj = 0; bj < 2; ++bj) { const int col = (pn - 60) * 256 + bj * 128 + cw; float* rowp = la + (size_t)row * 512 + col;
#pragma unroll
                        for (int n = 0; n < 2; ++n) { const pg8::f32x4 bv = glv[bj][n]; pg8::f32x4 z = acc[ai][bj][m][n] * ir + bv, o;
#pragma unroll
                            for (int j = 0; j < 4; ++j) o[j] = (fminf(z[j], 0.f) - 0.6931471805599453f * __builtin_amdgcn_logf(1.0f + __builtin_amdgcn_exp2f(-1.4426950408889634f * fabsf(z[j])))) * 0.0625f;
                            ST16P((rowp + 4 * n), o); } }
                }
            }
        if (pn < 8) {
#pragma unroll
            for (int bj = 0; bj < 2; ++bj) { float s = nmx[bj]; s = fmaxf(s, xshfl<1>(s)); s = fmaxf(s, xshfl<2>(s)); s = fmaxf(s, xshfl<4>(s)); s = fmaxf(s, xshfl<8>(s));
                if (fr == 0 && fq == 0) atomicMax(qkmax + ((pn >> 2) * 8 + 2 * (pn & 3) + bj) * 4 + wc, __float_as_uint(s)); }
        }
        if (ksumt) {
#pragma unroll
            for (int bj = 0; bj < 2; ++bj)
#pragma unroll
                for (int n = 0; n < 2; ++n)
#pragma unroll
                    for (int j = 0; j < 4; ++j) { float s = cs[bj][n][j]; s += xshfl<1>(s); s += xshfl<2>(s); s += xshfl<4>(s); s += xshfl<8>(s);
                        if (fr == 0) atomicAdd(ksum + u.pm * 1024 + (pn - 4) * 256 + bj * 128 + cw + 4 * n + j, s); }
        }
    }
};
struct EpiBranch {
    static constexpr bool PERM = true, AFTER_DRAIN = false, CARRY = true;
    const bf16* proj; bf16* mixed;
    __device__ __forceinline__ bool carry(const pg8::Unit& u) const { return (u.pm >> 5) < 2; }
    __device__ __forceinline__ void operator()(pg8::f32x4 (&acc)[2][2][4][2], const pg8::Unit& u, int wr, int wc, int fr, int fq) const {
        const int b = u.pm >> 5, pm = u.pm & 31, pn = u.pn & 7;
        const int row0 = pm * 256 + wr * 64 + fr, col0 = pn * 256 + wc * 32 + 8 * fq;
#pragma unroll
        for (int ai = 0; ai < 2; ++ai) {
            v4u ga[4][2], gb[4][2];
#pragma unroll
            for (int m = 0; m < 4; ++m)
#pragma unroll
                for (int bj = 0; bj < 2; ++bj) { const GAS bf16* gp = (const GAS bf16*)proj + (size_t)(row0 + ai * 128 + m * 16) * LDP + PC_G + b * D + col0 + bj * 128;
                    ga[m][bj] = *(const GAS v4u*)gp; gb[m][bj] = (b < 2) ? *(const GAS v4u*)(gp + D) : ga[m][bj]; }
#pragma unroll
            for (int m = 0; m < 4; ++m) { const int row = row0 + ai * 128 + m * 16;
#pragma unroll
                for (int bj = 0; bj < 2; ++bj) { const int col = col0 + bj * 128;
                    float f[8]; unpack8(ga[m][bj], f);
                    if (b < 2) { float f2[8]; unpack8(gb[m][bj], f2);
#pragma unroll
                        for (int j = 0; j < 8; ++j) f[j] *= __builtin_amdgcn_rcpf(f2[j]); }
                    pg8::f32x4 v0 = acc[ai][bj][m][0], v1 = acc[ai][bj][m][1];
                    v0[0] *= f[0]; v0[1] *= f[1]; v0[2] *= f[2]; v0[3] *= f[3]; v1[0] *= f[4]; v1[1] *= f[5]; v1[2] *= f[6]; v1[3] *= f[7];
                    if (b < 2) { acc[ai][bj][m][0] = v0; acc[ai][bj][m][1] = v1; }
                    else { pg8::u32x4 w; w.x = pg8::cvt_pk_bf16(v0[0], v0[1]); w.y = pg8::cvt_pk_bf16(v0[2], v0[3]); w.z = pg8::cvt_pk_bf16(v1[0], v1[1]); w.w = pg8::cvt_pk_bf16(v1[2], v1[3]);
                        ST16(((GAS bf16*)mixed + (size_t)row * D + col), w); } } }
            asm volatile("" ::: "memory"); }
    }
};
struct BranchOrder {
    pg8::StaticOrder so;
    __device__ bool next(int i, pg8::Unit& u) const { pg8::Unit t; if (!so.next(i / 3, t)) return false; const int b = i % 3; u.pm = b * 32 + t.pm; u.pn = b * 8 + t.pn; return true; }
    __device__ __forceinline__ void a_ready(const pg8::Unit&) const {}
    __device__ __forceinline__ void done(const pg8::Unit&) const {}
};
struct EpiResid {
    static constexpr bool PERM = true, AFTER_DRAIN = false, CARRY = false;
    bf16* XB; u64* st;
    __device__ __forceinline__ void operator()(const pg8::f32x4 (&acc)[2][2][4][2], const pg8::Unit& u, int wr, int wc, int fr, int fq) const {
        const int row0 = u.pm * 256 + wr * 64 + fr, col0 = u.pn * 256 + wc * 32 + 8 * fq;
#pragma unroll
        for (int ai = 0; ai < 2; ++ai) {
            v4u xv[4][2];
#pragma unroll
            for (int m = 0; m < 4; ++m)
#pragma unroll
                for (int bj = 0; bj < 2; ++bj) xv[m][bj] = *(const GAS v4u*)((const GAS bf16*)XB + (size_t)(row0 + ai * 128 + m * 16) * D + col0 + bj * 128);
#pragma unroll
            for (int m = 0; m < 4; ++m) { const int row = row0 + ai * 128 + m * 16; float ss = 0.f;
#pragma unroll
                for (int bj = 0; bj < 2; ++bj) { const int col = col0 + bj * 128; float x[8]; unpack8(xv[m][bj], x);
                    const pg8::f32x4 a0 = acc[ai][bj][m][0], a1 = acc[ai][bj][m][1];
                    const float v[8] = {x[0] + a0[0], x[1] + a0[1], x[2] + a0[2], x[3] + a0[3], x[4] + a1[0], x[5] + a1[1], x[6] + a1[2], x[7] + a1[3]};
                    ss += (v[0] * v[0] + v[1] * v[1]) + (v[2] * v[2] + v[3] * v[3]) + (v[4] * v[4] + v[5] * v[5]) + (v[6] * v[6] + v[7] * v[7]);
                    pg8::u32x4 w; w.x = pg8::cvt_pk_bf16(v[0], v[1]); w.y = pg8::cvt_pk_bf16(v[2], v[3]); w.z = pg8::cvt_pk_bf16(v[4], v[5]); w.w = pg8::cvt_pk_bf16(v[6], v[7]);
                    ST16(((GAS bf16*)XB + (size_t)row * D + col), w); }
                ss += xshfl<16>(ss); ss = swap32_sum(ss);
                if (fq == 0) __hip_atomic_fetch_add(st + row, (u64)(ss * FIX_SCALE + 0.5f), __ATOMIC_RELAXED, __HIP_MEMORY_SCOPE_AGENT); }
            asm volatile("" ::: "memory"); }
    }
};
struct EpiGU {
    static constexpr bool PERM = true, AFTER_DRAIN = false, CARRY = false;
    bf16* act; const u64* st;
    __device__ __forceinline__ void operator()(const pg8::f32x4 (&acc)[2][2][4][2], const pg8::Unit& u, int wr, int wc, int fr, int fq) const {
        const int row0 = u.pm * 256 + wr * 64 + fr, col0 = u.pn * 128 + wc * 32 + 8 * fq;
        float irs[2][4];
#pragma unroll
        for (int ai = 0; ai < 2; ++ai)
#pragma unroll
            for (int m = 0; m < 4; ++m) irs[ai][m] = inv_rms_of(st, row0 + ai * 128 + m * 16);
#pragma unroll
        for (int ai = 0; ai < 2; ++ai)
#pragma unroll
            for (int m = 0; m < 4; ++m) { const int row = row0 + ai * 128 + m * 16; const float ir = irs[ai][m];
                pg8::f32x4 o[2];
#pragma unroll
                for (int n = 0; n < 2; ++n) { const pg8::f32x4 g = acc[ai][0][m][n] * ir, uu = acc[ai][1][m][n] * ir;
#pragma unroll
                    for (int j = 0; j < 4; ++j) o[n][j] = g[j] * __builtin_amdgcn_rcpf(1.0f + __builtin_amdgcn_exp2f(-1.4426950408889634f * g[j])) * uu[j]; }
                pg8::u32x4 w; w.x = pg8::cvt_pk_bf16(o[0][0], o[0][1]); w.y = pg8::cvt_pk_bf16(o[0][2], o[0][3]); w.z = pg8::cvt_pk_bf16(o[1][0], o[1][1]); w.w = pg8::cvt_pk_bf16(o[1][2], o[1][3]);
                ST16P((act + (size_t)row * DFF + col0), w); }
    }
};


struct Args { const float* in[16]; float* out; unsigned char* ws; int ph_lo, ph_hi, li, pad; };
struct Ptrs {
    const float *x, *norm1_w, *w_in, *gla_w_up, *gla_b, *gla_norm_w, *conv_w, *w_br0, *w_br1, *w_br2, *w_out, *norm2_w, *w_gate, *w_up, *w_down, *final_w;
    float* X; unsigned char* ws; u64* stats;
    bf16 *XB, *PROJ, *A3, *MIXED, *ACT, *QKVH; float *LA, *KSUM, *DECAY, *T, *PML; bf16 *KVT, *SPT; unsigned* QKMAX; int* PLAN; int* SELCNT; int* BCNT; unsigned* SEL; float *RP, *RPML;
    int G, vcu, wv;
};
#define OPAQUE_TID() int lane_v_; asm volatile("v_mbcnt_lo_u32_b32 %0, -1, 0\n\tv_mbcnt_hi_u32_b32 %0, -1, %0" : "=v"(lane_v_)); const int lane = lane_v_, wave = P.wv, tid = wave * 64 + lane; (void)lane; (void)wave; (void)tid

typedef const __attribute__((address_space(4))) unsigned char* KPTR;
__device__ __forceinline__ void fill_ptrs(Ptrs& P, KPTR kp, int wv) {
    const __attribute__((address_space(4))) Args* a = (const __attribute__((address_space(4))) Args*)kp;
    P.wv = wv; P.G = gridDim.x; { const int bx = blockIdx.x; P.vcu = (P.G % 8 == 0) ? (bx % 8) * (P.G / 8) + bx / 8 : bx; }
    P.x = a->in[0]; P.norm1_w = a->in[1]; P.w_in = a->in[2]; P.gla_w_up = a->in[3]; P.gla_b = a->in[4]; P.gla_norm_w = a->in[5]; P.conv_w = a->in[6];
    P.w_br0 = a->in[7]; P.w_br1 = a->in[8]; P.w_br2 = a->in[9]; P.w_out = a->in[10]; P.norm2_w = a->in[11]; P.w_gate = a->in[12]; P.w_up = a->in[13]; P.w_down = a->in[14]; P.final_w = a->in[15];
    P.X = a->out; unsigned char* ws = a->ws; P.ws = ws;
    P.stats = (u64*)(ws + WS_CTL + CTL_STATS);
    P.XB = (bf16*)(ws + WS_XB); P.PROJ = (bf16*)(ws + WS_PROJ); P.LA = (float*)(ws + WS_LA); P.A3 = (bf16*)(ws + WS_A3); P.KSUM = (float*)(ws + WS_CTL + CTL_KSUM); P.QKMAX = (unsigned*)(ws + WS_CTL + CTL_QKMAX); P.PLAN = (int*)(ws + WS_CTL + CTL_PLAN); P.SELCNT = (int*)(ws + WS_CTL + CTL_SELCNT); P.BCNT = (int*)(ws + WS_CTL + CTL_BCNT); P.SEL = (unsigned*)(ws + WS_SEL); P.RP = (float*)(ws + WS_RP); P.RPML = (float*)(ws + WS_RPML); P.PML = (float*)(ws + WS_PML); P.DECAY = (float*)(ws + WS_DECAY);
    P.KVT = (bf16*)(ws + WS_KV); P.SPT = (bf16*)(ws + WS_SPREV); P.T = (float*)(ws + WS_T); P.MIXED = (bf16*)(ws + WS_MIXED); P.ACT = (bf16*)(ws + WS_ACT); P.QKVH = (bf16*)(ws + WS_QKVH);
}
__device__ __forceinline__ void xpose_store(LAS float* scr, bf16* dst, int K, int lane, const f32x4 s0, const f32x4 s1) {
    LDS_WAIT(); asm volatile("" ::: "memory");
    const int c = lane & 7;
#pragma unroll
    for (int j = 0; j < 4; ++j) { const int n = (lane >> 3) + 8 * j; const LAS float* s = scr + (8 * c) * 33 + n;
        v4u o; o.x = pk2(s[0 * 33] * s0.x, s[1 * 33] * s0.y); o.y = pk2(s[2 * 33] * s0.z, s[3 * 33] * s0.w); o.z = pk2(s[4 * 33] * s1.x, s[5 * 33] * s1.y); o.w = pk2(s[6 * 33] * s1.z, s[7 * 33] * s1.w);
        *(GAS v4u*)(dst + (size_t)n * K + 8 * c) = o; }
    LDS_WAIT(); asm volatile("" ::: "memory");
}
constexpr int IT_IN = 496 * 32, IT_BR = 3 * 64 * 16, IT_OUT = 64 * 32, IT_GU = 352 * 32, IT_DN = 64 * 88, IT_L = IT_IN + IT_BR + IT_OUT + IT_GU + IT_DN;
constexpr int R_T1 = 4096, R_TAIL = 4096 + 9216;
struct CvtD { const float* b0; const float* b1; const float* scale; bf16* dst; unsigned st0, st1, hs0, ls0, hs1, ls1; int K; int z; bool hs; };
__device__ __forceinline__ void cvt_copy(CvtD& d, const float* src, unsigned ld, const float* scale, bf16* dst, int K) {
    d.b0 = src; d.b1 = src + (size_t)32 * ld; d.st0 = d.st1 = 2 * ld; d.hs0 = d.hs1 = ld; d.ls0 = d.ls1 = 1; d.dst = dst; d.K = K; d.z = -1; d.hs = scale != nullptr; if (scale) d.scale = scale;
}
__device__ __forceinline__ void cvt_decode(const Ptrs& P, int it0, int nA, int lA, int rA0, int nB, int lB0, int rB0, CvtD& d) {
    int l, r; if (it0 < nA) { l = lA; r = rA0 + it0; } else { const int q = it0 - nA; l = lB0 + q / nB; r = rB0 + q % nB; }
    unsigned char* wl = P.ws + WS_W + (size_t)l * WL_BYTES;
    d.scale = P.norm1_w;
    if (r < IT_IN) {
        const int kb = r / 496, g = r % 496, k0 = 64 * kb;
        const float* win = P.w_in + (size_t)l * D * NIN; const float* sc = P.norm1_w + l * D + k0;
        bf16* dst = (bf16*)(wl + WL_IN) + (size_t)(32 * g) * D + k0;
        int c0;
        if (g < 192) c0 = 32 * g;
        else if (g < 224) c0 = 6160 + 32 * (g - 192);
        else if (g < 288) { const int t = (g - 224) >> 3, sub = (g - 224) & 7; c0 = (sub < 4 ? 7184 : 8208) + 128 * t + 32 * (sub & 3); }
        else if (g < 480) c0 = 9232 + 32 * (g - 288);
        else c0 = 6144;
        cvt_copy(d, win + (size_t)k0 * NIN + c0, NIN, sc, dst, D);
        if (g >= 480) { d.z = 32 * (g - 480); d.st0 = 1; d.hs0 = 32 * NIN; d.ls0 = NIN; d.b1 = P.gla_w_up + (size_t)l * 16 * 512 + 32 * (g - 480); d.st1 = 512; d.hs1 = 0; d.ls1 = 1; }
        return;
    }
    r -= IT_IN;
    if (r < 1024) { const int kb = r / 64, g = r % 64, k0 = 64 * kb;
        cvt_copy(d, P.w_br0 + (size_t)l * 1024 * D + (size_t)k0 * D + 32 * g, D, nullptr, (bf16*)(wl + WL_BR) + (size_t)(0 * D + 32 * g) * 1024 + k0, 1024); return; }
    r -= 1024;
    if (r < 1024) { const int kb = r / 64, g = r % 64, k0 = 64 * kb;
        cvt_copy(d, P.w_br1 + (size_t)l * 1024 * D + (size_t)k0 * D + 32 * g, D, nullptr, (bf16*)(wl + WL_BR) + (size_t)(1 * D + 32 * g) * 1024 + k0, 1024); return; }
    r -= 1024;
    if (r < 1024) { const int kb = r / 64, g = r % 64, k0 = 64 * kb;
        cvt_copy(d, P.w_br2 + (size_t)l * 1024 * D + (size_t)k0 * D + 32 * g, D, nullptr, (bf16*)(wl + WL_BR) + (size_t)(2 * D + 32 * g) * 1024 + k0, 1024); return; }
    r -= 1024;
    if (r < IT_OUT) { const int kb = r / 64, g = r % 64, k0 = 64 * kb;
        cvt_copy(d, P.w_out + (size_t)l * D * D + (size_t)k0 * D + 32 * g, D, nullptr, (bf16*)(wl + WL_OUT) + (size_t)(32 * g) * D + k0, D); return; }
    r -= IT_OUT;
    if (r < IT_GU) { const int kb = r / 352, g = r % 352, k0 = 64 * kb, t = g >> 3, sub = g & 7;
        cvt_copy(d, (sub < 4 ? P.w_gate : P.w_up) + (size_t)l * D * DFF + (size_t)k0 * DFF + 128 * t + 32 * (sub & 3), DFF, P.norm2_w + l * D + k0, (bf16*)(wl + WL_GU) + (size_t)(32 * g) * D + k0, D); return; }
    r -= IT_GU;
    { const int kb = r / 64, g = r % 64, k0 = 64 * kb;
        cvt_copy(d, P.w_down + (size_t)l * DFF * D + (size_t)k0 * D + 32 * g, D, nullptr, (bf16*)(wl + WL_DN) + (size_t)(32 * g) * DFF + k0, DFF); }
}
#define CVT_ISSUE(d, v, s0, s1) do { \
    { const GAS float* p_ = (const GAS float*)(d).b0 + ((lane >> 5) * (d).hs0 + (lane & 31) * (d).ls0); \
      _Pragma("unroll") for (int i_ = 0; i_ < 16; ++i_) { v[i_] = *p_; p_ += (d).st0; asm volatile("" : "+v"(p_)); } } \
    { const GAS float* p_ = (const GAS float*)(d).b1 + ((lane >> 5) * (d).hs1 + (lane & 31) * (d).ls1); \
      _Pragma("unroll") for (int i_ = 0; i_ < 16; ++i_) { v[16 + i_] = *p_; p_ += (d).st1; asm volatile("" : "+v"(p_)); } } \
    s0 = *(const GAS f32x4*)((const GAS float*)(d).scale + 8 * (lane & 7)); s1 = *(const GAS f32x4*)((const GAS float*)(d).scale + 8 * (lane & 7) + 4); } while (0)
#define CVT_FINISH(d, v, s0, s1) do { \
    const f32x4 one_ = {1.f, 1.f, 1.f, 1.f}; const f32x4 t0_ = (d).hs ? s0 : one_, t1_ = (d).hs ? s1 : one_; \
    if ((d).z < 0) { _Pragma("unroll") for (int i_ = 0; i_ < 32; ++i_) scr[(2 * i_ + (lane >> 5)) * 33 + (lane & 31)] = v[i_]; } \
    else { LAS f32x4* st_ = (LAS f32x4*)(scr + 64 * 33 + 16); \
        _Pragma("unroll") for (int q_ = 0; q_ < 4; ++q_) st_[lane * 4 + q_] = f32x4{v[4 * q_], v[4 * q_ + 1], v[4 * q_ + 2], v[4 * q_ + 3]}; \
        LDS_WAIT(); asm volatile("" ::: "memory"); \
        _Pragma("unroll 4") for (int i_ = 0; i_ < 32; ++i_) { const int kk_ = 2 * i_ + (lane >> 5); const f32x4 a0 = st_[kk_ * 4], a1 = st_[kk_ * 4 + 1], a2 = st_[kk_ * 4 + 2], a3 = st_[kk_ * 4 + 3]; \
            scr[kk_ * 33 + (lane & 31)] = ((a0.x * v[16] + a0.y * v[17]) + (a0.z * v[18] + a0.w * v[19])) + ((a1.x * v[20] + a1.y * v[21]) + (a1.z * v[22] + a1.w * v[23])) \
                                        + ((a2.x * v[24] + a2.y * v[25]) + (a2.z * v[26] + a2.w * v[27])) + ((a3.x * v[28] + a3.y * v[29]) + (a3.z * v[30] + a3.w * v[31])); } } \
    xpose_store(scr, (d).dst, (d).K, lane, t0_, t1_); } while (0)
__device__ __forceinline__ void convert_items(const Ptrs& P, LAS unsigned char* lds, int nA, int lA, int rA0, int nB, int nrep, int lB0, int rB0, int worker0, int nworkers) {
    OPAQUE_TID();
    LAS float* scr = (LAS float*)(lds + wave * 16384);
    const int tot = nA + nrep * nB, stride = nworkers * NWAVES;
    int it = worker0 * NWAVES + wave;
    if (it >= tot) return;
    CvtD a, b; float va[32], vb[32]; f32x4 sa0, sa1, sb0, sb1;
    cvt_decode(P, it, nA, lA, rA0, nB, lB0, rB0, a); CVT_ISSUE(a, va, sa0, sa1);
    for (;;) {
        const int itb = it + stride; const bool hb = itb < tot;
        cvt_decode(P, hb ? itb : it, nA, lA, rA0, nB, lB0, rB0, b); CVT_ISSUE(b, vb, sb0, sb1);
        CVT_FINISH(a, va, sa0, sa1);
        if (!hb) break;
        it = itb + stride; const bool ha = it < tot;
        cvt_decode(P, ha ? it : itb, nA, lA, rA0, nB, lB0, rB0, a); CVT_ISSUE(a, va, sa0, sa1);
        CVT_FINISH(b, vb, sb0, sb1);
        if (!ha) break;
    }
}
__device__ __forceinline__ void p0_prologue(const Ptrs& P, LAS unsigned char* lds) {
    convert_items(P, lds, IT_L, 0, 0, IT_L - R_TAIL, NL - 1, 1, R_TAIL, P.vcu, P.G);
    OPAQUE_TID();
    const int gw = P.vcu * NWAVES + wave, NGW = P.G * NWAVES;
    for (int m = gw; m < S; m += NGW) {
        const GAS f32x4* xr = (const GAS f32x4*)(P.x + (size_t)m * D) + lane;
        GAS unsigned long long* xb = (GAS unsigned long long*)(P.XB + (size_t)m * D) + lane;
        float ss = 0.f;
#pragma unroll
        for (int j = 0; j < 8; ++j) { const f32x4 v = xr[64 * j]; ss += (v.x * v.x + v.y * v.y) + (v.z * v.z + v.w * v.w);
            xb[64 * j] = (unsigned long long)pk2(v.x, v.y) | ((unsigned long long)pk2(v.z, v.w) << 32); }
        ss = wave_sum(ss);
        if (lane == 0) P.stats[m] = (u64)(ss * FIX_SCALE + 0.5f);
    }
}
__device__ __forceinline__ void final_norm(const Ptrs& P) {
    OPAQUE_TID();
    const int gw = P.vcu * NWAVES + wave, NGW = P.G * NWAVES;
    f32x4 w[4][2];
#pragma unroll
    for (int j = 0; j < 4; ++j) { const GAS f32x4* wf = (const GAS f32x4*)(P.final_w + 512 * j + 8 * lane); w[j][0] = wf[0]; w[j][1] = wf[1]; }
    for (int m0 = gw; m0 < S; m0 += 4 * NGW) {
        v4u xv[4][4];
#pragma unroll
        for (int r = 0; r < 4; ++r) { const int m = m0 + r * NGW; const GAS v4u* xr = (const GAS v4u*)(P.XB + (size_t)(m < S ? m : m0) * D) + lane;
#pragma unroll
            for (int j = 0; j < 4; ++j) xv[r][j] = xr[64 * j]; }
#pragma unroll
        for (int r = 0; r < 4; ++r) { const int m = m0 + r * NGW; float x[4][8]; float ss = 0.f;
#pragma unroll
            for (int j = 0; j < 4; ++j) { unpack8(xv[r][j], x[j]);
#pragma unroll
                for (int q = 0; q < 8; ++q) ss += x[j][q] * x[j][q]; }
            const float ir = rsqrtf(wave_sum(ss) * (1.0f / D) + RMS_EPS);
            if (m < S) {
#pragma unroll
                for (int j = 0; j < 4; ++j) { GAS f32x4* op = (GAS f32x4*)(P.X + (size_t)m * D + 512 * j + 8 * lane); const f32x4 w0 = w[j][0], w1 = w[j][1];
                    op[0] = (f32x4){x[j][0] * ir * w0.x, x[j][1] * ir * w0.y, x[j][2] * ir * w0.z, x[j][3] * ir * w0.w};
                    op[1] = (f32x4){x[j][4] * ir * w1.x, x[j][5] * ir * w1.y, x[j][6] * ir * w1.z, x[j][7] * ir * w1.w}; } } }
    }
}

__device__ __forceinline__ void att_plan_write(const unsigned* qkmax, int* plan, int lane);
__device__ __forceinline__ void m1_kmean_conv(const Ptrs& P, int l) {
    OPAQUE_TID();
    if ((int)blockIdx.x == P.G - 97 && wave == 0) att_plan_write(P.QKMAX + l * 64, P.PLAN + l * 32, lane);
    const GAS float* cw = (const GAS float*)P.conv_w + (size_t)l * 3 * 1024;
    if ((int)blockIdx.x >= P.G - 96) return;
    for (int item = blockIdx.x * 512 + tid; item < (S / 8) * 128; item += (P.G - 96) * 512) { const int c8 = (item & 127) * 8, t0 = (item >> 7) * 8;
        const GAS bf16* pr = (const GAS bf16*)P.PROJ + c8;
        v4u x[10], bgv[8]; f32x4 w[3][2];
#pragma unroll
        for (int i = 0; i < 10; ++i) { const int t = t0 + i - 2; x[i] = *(const GAS v4u*)(pr + (size_t)(t < 0 ? 0 : t) * LDP + PC_CU); }
#pragma unroll
        for (int i = 0; i < 8; ++i) bgv[i] = *(const GAS v4u*)(pr + (size_t)(t0 + i) * LDP + PC_BG);
#pragma unroll
        for (int k = 0; k < 3; ++k) { w[k][0] = *(const GAS f32x4*)(cw + k * 1024 + c8); w[k][1] = *(const GAS f32x4*)(cw + k * 1024 + c8 + 4); }
        if (t0 == 0) { x[0] = v4u{0u, 0u, 0u, 0u}; x[1] = x[0]; }
#pragma unroll
        for (int i = 0; i < 8; ++i) {
            float f2[8], f1[8], f0[8], fb[8], y[8]; unpack8(x[i], f2); unpack8(x[i + 1], f1); unpack8(x[i + 2], f0); unpack8(bgv[i], fb);
#pragma unroll
            for (int j = 0; j < 8; ++j) y[j] = fb[j] * (w[0][j >> 2][j & 3] * f2[j] + w[1][j >> 2][j & 3] * f1[j] + w[2][j >> 2][j & 3] * f0[j]);
            v4u o; o.x = pk2(y[0], y[1]); o.y = pk2(y[2], y[3]); o.z = pk2(y[4], y[5]); o.w = pk2(y[6], y[7]);
            ST16P((P.A3 + (size_t)2 * S * 1024 + (size_t)(t0 + i) * 1024 + c8), o); } }
}
typedef short s16x4 __attribute__((ext_vector_type(4)));
typedef float f32x16 __attribute__((ext_vector_type(16)));
__device__ __forceinline__ int crow(int r, int h) { return (r & 3) + 8 * (r >> 2) + 4 * h; }
__device__ __forceinline__ bf16x8 tr_frag(LAS const unsigned char* tile, int stride, int k0, int col0, int lane) {
    const int h = lane >> 5, blk = (lane >> 4) & 1, q = (lane & 15) >> 2, p = lane & 3;
    LAS const unsigned char* a = tile + (k0 + 8 * h + q) * stride + (col0 + 16 * blk + 4 * p) * 2;
    const s16x4 lo = __builtin_amdgcn_ds_read_tr16_b64_v4i16((LAS s16x4*)a);
    const s16x4 hi = __builtin_amdgcn_ds_read_tr16_b64_v4i16((LAS s16x4*)(a + 4 * stride));
    return (bf16x8){lo[0], lo[1], lo[2], lo[3], hi[0], hi[1], hi[2], hi[3]};
}
__device__ __forceinline__ bf16x8 row_frag(LAS const unsigned char* tile, int stride, int row0, int k0, int lane) {
    return *(LAS const bf16x8*)(tile + (row0 + (lane & 31)) * stride + (k0 + 8 * (lane >> 5)) * 2);
}
constexpr int GL_VL_STRIDE = 576, GL_QK_STRIDE = 272, GL_KD_STRIDE = 320, GL_XS_STRIDE = 144, GL_OL_STRIDE = 1040;
__device__ __forceinline__ void gla_cumsum(float (&la)[16], int tid, LAS float* tot, LAS float* bcum) {
    const int d = tid & 127, g = tid >> 7; float a = 0.f;
#pragma unroll
    for (int i = 0; i < 16; ++i) { a += la[i]; la[i] = a; }
    tot[g * 128 + d] = a;
    __syncthreads();
    const float t0v = tot[d], t1v = tot[128 + d], t2v = tot[256 + d];
    const float off = (g > 0 ? t0v : 0.f) + (g > 1 ? t1v : 0.f) + (g > 2 ? t2v : 0.f);
#pragma unroll
    for (int i = 0; i < 16; ++i) bcum[(16 * g + i) * 128 + d] = la[i] + off;
    __syncthreads();
}
__device__ __forceinline__ void m1_gla_local(const Ptrs& P, LAS unsigned char* lds) {
    OPAQUE_TID();
    LAS float* bcum = (LAS float*)lds; LAS unsigned char* KD = lds + 32768; LAS unsigned char* VL = lds + 65536; LAS float* tot = (LAS float*)(lds + 102400);
    LAS unsigned char* stg = lds + wave * 8192;
    for (int unit = blockIdx.x; unit < 512; unit += P.G) { const int h = unit >> 7, n = unit & 127, t0 = n * 64;
        float la[16]; { const GAS float* p = (const GAS float*)P.LA + (size_t)(t0 + 16 * (tid >> 7)) * 512 + h * 128 + (tid & 127);
#pragma unroll
            for (int i = 0; i < 16; ++i) la[i] = p[(size_t)i * 512]; }
        v4u kq[2], vv[4];
#pragma unroll
        for (int i = 0; i < 2; ++i) { const int idx = tid + 512 * i, s = idx >> 4, ch = idx & 15; kq[i] = *(const GAS v4u*)((const GAS bf16*)P.PROJ + (size_t)(t0 + s) * LDP + PC_KG + h * 128 + 8 * ch); }
#pragma unroll
        for (int j = 0; j < 4; ++j) { const int idx = tid + 512 * j, s = idx >> 5, ch = idx & 31; vv[j] = *(const GAS v4u*)((const GAS bf16*)P.PROJ + (size_t)(t0 + s) * LDP + PC_VG + h * 256 + 8 * ch); }
        gla_cumsum(la, tid, tot, bcum);
        if (tid < 128) P.DECAY[(h * 128 + n) * 128 + tid] = __expf(bcum[63 * 128 + tid]);
#pragma unroll
        for (int i = 0; i < 2; ++i) { const int idx = tid + 512 * i, s = idx >> 4, ch = idx & 15;
            const f32x4 b0 = *(const LAS f32x4*)(bcum + s * 128 + 8 * ch), b1 = *(const LAS f32x4*)(bcum + s * 128 + 8 * ch + 4), l0 = *(const LAS f32x4*)(bcum + 63 * 128 + 8 * ch), l1 = *(const LAS f32x4*)(bcum + 63 * 128 + 8 * ch + 4);
            float k[8]; unpack8(kq[i], k);
            v4u w; w.x = pk2(k[0] * __expf(l0.x - b0.x), k[1] * __expf(l0.y - b0.y)); w.y = pk2(k[2] * __expf(l0.z - b0.z), k[3] * __expf(l0.w - b0.w));
            w.z = pk2(k[4] * __expf(l1.x - b1.x), k[5] * __expf(l1.y - b1.y)); w.w = pk2(k[6] * __expf(l1.z - b1.z), k[7] * __expf(l1.w - b1.w));
            *(LAS v4u*)(KD + s * GL_KD_STRIDE + ch * 16) = w; }
#pragma unroll
        for (int j = 0; j < 4; ++j) { const int idx = tid + 512 * j, s = idx >> 5, ch = idx & 31; *(LAS v4u*)(VL + s * GL_VL_STRIDE + ch * 16) = vv[j]; }
        __syncthreads();
        f32x16 acc[4];
#pragma unroll
        for (int dt = 0; dt < 4; ++dt)
#pragma unroll
            for (int r = 0; r < 16; ++r) acc[dt][r] = 0.f;
#pragma unroll
        for (int ks = 0; ks < 4; ++ks) { const bf16x8 a = tr_frag(VL, GL_VL_STRIDE, 16 * ks, 32 * wave, lane);
#pragma unroll
            for (int dt = 0; dt < 4; ++dt) { const bf16x8 bb = tr_frag(KD, GL_KD_STRIDE, 16 * ks, 32 * dt, lane); acc[dt] = __builtin_amdgcn_mfma_f32_32x32x16_bf16(a, bb, acc[dt], 0, 0, 0); } }
        __syncthreads();
#pragma unroll
        for (int r = 0; r < 16; ++r) { LAS unsigned char* rowp = stg + crow(r, lane >> 5) * 256 + (lane & 31) * 2;
#pragma unroll
            for (int dt = 0; dt < 4; ++dt) *(LAS bf16*)(rowp + dt * 64) = (bf16)f2bf(acc[dt][r]); }
        LDS_WAIT();
        { GAS bf16* kvt = (GAS bf16*)P.KVT + ((size_t)(h * 128 + n) * 256 + 32 * wave) * 128;
#pragma unroll
            for (int i = 0; i < 8; ++i) { const int row = 4 * i + (lane >> 4); ST16((kvt + (size_t)row * 128 + 8 * (lane & 15)), *(const LAS v4u*)(stg + row * 256 + (lane & 15) * 16)); } }
        __syncthreads();
    }
}
typedef float f32x2v __attribute__((ext_vector_type(2)));
__device__ __forceinline__ void m2_gla_scan(const Ptrs& P) {
    OPAQUE_TID();
    if (tid < 256) for (int gid = blockIdx.x * 256 + tid; gid < 4 * 16384; gid += P.G * 256) { const int h = gid >> 14, rem = gid & 16383, e = rem >> 6, d = (rem & 63) * 2; float s0 = 0.f, s1 = 0.f;
        const GAS bf16* kp = (const GAS bf16*)P.KVT + ((size_t)(h * 128) * 256 + e) * 128 + d; GAS bf16* sp = (GAS bf16*)P.SPT + ((size_t)(h * 128) * 256 + e) * 128 + d; const GAS float* dp = (const GAS float*)P.DECAY + (h * 128) * 128 + d;
        unsigned kvA[16], kvB[16]; f32x2v dA[16], dB[16];
#define SCAN_LOAD(KV, DD, N0) do { _Pragma("unroll") for (int j = 0; j < 16; ++j) { KV[j] = *(const GAS unsigned*)(kp + (size_t)((N0) + j) * 32768); DD[j] = *(const GAS f32x2v*)(dp + ((N0) + j) * 128); } } while (0)
#define SCAN_STEP(KV, DD, N0) do { _Pragma("unroll") for (int j = 0; j < 16; ++j) { *(GAS unsigned*)(sp + (size_t)((N0) + j) * 32768) = pk2(s0, s1); s0 = DD[j].x * s0 + bflo(KV[j]); s1 = DD[j].y * s1 + bfhi(KV[j]); } } while (0)
        SCAN_LOAD(kvA, dA, 0);
#pragma unroll 1
        for (int n0 = 0; n0 < 96; n0 += 32) { SCAN_LOAD(kvB, dB, n0 + 16); SCAN_STEP(kvA, dA, n0); SCAN_LOAD(kvA, dA, n0 + 32); SCAN_STEP(kvB, dB, n0 + 16); }
        SCAN_LOAD(kvB, dB, 112); SCAN_STEP(kvA, dA, 96); SCAN_STEP(kvB, dB, 112);
#undef SCAN_LOAD
#undef SCAN_STEP
    }
}
namespace mo {
constexpr float SCALE = 0.08838834764831845f, THR = 8.f;
constexpr int NW = 8, QBLK = 32, KVBLK = 64, QB = 256, DH = 128, LDQ = 128, LDO = 1024;
constexpr int SHM_V = KVBLK * DH * 2, SHM_K = KVBLK * DH * 2, ATT_STG = 2 * SHM_V + 2 * SHM_K  , ATT_WS = RING_BYTES + 1024  ;
constexpr int ATT_RL = RING_BYTES + 4096  , ATT_SL = RING_BYTES + 5120  ;
static_assert(ATT_STG + NW * 8192 <= RING_BYTES && ATT_WS + NW * 256 <= ATT_RL && ATT_SL + 1024 <= LDS_BYTES && ATT_WS >= MISC_OFF + 128, "attention LDS");
typedef short s16x4 __attribute__((ext_vector_type(4)));
typedef float f32x16 __attribute__((ext_vector_type(16)));
typedef unsigned u32x4 __attribute__((ext_vector_type(4)));
#define KSWZ(row, colB) ((row) * 256 + ((colB) ^ (((row) & 7) << 4)))
#define SBAR() __builtin_amdgcn_sched_barrier(0)
__device__ __forceinline__ int v_st(int k, int c) { const int kk = (k & ~0xC) | ((k & 4) << 1) | ((k & 8) >> 1); return ((kk >> 3) * 4 + (c >> 5)) * 512 + ((kk & 7) * 32 + (c & 31)) * 2; }
__device__ __forceinline__ int v_rd_base(int lane) { return ((lane & 3) << 3) | (((lane >> 2) & 3) << 6) | (((lane >> 4) & 1) << 5) | (((lane >> 5) & 1) << 8); }
constexpr int v_rd_off(int d0, int ks, int half) { return d0 * 512 + ks * 4096 + half * 2048; }
__device__ __forceinline__ int crow(int r, int hi) { return (r & 3) + 8 * (r >> 2) + 4 * hi; }
__device__ __forceinline__ unsigned cvtpk(float lo, float hi) { unsigned r; asm volatile("v_cvt_pk_bf16_f32 %0, %1, %2" : "=v"(r) : "v"(lo), "v"(hi)); return r; }
__device__ __forceinline__ bf16x8 pack8(f32x4 a, f32x4 b) { u32x4 w = {cvtpk(a[0], a[1]), cvtpk(a[2], a[3]), cvtpk(b[0], b[1]), cvtpk(b[2], b[3])}; return *reinterpret_cast<bf16x8*>(&w); }
__device__ __forceinline__ bf16x8 load8(const GAS bf16* p) { return *reinterpret_cast<const GAS bf16x8*>(p); }
__device__ __forceinline__ void mask_tile(f32x16& p0, f32x16& p1, int dq) {
    const float NEG = -__builtin_inff();
#pragma unroll
    for (int r = 0; r < 16; ++r) { const int c = (r & 3) + 8 * (r >> 2); if (dq - c < 0) p0[r] = NEG; if (dq - c - 32 < 0) p1[r] = NEG; }
}
__device__ __forceinline__ void partialSM(f32x16& p0, f32x16& p1, float& m_reg, float& mn, float& alpha) {
    float pmax = p0[0]; for (int r = 1; r < 16; ++r) pmax = fmaxf(pmax, p0[r]); for (int r = 0; r < 16; ++r) pmax = fmaxf(pmax, p1[r]);
    { auto rr = __builtin_amdgcn_permlane32_swap(__float_as_uint(pmax), __float_as_uint(pmax), false, false);
      pmax = fmaxf(__uint_as_float(rr[0]), __uint_as_float(rr[1])); }
    constexpr float C2 = 1.4426950408889634f * SCALE;
    if (__builtin_expect(__all((pmax - m_reg) * SCALE <= THR), 1)) { mn = m_reg; alpha = 1.f; }
    else { mn = fmaxf(m_reg, pmax); alpha = __builtin_amdgcn_exp2f((m_reg - mn) * C2); m_reg = mn; }
    const float mnL = -mn * C2;
    for (int r = 0; r < 16; ++r) p0[r] = fmaf(p0[r], C2, mnL); for (int r = 0; r < 16; ++r) p1[r] = fmaf(p1[r], C2, mnL);
    for (int r = 0; r < 16; ++r) p0[r] = __builtin_amdgcn_exp2f(p0[r]);
}
__device__ __forceinline__ void finishSM(f32x16& p0, f32x16& p1, float alpha, float& l_reg, bf16x8& pa0, bf16x8& pa1, bf16x8& pa2, bf16x8& pa3) {
    for (int r = 0; r < 16; ++r) p1[r] = __builtin_amdgcn_exp2f(p1[r]);
    float ps = 0; for (int r = 0; r < 16; ++r) ps += p0[r]; for (int r = 0; r < 16; ++r) ps += p1[r];
    { auto rr = __builtin_amdgcn_permlane32_swap(__float_as_uint(ps), __float_as_uint(ps), false, false);
      ps = __uint_as_float(rr[0]) + __uint_as_float(rr[1]); }
    l_reg = l_reg * alpha + ps;
#define PK4(P, B_, OUT) do { unsigned a0 = cvtpk(P[B_+0], P[B_+1]), a1 = cvtpk(P[B_+2], P[B_+3]);                          \
        unsigned b0 = cvtpk(P[B_+4], P[B_+5]), b1 = cvtpk(P[B_+6], P[B_+7]);                                             \
        auto r0 = __builtin_amdgcn_permlane32_swap(a0, b0, false, false); auto r1 = __builtin_amdgcn_permlane32_swap(a1, b1, false, false); \
        u32x4 w = {r0[0], r1[0], r0[1], r1[1]}; OUT = *reinterpret_cast<bf16x8*>(&w); } while (0)
    PK4(p0, 0, pa0); PK4(p0, 8, pa1); PK4(p1, 0, pa2); PK4(p1, 8, pa3);
#undef PK4
}
template <int KB>
__device__ __forceinline__ void qkt(f32x16& p0, f32x16& p1, const char* K_lds, int r32, int hi, const bf16x8* qr, float base, float sl) {
    { const float sl8 = 8.f * sl, sl32 = 32.f * sl; float gb = base;
#pragma unroll
        for (int g4 = 0; g4 < 4; ++g4) { float t = gb;
#pragma unroll
            for (int i = 0; i < 4; ++i) { p0[4 * g4 + i] = t; p1[4 * g4 + i] = t + sl32; t += sl; }
            gb += sl8; } }
    const char* kb[4];
#pragma unroll
    for (int dd = 0; dd < 4; ++dd) kb[dd] = K_lds + KB * SHM_K + KSWZ(r32, (dd * 16 + hi * 8) * 2);
#pragma unroll
    for (int d0 = 0; d0 < 8; ++d0) { const char* a = kb[d0 & 3] + (d0 >> 2) * 128;
        bf16x8 b0 = *reinterpret_cast<const bf16x8*>(a);
        bf16x8 b1 = *reinterpret_cast<const bf16x8*>(a + 32 * 256);
        p0 = __builtin_amdgcn_mfma_f32_32x32x16_bf16(b0, qr[d0], p0, 0, 0, 0);
        p1 = __builtin_amdgcn_mfma_f32_32x32x16_bf16(b1, qr[d0], p1, 0, 0, 0); }
}
template <int VB>
__device__ __forceinline__ void pv_tile(f32x16* o, int vb0, bf16x8 pa0, bf16x8 pa1, bf16x8 pa2, bf16x8 pa3) {
#define TRRD(dst, off) asm volatile("ds_read_b64_tr_b16 %0, %1 offset:%2" : "=&v"(dst) : "v"(vb0), "i"(off) : "memory")
#define PV_D0(d0) do { s16x4 l0, l1, l2, l3, h0, h1, h2, h3; constexpr int b_ = VB * SHM_V + v_rd_off(d0, 0, 0); \
        TRRD(l0, b_); TRRD(h0, b_ + 2048); TRRD(l1, b_ + 4096); TRRD(h1, b_ + 6144); TRRD(l2, b_ + 8192); TRRD(h2, b_ + 10240); TRRD(l3, b_ + 12288); TRRD(h3, b_ + 14336); \
        asm volatile("s_waitcnt lgkmcnt(0)" ::: "memory"); SBAR();   \
        o[d0] = __builtin_amdgcn_mfma_f32_32x32x16_bf16(pa0, (bf16x8){l0[0], l0[1], l0[2], l0[3], h0[0], h0[1], h0[2], h0[3]}, o[d0], 0, 0, 0);   \
        o[d0] = __builtin_amdgcn_mfma_f32_32x32x16_bf16(pa1, (bf16x8){l1[0], l1[1], l1[2], l1[3], h1[0], h1[1], h1[2], h1[3]}, o[d0], 0, 0, 0);   \
        o[d0] = __builtin_amdgcn_mfma_f32_32x32x16_bf16(pa2, (bf16x8){l2[0], l2[1], l2[2], l2[3], h2[0], h2[1], h2[2], h2[3]}, o[d0], 0, 0, 0);   \
        o[d0] = __builtin_amdgcn_mfma_f32_32x32x16_bf16(pa3, (bf16x8){l3[0], l3[1], l3[2], l3[3], h3[0], h3[1], h3[2], h3[3]}, o[d0], 0, 0, 0); } while (0)
    PV_D0(0); PV_D0(1); PV_D0(2); PV_D0(3);
#undef PV_D0
#undef TRRD
}
struct Seg { int P0, jb, je, slot; };
struct Head { unsigned char* ws; int h, l; float sl;
    __device__ __forceinline__ const GAS bf16* HB(int type) const { return (const GAS bf16*)(ws + WS_QKVH) + (size_t)(type * 8 + h) * S * 128; }
    __device__ __forceinline__ const GAS float* KM() const { unsigned char* w = ws; asm volatile("" : "+s"(w)); return (const GAS float*)(w + WS_CTL + CTL_KSUM) + (size_t)l * 32 * 1024 + h * 128; }
    __device__ __forceinline__ GAS bf16* OB() const { unsigned char* w = ws; asm volatile("" : "+s"(w)); return (GAS bf16*)(w + WS_A3) + h * 128; }
    __device__ __forceinline__ GAS float* PO() const { unsigned char* w = ws; asm volatile("" : "+s"(w)); return (GAS float*)(w + WS_T); }
    __device__ __forceinline__ GAS float* PML() const { unsigned char* w = ws; asm volatile("" : "+s"(w)); return (GAS float*)(w + WS_PML); }
    __device__ __forceinline__ GAS float* RP() const { unsigned char* w = ws; asm volatile("" : "+s"(w)); return (GAS float*)(w + WS_RP) + (size_t)(h - 5) * S * 3 * 128; }
    __device__ __forceinline__ GAS float* RPML() const { unsigned char* w = ws; asm volatile("" : "+s"(w)); return (GAS float*)(w + WS_RPML) + (size_t)(h - 5) * S * 3 * 2; }
};
struct Seam { bf16x8 qr[8]; bf16x8 st_v0, st_v1, st_k0, st_k1; };
#define ROW(p, k0, rr) ((const GAS bf16*)((const GAS char*)(p) + (unsigned)((((k0) + (rr)) * LDQ + sc) * 2)))
#define VMW() asm volatile("s_waitcnt vmcnt(0)" ::: "memory")
#define VMWN(n) asm volatile("s_waitcnt vmcnt(%0)" :: "i"(n) : "memory")
#define SLOAD_H(Kp, Vp, k0) do { S.st_v0 = load8(ROW(Vp, k0, sr)); S.st_v1 = load8(ROW(Vp, k0, 32 + sr)); S.st_k0 = load8(ROW(Kp, k0, sr)); S.st_k1 = load8(ROW(Kp, k0, 32 + sr)); } while (0)
#define SWRITE_HK(bf) do { *(bf16x8*)(K_lds + (bf) * SHM_K + kws) = S.st_k0; *(bf16x8*)(K_lds + (bf) * SHM_K + kws + 32 * 256) = S.st_k1; } while (0)
#define SWRITE_HV(bf) do { *(bf16x8*)(V_lds + (bf) * SHM_V + vst0) = S.st_v0; *(bf16x8*)(V_lds + (bf) * SHM_V + vst1) = S.st_v1; } while (0)
#define SWRITE_H(bf) do { SWRITE_HV(bf); SWRITE_HK(bf); } while (0)
template <bool G> __device__ __forceinline__ void att_prime(const Head& H, const Seg& cur, char* lds, LAS unsigned char* lds3, Seam& S, int wave_sgpr) {
    int tid; asm volatile("v_mbcnt_lo_u32_b32 %0, -1, 0\n\tv_mbcnt_hi_u32_b32 %0, -1, %0" : "=v"(tid)); tid += wave_sgpr * 64;
    const int wid = __builtin_amdgcn_readfirstlane(tid >> 6), lane = tid & 63, r32 = lane & 31, hi = lane >> 5;
    const int sr = tid >> 4, sc = (tid & 15) * 8, kws = KSWZ(sr, sc * 2); char* K_lds = lds + 2 * SHM_V;
    const int kb0 = cur.jb * KVBLK;
    const int qrow = G ? ((const LAS int*)(lds3 + ATT_RL))[wid * QBLK + r32] : cur.P0 + wid * QBLK + r32;
#pragma unroll
    for (int d0 = 0; d0 < 8; ++d0) S.qr[d0] = load8(H.HB(0) + (size_t)qrow * LDQ + d0 * 16 + hi * 8);
    SLOAD_H(H.HB(1), H.HB(2), kb0); VMW(); SWRITE_HK(0);
    __syncthreads();
}
template <bool G> __device__ __forceinline__ void att_block(const Head& H, const Seg& cur, const Seg& nxt, char* lds, LAS unsigned char* lds3, Seam& S, int tid_in) {
    int tid; asm volatile("v_mbcnt_lo_u32_b32 %0, -1, 0\n\tv_mbcnt_hi_u32_b32 %0, -1, %0" : "=v"(tid)); tid += tid_in * 64;
    const int wid = __builtin_amdgcn_readfirstlane(tid >> 6), lane = tid & 63, r32 = lane & 31, hi = lane >> 5;
    const int NT = cur.je - cur.jb, kbn = nxt.jb * KVBLK;
    const int qlo = G ? (1 << 28) : cur.P0 + wid * QBLK, qm = qlo + r32 - 4 * hi, own = cur.P0 >> 8;
    const int tl = G ? ((const LAS int*)(lds3 + ATT_RL))[wid * QBLK + r32] : 0;
    char* V_lds = lds; char* K_lds = lds + 2 * SHM_V;
    float* ws = (float*)(lds + ATT_WS) + wid * 64; float* li_l = ws, * al_l = ws + 32;
    float m_reg = -1e30f, l_reg = 0; f32x16 o[4] = {};
    const int sr = tid >> 4, sc = (tid & 15) * 8, vst0 = v_st(sr, sc), vst1 = v_st(32 + sr, sc), kws = KSWZ(sr, sc * 2);
    const int vb0 = (int)(uintptr_t)V_lds + v_rd_base(lane);
    const GAS bf16* Kh = H.HB(1); const GAS bf16* Vh = H.HB(2); const float sl = H.sl;
    unsigned selm = 0u;
    if constexpr (!G) { f32x16 g = {};
#pragma unroll
        for (int d0 = 0; d0 < 8; ++d0) { const GAS float* kp = H.KM() + (size_t)r32 * 1024 + d0 * 16 + hi * 8; const f32x4 a = *(const GAS f32x4*)kp, b = *(const GAS f32x4*)(kp + 4);
            const bf16x8 kh = pack8(a, b); const unsigned short* khs = reinterpret_cast<const unsigned short*>(&kh);
            f32x4 ra, rb; ra[0] = a[0] - bf2f(khs[0]); ra[1] = a[1] - bf2f(khs[1]); ra[2] = a[2] - bf2f(khs[2]); ra[3] = a[3] - bf2f(khs[3]);
            rb[0] = b[0] - bf2f(khs[4]); rb[1] = b[1] - bf2f(khs[5]); rb[2] = b[2] - bf2f(khs[6]); rb[3] = b[3] - bf2f(khs[7]);
            g = __builtin_amdgcn_mfma_f32_32x32x16_bf16(kh, S.qr[d0], g, 0, 0, 0); g = __builtin_amdgcn_mfma_f32_32x32x16_bf16(pack8(ra, rb), S.qr[d0], g, 0, 0, 0); }
        const float NEG = -__builtin_inff();
#pragma unroll
        for (int k = 0; k < 3; ++k) { float bv = NEG; int bi = 64;
#pragma unroll
            for (int r = 0; r < 16; ++r) { const int n = crow(r, hi); const float v = (n < own && !((selm >> n) & 1u)) ? g[r] : NEG; if (v > bv) { bv = v; bi = n; } }
            float ov; int oi; { auto rv = __builtin_amdgcn_permlane32_swap(__float_as_uint(bv), __float_as_uint(bv), false, false); auto ri = __builtin_amdgcn_permlane32_swap((unsigned)bi, (unsigned)bi, false, false);
                ov = __uint_as_float(hi ? rv[0] : rv[1]); oi = (int)(hi ? ri[0] : ri[1]); }
            if (ov > bv || (ov == bv && oi < bi)) { bv = ov; bi = oi; }
            if (bv > NEG) selm |= 1u << bi; } }
#define RESC(a) do { if (__any((a) < 1.f)) { if (hi == 0) al_l[r32] = (a); asm volatile("s_waitcnt lgkmcnt(0)" ::: "memory");              \
                     for (int d_ = 0; d_ < 4; ++d_) for (int r = 0; r < 16; ++r) o[d_][r] *= al_l[crow(r, hi)]; } } while (0)
#define KBASE(t) ((cur.jb + (t)) * KVBLK)
#define TBASE(t) (G ? sl * (float)(KBASE(t) + 4 * hi - (tl & ~255))   : (((KBASE(t) >> 8) == own || ((selm >> (KBASE(t) >> 8)) & 1u)) ? sl * (float)(KBASE(t) - cur.P0 + 4 * hi) : -__builtin_inff()))
#define MASKT(P0_, P1_, t) do { const int kb_ = KBASE(t); if (kb_ + KVBLK - 1 > qlo) mask_tile(P0_, P1_, qm - kb_); } while (0)
#define SEAM_K0() do { if constexpr (!G) { VMWN(8); SWRITE_HK(0); } SBAR(); } while (0)
    f32x16 pA0, pA1, pB0, pB1; float mnA, mnB, alA, alB; bf16x8 pa0, pa1, pa2, pa3;
    SWRITE_HV(0); SBAR();
    if (NT > 1) SLOAD_H(Kh, Vh, KBASE(1));
    SBAR(); qkt<0>(pA0, pA1, K_lds, r32, hi, S.qr, TBASE(0), sl);
    MASKT(pA0, pA1, 0); partialSM(pA0, pA1, m_reg, mnA, alA);
    if (NT > 1) { VMW(); SWRITE_H(1); }
    __syncthreads();
#define HALF_STEP(PX0, PX1, mnX, alX, PY0, PY1, alY, t, KB, VB, SB) do {                                                      \
        SBAR(); qkt<KB>(PX0, PX1, K_lds, r32, hi, S.qr, TBASE(t), sl);                                                        \
        finishSM(PY0, PY1, alY, l_reg, pa0, pa1, pa2, pa3); SBAR();                                                           \
        if ((t) + 1 < NT) { SLOAD_H(Kh, Vh, KBASE((t) + 1)); SBAR(); }                                                        \
        pv_tile<VB>(o, vb0, pa0, pa1, pa2, pa3); MASKT(PX0, PX1, (t)); partialSM(PX0, PX1, m_reg, mnX, alX);                  \
        __syncthreads();                                                                                                      \
        if ((t) + 1 < NT) { VMW(); SWRITE_H(SB); }                                                                            \
        RESC(alX); __syncthreads(); } while (0)
    for (int t = 1; t + 1 < NT; t += 2) {
        HALF_STEP(pB0, pB1, mnB, alB, pA0, pA1, alA, t, 1, 0, 0);
        HALF_STEP(pA0, pA1, mnA, alA, pB0, pB1, alB, t + 1, 0, 1, 1);
    }
    const bool even = (NT & 1) == 0;
    if (even) { SBAR(); qkt<1>(pB0, pB1, K_lds, r32, hi, S.qr, TBASE(NT - 1), sl); SBAR(); }
    if constexpr (!G) { SLOAD_H(Kh, Vh, kbn); } SBAR();
    int r32_t = r32, hi_t = hi; asm volatile("" : "+v"(r32_t), "+v"(hi_t));
#pragma unroll
    for (int d0 = 0; d0 < 8; ++d0) if constexpr (!G) S.qr[d0] = load8(H.HB(0) + (size_t)(nxt.P0 + wid * QBLK + r32_t) * LDQ + d0 * 16 + hi_t * 8);
    SBAR();
    finishSM(pA0, pA1, alA, l_reg, pa0, pa1, pa2, pa3); SBAR();
    pv_tile<0>(o, vb0, pa0, pa1, pa2, pa3);
    if (even) { MASKT(pB0, pB1, NT - 1); partialSM(pB0, pB1, m_reg, mnB, alB); __syncthreads(); RESC(alB);
        finishSM(pB0, pB1, alB, l_reg, pa0, pa1, pa2, pa3); SBAR(); pv_tile<1>(o, vb0, pa0, pa1, pa2, pa3); }
    SBAR(); SEAM_K0();
    int hi_e = hi, r32_e = r32; asm volatile("" : "+v"(hi_e), "+v"(r32_e));
    LAS unsigned char* stg = lds3 + ATT_STG + wid * 8192;
    if constexpr (G) {
        const LAS int* rl = (const LAS int*)(lds3 + ATT_RL); const LAS int* sll = (const LAS int*)(lds3 + ATT_SL);
        GAS float* rp = H.RP();
#pragma unroll
        for (int ps = 0; ps < 2; ++ps) {
#pragma unroll
            for (int r = 0; r < 16; ++r) { LAS unsigned char* rowp = stg + crow(r, hi_e) * 256 + r32_e * 4; *(LAS float*)rowp = o[2 * ps][r]; *(LAS float*)(rowp + 128) = o[2 * ps + 1][r]; }
            asm volatile("s_waitcnt lgkmcnt(0)" ::: "memory");
#pragma unroll
            for (int i = 0; i < 8; ++i) { const int row = 4 * i + (lane >> 4), rr = wid * QBLK + row, t = rl[rr], sq = sll[rr];
                if (sq >= 0) ST16((rp + ((size_t)t * 3 + sq) * 128 + 64 * ps + 4 * (lane & 15)), *(const LAS f32x4*)(stg + row * 256 + (lane & 15) * 16)); }
            asm volatile("s_waitcnt lgkmcnt(0)" ::: "memory"); }
        if (hi_e == 0) { const int rr = wid * QBLK + r32_e, t = rl[rr], sq = sll[rr]; if (sq >= 0) { GAS float* ml = H.RPML() + ((size_t)t * 3 + sq) * 2; ml[0] = m_reg; ml[1] = l_reg; } }
    } else
    if (cur.slot < 0) {
        if (hi_e == 0) li_l[r32_e] = l_reg; asm volatile("s_waitcnt lgkmcnt(0)" ::: "memory");
        float rli[16];
#pragma unroll
        for (int r = 0; r < 16; ++r) rli[r] = __builtin_amdgcn_rcpf(li_l[crow(r, hi_e)]);
#pragma unroll
        for (int r = 0; r < 16; ++r) { LAS unsigned char* rowp = stg + crow(r, hi_e) * 256 + r32_e * 2;
#pragma unroll
            for (int d0 = 0; d0 < 4; ++d0) *(LAS bf16*)(rowp + d0 * 64) = (bf16)f2bf(o[d0][r] * rli[r]); }
        asm volatile("s_waitcnt lgkmcnt(0)" ::: "memory");
        GAS bf16* Ow = H.OB() + (size_t)(cur.P0 + wid * QBLK) * LDO;
#pragma unroll
        for (int i = 0; i < 8; ++i) { const int row = 4 * i + (lane >> 4); ST16((Ow + (size_t)row * LDO + 8 * (lane & 15)), *(const LAS u32x4*)(stg + row * 256 + (lane & 15) * 16)); }
    } else {
        GAS float* Pw = H.PO() + ((size_t)cur.slot * 256 + wid * QBLK) * DH;
#pragma unroll
        for (int ps = 0; ps < 2; ++ps) {
#pragma unroll
            for (int r = 0; r < 16; ++r) { LAS unsigned char* rowp = stg + crow(r, hi_e) * 256 + r32_e * 4; *(LAS float*)rowp = o[2 * ps][r]; *(LAS float*)(rowp + 128) = o[2 * ps + 1][r]; }
            asm volatile("s_waitcnt lgkmcnt(0)" ::: "memory");
#pragma unroll
            for (int i = 0; i < 8; ++i) { const int row = 4 * i + (lane >> 4); ST16((Pw + (size_t)row * DH + 64 * ps + 4 * (lane & 15)), *(const LAS f32x4*)(stg + row * 256 + (lane & 15) * 16)); }
            asm volatile("s_waitcnt lgkmcnt(0)" ::: "memory"); }
        if (hi_e == 0) { GAS float* ml = H.PML() + ((size_t)cur.slot * 256 + wid * QBLK + r32_e) * 2; ml[0] = m_reg; ml[1] = l_reg; }
    }
    __syncthreads();
#undef RESC
#undef KBASE
#undef TBASE
#undef MASKT
#undef SEAM_K0
#undef HALF_STEP
}
#undef ROW
#undef VMW
#undef VMWN
#undef SLOAD_H
#undef SWRITE_HK
#undef SWRITE_HV
#undef SWRITE_H
#undef KSWZ
#undef SBAR
}

constexpr float ATT_CUT = 26.f;
constexpr int ATT_BLK_COST = 2, ATT_MAXP = 8;
constexpr int ATT_NG = 99, ATT_ND = 256 - ATT_NG;
struct AttPlan { int rt, T, W, w, h, vbase; };
__device__ __forceinline__ int att_rt(const unsigned qk, int h) {
    float q2 = 0.f, k2 = 0.f;
#pragma unroll
    for (int j = 0; j < 4; ++j) { q2 += __uint_as_float(__builtin_amdgcn_readlane(qk, h * 4 + j)); k2 += __uint_as_float(__builtin_amdgcn_readlane(qk, 32 + h * 4 + j)); }
    const float B = sqrtf(q2 * k2) * mo::SCALE * 1.02f;
    const float R = (2.f * B + ATT_CUT) * exp2f((float)(h + 1));
    const float rtf = floorf((R + 63.f) * (1.0f / 64.f));
    return rtf >= 128.f ? 128 : (int)rtf;
}
__device__ __forceinline__ int att_tiles(int rt) { int t = 0; for (int b = 0; b < 32; ++b) { const int jl = 4 * b - rt; t += 4 * (b + 1) - (jl > 0 ? jl : 0); } return t; }
__device__ __forceinline__ void att_plan_write(const unsigned* qkmax, int* plan, int lane) {
    int rt[8], T[8], cum[9]; cum[0] = 0; const unsigned qk = __hip_atomic_load(qkmax + lane, __ATOMIC_RELAXED, __HIP_MEMORY_SCOPE_AGENT);
#pragma unroll
    for (int h = 0; h < 8; ++h) { rt[h] = h >= 5 ? 0 : __builtin_amdgcn_readfirstlane(att_rt(qk, h)); T[h] = att_tiles(rt[h]); cum[h + 1] = cum[h] + T[h] + 32 * ATT_BLK_COST; }
    int prev = 0;
#pragma unroll
    for (int h = 0; h < 8; ++h) { int bnd = (ATT_ND * cum[h + 1] + cum[8] / 2) / cum[8]; if (bnd <= prev) bnd = prev + 1; if (h == 7) bnd = ATT_ND;
        if (lane == 0) { __hip_atomic_store(plan + 4 * h, rt[h], RLX_AGENT); __hip_atomic_store(plan + 4 * h + 1, T[h], RLX_AGENT); __hip_atomic_store(plan + 4 * h + 2, prev, RLX_AGENT); __hip_atomic_store(plan + 4 * h + 3, bnd - prev, RLX_AGENT); }
        prev = bnd; }
}
__device__ __forceinline__ AttPlan att_plan(const int* plan, int v, int lane) {
    const int val = __hip_atomic_load(plan + (lane & 31), RLX_AGENT);
    AttPlan p; p.h = 0; p.vbase = 0; p.rt = 0; p.T = 1; p.W = 1; p.w = 0;
#pragma unroll
    for (int h = 0; h < 8; ++h) { const int rt = __builtin_amdgcn_readlane(val, 4 * h), T = __builtin_amdgcn_readlane(val, 4 * h + 1), vb = __builtin_amdgcn_readlane(val, 4 * h + 2), W = __builtin_amdgcn_readlane(val, 4 * h + 3);
        if (v >= vb && v < vb + W) { p.h = h; p.vbase = vb; p.rt = rt; p.T = T; p.W = W; p.w = v - vb; } }
    return p;
}
struct SegIter { int b, pre, lo, hi, rt, v, h;
    __device__ __forceinline__ bool next(mo::Seg& s) {
        while (b < 32) { const int jl0 = 4 * b - rt, jl = jl0 > 0 ? jl0 : 0, nb = 4 * (b + 1) - jl, pb = pre, bb = b; pre += nb; ++b;
            const int s0 = lo > pb ? lo : pb, e0 = hi < pb + nb ? hi : pb + nb;
            if (e0 > s0) { s.P0 = bb * 256; s.jb = jl + (s0 - pb); s.je = jl + (e0 - pb); s.slot = (s0 == pb && e0 == pb + nb) ? (h >= 5 ? 512 + (h - 5) * 32 + bb : -1) : (pb < lo ? 2 * v : 2 * v + 1); return true; }
            if (pb + nb >= hi) b = 32; }
        return false; }
};
__device__ __forceinline__ void m1_att_select(const Ptrs& P, int l) {
    OPAQUE_TID();
    const int u = (int)blockIdx.x - (P.G - 96); if (u < 0) return;
    const int hs = u >> 5, b = u & 31, h = 5 + hs, r32 = lane & 31, hi = lane >> 5, row = b * 256 + wave * 32 + r32;
    const GAS bf16* qp = (const GAS bf16*)P.QKVH + ((size_t)h * S + row) * 128 + hi * 8; const GAS float* km = (const GAS float*)P.KSUM + (size_t)l * 32 * 1024 + h * 128 + (size_t)r32 * 1024 + hi * 8;
    mo::f32x16 g = {};
#pragma unroll
    for (int d0 = 0; d0 < 8; ++d0) { const bf16x8 q = *(const GAS bf16x8*)(qp + d0 * 16); const f32x4 a = *(const GAS f32x4*)(km + d0 * 16), c = *(const GAS f32x4*)(km + d0 * 16 + 4);
        const bf16x8 kh = mo::pack8(a, c); const unsigned short* khs = reinterpret_cast<const unsigned short*>(&kh);
        f32x4 ra, rb; ra[0] = a[0] - bf2f(khs[0]); ra[1] = a[1] - bf2f(khs[1]); ra[2] = a[2] - bf2f(khs[2]); ra[3] = a[3] - bf2f(khs[3]);
        rb[0] = c[0] - bf2f(khs[4]); rb[1] = c[1] - bf2f(khs[5]); rb[2] = c[2] - bf2f(khs[6]); rb[3] = c[3] - bf2f(khs[7]);
        g = __builtin_amdgcn_mfma_f32_32x32x16_bf16(kh, q, g, 0, 0, 0); g = __builtin_amdgcn_mfma_f32_32x32x16_bf16(mo::pack8(ra, rb), q, g, 0, 0, 0); }
    unsigned selm = 0u; const float NEG = -__builtin_inff();
#pragma unroll
    for (int k = 0; k < 3; ++k) { float bv = NEG; int bi = 64;
#pragma unroll
        for (int r = 0; r < 16; ++r) { const int n = mo::crow(r, hi); const float v = (n < b && !((selm >> n) & 1u)) ? g[r] : NEG; if (v > bv) { bv = v; bi = n; } }
        float ov; int oi; { auto rv = __builtin_amdgcn_permlane32_swap(__float_as_uint(bv), __float_as_uint(bv), false, false); auto ri = __builtin_amdgcn_permlane32_swap((unsigned)bi, (unsigned)bi, false, false);
            ov = __uint_as_float(hi ? rv[0] : rv[1]); oi = (int)(hi ? ri[0] : ri[1]); }
        if (ov > bv || (ov == bv && oi < bi)) { bv = ov; bi = oi; }
        if (bv > NEG) selm |= 1u << bi; }
    if (hi == 0) P.SEL[hs * S + row] = selm;
    int mine = 0;
    for (int n = 0; n < 31; ++n) { const int c = __popcll(__ballot(hi == 0 && ((selm >> n) & 1u))); if (lane == n) mine = c; }
    if (lane < 31 && mine) { atomicAdd(P.SELCNT + (l * 3 + hs) * 32 + lane, mine); atomicAdd(P.BCNT + ((l * 3 + hs) * 32 + lane) * 32 + b, mine); }
}
__device__ __forceinline__ void att_rowlist(const Ptrs& P, LAS unsigned char* lds3, int l, int hs, int n, int j, int tid) {
    const int lane = tid & 63, wave = tid >> 6;
    LAS int* rl = (LAS int*)(lds3 + mo::ATT_RL); LAS int* sll = (LAS int*)(lds3 + mo::ATT_SL); LAS int* wtot = (LAS int*)(lds3 + mo::ATT_WS);
    if (tid < 256) { rl[tid] = S - 1; sll[tid] = -1; }
    const int bc = __hip_atomic_load(P.BCNT + ((l * 3 + hs) * 32 + n) * 32 + (lane & 31), RLX_AGENT);
    int pre = 0, b0 = -1, b1 = 0, skip = 0;
    for (int bq = 0; bq < 32; ++bq) { const int c = __builtin_amdgcn_readlane(bc, bq); const int lo = pre, hi = pre + c; pre = hi;
        if (c > 0 && hi > 256 * j && lo < 256 * j + 256) { if (b0 < 0) { b0 = bq; skip = lo; } b1 = bq + 1; } }
    if (b0 < 0) { b0 = 31; b1 = 32; skip = 0; }
    const int base = 256 * b0, R = 256 * (b1 - b0), per = (R + 511) / 512;
    const GAS char* selp = (const GAS char*)((const GAS unsigned*)P.SEL + hs * S);
#define SELLD(r_) (*(const GAS unsigned*)(selp + (unsigned)(((r_) < S ? (r_) : S - 1) * 4)))
    int cnt = 0;
#pragma unroll 4
    for (int i = 0; i < 16; ++i) { const int r = base + tid * per + i; const unsigned x = SELLD(r); cnt += (i < per && tid * per + i < R) ? ((x >> n) & 1u) : 0u; }
    int inc = cnt;
#pragma unroll
    for (int o = 1; o < 64; o <<= 1) { const int t = __builtin_amdgcn_ds_bpermute(((lane - o) & 63) << 2, inc); if (lane >= o) inc += t; }
    if (lane == 63) wtot[wave] = inc;
    __syncthreads();
    int woff = 0;
#pragma unroll
    for (int w = 0; w < 8; ++w) { const int a = wtot[w]; if (w < wave) woff += a; }
    int rank = skip + woff + inc - cnt - 256 * j;
    int tid2 = tid; asm volatile("" : "+v"(tid2));
#pragma unroll 4
    for (int i = 0; i < 16; ++i) { const int r = base + tid2 * per + i; const unsigned x = SELLD(r);
        if (i < per && tid2 * per + i < R && ((x >> n) & 1u)) { if (rank >= 0 && rank < 256) { rl[rank] = r; sll[rank] = __popc(x & ((1u << n) - 1u)); } ++rank; } }
    __syncthreads();
#undef SELLD
}
__device__ __forceinline__ void m2_attn(const Ptrs& P, char* lds, LAS unsigned char* lds3, int l) {
    { const int v0 = blockIdx.x; if (v0 >= 256) return;
        const int v = (v0 & 7) * 32 + (v0 >> 3);
        int lane_p_; asm volatile("v_mbcnt_lo_u32_b32 %0, -1, 0\n\tv_mbcnt_hi_u32_b32 %0, -1, %0" : "=v"(lane_p_));
        if (v >= ATT_ND) {
            const int g = v - ATT_ND;
            LAS int* cntl = (LAS int*)(lds3 + RING_BYTES + 6144);
            { const int c0 = __hip_atomic_load(P.SELCNT + l * 96 + lane_p_, RLX_AGENT), c1 = __hip_atomic_load(P.SELCNT + l * 96 + 64 + (lane_p_ & 31), RLX_AGENT);
              if (P.wv == 0) { cntl[lane_p_] = c0; if (lane_p_ < 32) cntl[64 + lane_p_] = c1; } }
            __syncthreads();
            int ui = 0;
            for (int e = 0; e < 96; ++e) { if ((e & 31) == 31) continue; const int c = __builtin_amdgcn_readfirstlane(cntl[e]); const int nu = (c + 255) >> 8;
                int j = (g - ui % ATT_NG + ATT_NG) % ATT_NG;
                for (; j < nu; j += ATT_NG) {
                    const int hs = e >> 5, n = e & 31;
                    att_rowlist(P, lds3, l, hs, n, j, P.wv * 64 + lane_p_);
                    mo::Head H; H.ws = P.ws; H.h = 5 + hs; H.l = l; H.sl = exp2f(-(float)(6 + hs)) * (1.0f / mo::SCALE);
                    mo::Seg sg; sg.P0 = 0; sg.jb = 4 * n; sg.je = 4 * n + 4; sg.slot = 0;
                    mo::Seam Sm;
                    mo::att_prime<true>(H, sg, lds, lds3, Sm, P.wv);
                    mo::att_block<true>(H, sg, sg, lds, lds3, Sm, P.wv); }
                ui += nu; }
            return; }
        const AttPlan pl = att_plan(P.PLAN + l * 32, v, lane_p_); const int h = pl.h;
        mo::Head H; H.ws = P.ws; H.h = h; H.l = l; H.sl = exp2f(-(float)(h + 1)) * (1.0f / mo::SCALE);
        SegIter it; it.b = 0; it.pre = 0; it.lo = (pl.w * pl.T) / pl.W; it.hi = ((pl.w + 1) * pl.T) / pl.W; it.rt = pl.rt; it.v = v; it.h = h;
        mo::Seg cur, nxt; if (!it.next(cur)) return;
        bool more = it.next(nxt);
        mo::Seam Sm;
        mo::att_prime<false>(H, cur, lds, lds3, Sm, P.wv);
        for (;;) { const mo::Seg nx = more ? nxt : cur; mo::att_block<false>(H, cur, nx, lds, lds3, Sm, P.wv); if (!more) break; cur = nxt; more = it.next(nxt); }
    }
}
__device__ __forceinline__ void m3_attn_merge(const Ptrs& P, int l) {
    OPAQUE_TID();
    constexpr float C2 = 1.4426950408889634f * mo::SCALE;
    for (int s = blockIdx.x; s < 1024; s += P.G) { const int hb = s < 384 ? 160 + (s >> 2) : ((s - 384) >> 2), qt = s & 3; const int h = hb >> 5, b = hb & 31;
        int rt = 0, T = 1, W = 1, vbase = 0;
        { const int val = __hip_atomic_load(P.PLAN + l * 32 + (lane & 31), RLX_AGENT);
#pragma unroll
            for (int hh = 0; hh < 8; ++hh) if (hh == h) { rt = __builtin_amdgcn_readlane(val, 4 * hh); T = __builtin_amdgcn_readlane(val, 4 * hh + 1); vbase = __builtin_amdgcn_readlane(val, 4 * hh + 2); W = __builtin_amdgcn_readlane(val, 4 * hh + 3); } }
        int pb = 0; for (int bb = 0; bb < b; ++bb) { const int jl = 4 * bb - rt; pb += 4 * (bb + 1) - (jl > 0 ? jl : 0); }
        const int jl0 = 4 * b - rt, nb = 4 * (b + 1) - (jl0 > 0 ? jl0 : 0);
        int w1 = (pb * W) / T; while (w1 > 0 && (w1 * T) / W > pb) --w1; while (((w1 + 1) * T) / W <= pb) ++w1;
        const bool whole = (w1 * T) / W <= pb && ((w1 + 1) * T) / W >= pb + nb;
        if (whole && h < 5) continue;
        int slots[ATT_MAXP]; int np = 0;
#pragma unroll
        for (int k = 0; k < ATT_MAXP; ++k) { const int w = w1 + k, lo = (w * T) / W; const bool on = w < W && lo < pb + nb; slots[k] = on ? ((pb < lo) ? 2 * (vbase + w) : 2 * (vbase + w) + 1) : 0; np += on ? 1 : 0; }
        if (whole) { slots[0] = 512 + (h - 5) * 32 + b; np = 1; }
        const int c8 = (tid & 15) * 8, rbase = 64 * qt + (tid >> 4);
        if (np <= 2) {
            const bool two = np == 2, gath = h >= 5; const int s0 = slots[0], s1 = two ? slots[1] : slots[0];
            f32x2v mlA[2], mlB[2]; f32x4 oA[2][2], oB[2][2]; f32x2v gml[2][3]; f32x4 go[2][3][2]; unsigned selw[2] = {0u, 0u};
#pragma unroll
            for (int r = 0; r < 2; ++r) { const int row = rbase + 32 * r;
                mlA[r] = *(const GAS f32x2v*)((const GAS float*)P.PML + ((size_t)s0 * 256 + row) * 2); mlB[r] = *(const GAS f32x2v*)((const GAS float*)P.PML + ((size_t)s1 * 256 + row) * 2);
                const GAS float* o0 = (const GAS float*)P.T + ((size_t)s0 * 256 + row) * 128 + c8; const GAS float* o1 = (const GAS float*)P.T + ((size_t)s1 * 256 + row) * 128 + c8;
                oA[r][0] = *(const GAS f32x4*)o0; oA[r][1] = *(const GAS f32x4*)(o0 + 4); oB[r][0] = *(const GAS f32x4*)o1; oB[r][1] = *(const GAS f32x4*)(o1 + 4); }
            if (gath) {
#pragma unroll
                for (int r = 0; r < 2; ++r) { const int qrow = b * 256 + rbase + 32 * r; selw[r] = ((const GAS unsigned*)P.SEL)[(h - 5) * S + qrow];
                    const GAS float* gp = (const GAS float*)P.RPML + ((size_t)(h - 5) * S + qrow) * 6; const GAS float* rp = (const GAS float*)P.RP + ((size_t)(h - 5) * S + qrow) * 384 + c8;
#pragma unroll
                    for (int k = 0; k < 3; ++k) { gml[r][k] = *(const GAS f32x2v*)(gp + 2 * k); go[r][k][0] = *(const GAS f32x4*)(rp + k * 128); go[r][k][1] = *(const GAS f32x4*)(rp + k * 128 + 4); } } }
#pragma unroll
            for (int r = 0; r < 2; ++r) { const int row = rbase + 32 * r; const int ng = gath ? __popc(selw[r]) : 0;
                float M = mlA[r].x; if (two) M = fmaxf(M, mlB[r].x);
                if (gath) {
#pragma unroll
                    for (int k = 0; k < 3; ++k) M = fmaxf(M, k < ng ? gml[r][k].x : -3.0e38f); }
                const float wA = __builtin_amdgcn_exp2f((mlA[r].x - M) * C2), wB = two ? __builtin_amdgcn_exp2f((mlB[r].x - M) * C2) : 0.f;
                float den = wA * mlA[r].y + wB * mlB[r].y; f32x4 a0 = oA[r][0] * wA + oB[r][0] * wB, a1 = oA[r][1] * wA + oB[r][1] * wB;
                if (gath) {
#pragma unroll
                    for (int k = 0; k < 3; ++k) { const float wgt = k < ng ? __builtin_amdgcn_exp2f((gml[r][k].x - M) * C2) : 0.f; den += wgt * (k < ng ? gml[r][k].y : 0.f);
                        a0 += (k < ng ? go[r][k][0] : f32x4{0.f, 0.f, 0.f, 0.f}) * wgt; a1 += (k < ng ? go[r][k][1] : f32x4{0.f, 0.f, 0.f, 0.f}) * wgt; } }
                const float inv = 1.0f / den; a0 = a0 * inv; a1 = a1 * inv;
                v4u wv; wv.x = pk2(a0.x, a0.y); wv.y = pk2(a0.z, a0.w); wv.z = pk2(a1.x, a1.y); wv.w = pk2(a1.z, a1.w);
                ST16P((P.A3 + (size_t)(b * 256 + row) * 1024 + h * 128 + c8), wv); }
            continue;
        }
        for (int rr = 0; rr < 2; ++rr) { const int row = rbase + 32 * rr;
            float m[ATT_MAXP], lsum[ATT_MAXP]; float M = -3.0e38f;
#pragma unroll
            for (int k = 0; k < ATT_MAXP; ++k) if (k < np) { const float* ml = P.PML + ((size_t)slots[k] * 256 + row) * 2; m[k] = ml[0]; lsum[k] = ml[1]; M = fmaxf(M, m[k]); }
            f32x4 a0 = {0.f, 0.f, 0.f, 0.f}, a1 = a0; float den = 0.f;
#pragma unroll
            for (int k = 0; k < ATT_MAXP; ++k) if (k < np) { const float wgt = __builtin_amdgcn_exp2f((m[k] - M) * C2); den += wgt * lsum[k];
                const float* o = P.T + ((size_t)slots[k] * 256 + row) * 128 + c8; a0 += *(const f32x4*)o * wgt; a1 += *(const f32x4*)(o + 4) * wgt; }
            const float inv = 1.0f / den; a0 = a0 * inv; a1 = a1 * inv;
            v4u wv; wv.x = pk2(a0.x, a0.y); wv.y = pk2(a0.z, a0.w); wv.z = pk2(a1.x, a1.y); wv.w = pk2(a1.z, a1.w);
            ST16P((P.A3 + (size_t)(b * 256 + row) * 1024 + h * 128 + c8), wv); }
    }
}
__device__ __forceinline__ void m3_gla_out(const Ptrs& P, LAS unsigned char* lds, int l) {
    OPAQUE_TID();
    LAS float* bcum = (LAS float*)lds; LAS unsigned char* QI = lds + 32768; LAS unsigned char* KI = lds + 50176; LAS unsigned char* VL = lds + 67584; LAS unsigned char* XS = lds + 104448; LAS float* tot = (LAS float*)(lds + 113664);
    LAS unsigned char* OL = lds;
    const int hl = lane >> 5, fc = tid >> 3, fpart = tid & 7;
    f32x4 gw[8]; { const GAS f32x4* gp = (const GAS f32x4*)(P.gla_norm_w + l * 256 + 32 * fpart);
#pragma unroll
        for (int j = 0; j < 8; ++j) gw[j] = gp[j]; }
    for (int unit = blockIdx.x; unit < 512; unit += P.G) { const int h = unit >> 7, n = unit & 127, t0 = n * 64;

        float la[16]; { const GAS float* p = (const GAS float*)P.LA + (size_t)(t0 + 16 * (tid >> 7)) * 512 + h * 128 + (tid & 127);
#pragma unroll
            for (int i = 0; i < 16; ++i) la[i] = p[(size_t)i * 512]; }
        v4u qq[2], kq[2], vv[4], rv[4]; bf16x8 spf[8];
#pragma unroll
        for (int i = 0; i < 2; ++i) { const int idx = tid + 512 * i, s = idx >> 4, ch = idx & 15; const GAS bf16* pr = (const GAS bf16*)P.PROJ + (size_t)(t0 + s) * LDP + h * 128 + 8 * ch;
            qq[i] = *(const GAS v4u*)(pr + PC_QG); kq[i] = *(const GAS v4u*)(pr + PC_KG); }
#pragma unroll
        for (int j = 0; j < 4; ++j) { const int idx = tid + 512 * j, s = idx >> 5, ch = idx & 31; vv[j] = *(const GAS v4u*)((const GAS bf16*)P.PROJ + (size_t)(t0 + s) * LDP + PC_VG + h * 256 + 8 * ch); }
        { const GAS bf16* spt = (const GAS bf16*)P.SPT + ((size_t)(h * 128 + n) * 256 + 32 * wave + (lane & 31)) * 128 + 8 * hl;
#pragma unroll
            for (int kk = 0; kk < 8; ++kk) spf[kk] = *(const GAS bf16x8*)(spt + 16 * kk); }
        { const GAS bf16* rp = (const GAS bf16*)P.PROJ + (size_t)(t0 + fc) * LDP + PC_RG + h * 256 + 32 * fpart;
#pragma unroll
            for (int j = 0; j < 4; ++j) rv[j] = *(const GAS v4u*)(rp + 8 * j); }
        gla_cumsum(la, tid, tot, bcum);

#pragma unroll
        for (int i = 0; i < 2; ++i) { const int idx = tid + 512 * i, s = idx >> 4, ch = idx & 15;
            const f32x4 b0 = *(const LAS f32x4*)(bcum + s * 128 + 8 * ch), b1 = *(const LAS f32x4*)(bcum + s * 128 + 8 * ch + 4);
            const float bb[8] = {b0.x, b0.y, b0.z, b0.w, b1.x, b1.y, b1.z, b1.w}; float q[8], k[8], qi[8], ki[8]; unpack8(qq[i], q); unpack8(kq[i], k);
#pragma unroll
            for (int j = 0; j < 8; ++j) { qi[j] = q[j] * 0.08838834764831845f * __expf(bb[j]); ki[j] = k[j] * __expf(-bb[j]); }
            v4u w; w.x = pk2(qi[0], qi[1]); w.y = pk2(qi[2], qi[3]); w.z = pk2(qi[4], qi[5]); w.w = pk2(qi[6], qi[7]); *(LAS v4u*)(QI + s * GL_QK_STRIDE + ch * 16) = w;
            w.x = pk2(ki[0], ki[1]); w.y = pk2(ki[2], ki[3]); w.z = pk2(ki[4], ki[5]); w.w = pk2(ki[6], ki[7]); *(LAS v4u*)(KI + s * GL_QK_STRIDE + ch * 16) = w; }
#pragma unroll
        for (int j = 0; j < 4; ++j) { const int idx = tid + 512 * j, s = idx >> 5, ch = idx & 31; *(LAS v4u*)(VL + s * GL_VL_STRIDE + ch * 16) = vv[j]; }
        __syncthreads();

        if (wave < 3) {
            const int ct = wave > 0 ? 1 : 0, st = wave > 1 ? 1 : 0; f32x16 x;
#pragma unroll
            for (int r = 0; r < 16; ++r) x[r] = 0.f;
#pragma unroll
            for (int kk = 0; kk < 8; ++kk) x = __builtin_amdgcn_mfma_f32_32x32x16_bf16(row_frag(QI, GL_QK_STRIDE, 32 * ct, 16 * kk, lane), row_frag(KI, GL_QK_STRIDE, 32 * st, 16 * kk, lane), x, 0, 0, 0);
#pragma unroll
            for (int r = 0; r < 16; ++r) { const int c = 32 * ct + crow(r, hl), sidx = 32 * st + (lane & 31); *(LAS bf16*)(XS + c * GL_XS_STRIDE + sidx * 2) = (bf16)f2bf(sidx <= c ? x[r] : 0.f); }
        } else if (wave == 3) {
#pragma unroll
            for (int r = 0; r < 16; ++r) *(LAS bf16*)(XS + crow(r, hl) * GL_XS_STRIDE + (32 + (lane & 31)) * 2) = (bf16)0;
        }
        f32x16 acc0, acc1;
#pragma unroll
        for (int r = 0; r < 16; ++r) { acc0[r] = 0.f; acc1[r] = 0.f; }
#pragma unroll
        for (int kk = 0; kk < 8; ++kk) {
            acc0 = __builtin_amdgcn_mfma_f32_32x32x16_bf16(row_frag(QI, GL_QK_STRIDE, 0, 16 * kk, lane), spf[kk], acc0, 0, 0, 0);
            acc1 = __builtin_amdgcn_mfma_f32_32x32x16_bf16(row_frag(QI, GL_QK_STRIDE, 32, 16 * kk, lane), spf[kk], acc1, 0, 0, 0); }
        __syncthreads();
#pragma unroll
        for (int ks = 0; ks < 4; ++ks) { const bf16x8 bfr = tr_frag(VL, GL_VL_STRIDE, 16 * ks, 32 * wave, lane);
            acc0 = __builtin_amdgcn_mfma_f32_32x32x16_bf16(row_frag(XS, GL_XS_STRIDE, 0, 16 * ks, lane), bfr, acc0, 0, 0, 0);
            acc1 = __builtin_amdgcn_mfma_f32_32x32x16_bf16(row_frag(XS, GL_XS_STRIDE, 32, 16 * ks, lane), bfr, acc1, 0, 0, 0); }
        __syncthreads();

#pragma unroll
        for (int r = 0; r < 16; ++r) { *(LAS float*)(OL + crow(r, hl) * GL_OL_STRIDE + (32 * wave + (lane & 31)) * 4) = acc0[r]; *(LAS float*)(OL + (32 + crow(r, hl)) * GL_OL_STRIDE + (32 * wave + (lane & 31)) * 4) = acc1[r]; }
        __syncthreads();
        { const int row = t0 + fc; float o[32]; float ss = 0.f;
#pragma unroll
            for (int j = 0; j < 8; ++j) { const f32x4 v = *(const LAS f32x4*)(OL + fc * GL_OL_STRIDE + (32 * fpart + 4 * j) * 4); o[4 * j] = v.x; o[4 * j + 1] = v.y; o[4 * j + 2] = v.z; o[4 * j + 3] = v.w; ss += (v.x * v.x + v.y * v.y) + (v.z * v.z + v.w * v.w); }
            ss += xshfl<1>(ss); ss += xshfl<2>(ss); ss += xshfl<4>(ss);
            const float inv = rsqrtf(ss * (1.0f / 256.0f) + RMS_EPS);
            GAS bf16* op = (GAS bf16*)P.A3 + (size_t)S * 1024 + (size_t)row * 1024 + h * 256 + 32 * fpart;
#pragma unroll
            for (int j = 0; j < 4; ++j) { float r[8], y[8]; unpack8(rv[j], r); const f32x4 g0 = gw[2 * j], g1 = gw[2 * j + 1]; const float gg[8] = {g0.x, g0.y, g0.z, g0.w, g1.x, g1.y, g1.z, g1.w};
#pragma unroll
                for (int bq = 0; bq < 8; ++bq) y[bq] = o[8 * j + bq] * inv * gg[bq] * (r[bq] / (1.0f + __expf(-r[bq])));
                v4u w; w.x = pk2(y[0], y[1]); w.y = pk2(y[2], y[3]); w.z = pk2(y[4], y[5]); w.w = pk2(y[6], y[7]);
                ST16((op + 8 * j), w); } }
        __syncthreads();

    }
}

__global__ void __launch_bounds__(NWAVES * 64, 2) mk_fwd(Args args) {
    extern __shared__ __attribute__((aligned(16))) unsigned char lds_raw[];
    LAS unsigned char* lds = (LAS unsigned char*)lds_raw;
    const int wv = __builtin_amdgcn_readfirstlane((int)threadIdx.x >> 6);
#define LOAD_PTRS() Ptrs P; do { KPTR kp_ = (KPTR)__builtin_amdgcn_kernarg_segment_ptr(); asm volatile("" : "+s"(kp_)); fill_ptrs(P, kp_, wv); } while (0)
    for (int u = threadIdx.x; u < (LDS_BYTES - LDSCTL_OFF) / 4; u += NWAVES * 64) ((LAS unsigned*)(lds + LDSCTL_OFF))[u] = 0u;
    __syncthreads();
    const int lo = args.ph_lo, hi = args.ph_hi;
    unsigned* barw = (unsigned*)(args.ws + WS_CTL) + CW_BAR + args.li * XCD_BAR_WORDS;
    XcdBarrier bar; bar.bar = barw; bar.x = 0; bar.st = nullptr;
    if (hi - lo > 1) bar = xcd_barrier_post(barw, (volatile LAS unsigned*)(lds + MISC_OFF) + 8);
#define IN(k) (lo <= (k) && (k) < hi)
#define SEAM(k) do { if ((k) + 1 < hi) { int l0_; asm volatile("v_mbcnt_lo_u32_b32 %0, -1, 0\n\tv_mbcnt_hi_u32_b32 %0, -1, %0" : "=v"(l0_)); xcd_barrier(bar, wv == 0 && l0_ == 0); } } while (0)
 if (IN(0)) { LOAD_PTRS(); p0_prologue(P, lds); SEAM(0); }
    for (int l = 0; l < NL; ++l) {
        const int pb = 1 + 8 * l;

        if (IN(pb + 0)) {
            LOAD_PTRS(); unsigned char* wl = P.ws + WS_W + (size_t)l * WL_BYTES;
            pg8::Gemm g{P.XB, (const bf16*)(wl + WL_IN), S, NPROJ, D}; pg8::StaticOrder So; So.init(S, NPROJ, P.G, (int)blockIdx.x);
            EpiProj E{P.PROJ, P.QKVH, P.LA, P.stats + (size_t)(2 * l) * S, P.gla_b + l * 512, P.KSUM + (size_t)l * 32 * 1024, P.QKMAX + l * 64};
            pg8::gemm_phase<EpiProj, pg8::StaticOrder, true, true>(lds, g, So, E, P.wv);
            if (l + 1 < NL && (int)blockIdx.x >= 192) convert_items(P, lds, R_T1, l + 1, 0, 1, 0, 0, 0, (int)blockIdx.x - 192, 64);
            SEAM(pb + 0); }

        if (IN(pb + 1)) { LOAD_PTRS(); { m1_att_select(P, l); m1_kmean_conv(P, l);  m1_gla_local(P, lds); } SEAM(pb + 1); }

        if (IN(pb + 2)) { LOAD_PTRS(); m2_gla_scan(P);  m2_attn(P, (char*)lds_raw, lds, l);  SEAM(pb + 2); }

        if (IN(pb + 3)) { LOAD_PTRS(); { m3_attn_merge(P, l);  m3_gla_out(P, lds, l); } SEAM(pb + 3); }

        if (IN(pb + 4)) {
            LOAD_PTRS(); unsigned char* wl = P.ws + WS_W + (size_t)l * WL_BYTES;
            pg8::Gemm g{P.A3, (const bf16*)(wl + WL_BR), 3 * S, 3 * D, 1024}; BranchOrder Bo; Bo.so.init(S, D, P.G, (int)blockIdx.x);
            EpiBranch E{P.PROJ, P.MIXED};
            pg8::gemm_phase<EpiBranch, BranchOrder, true, true>(lds, g, Bo, E, P.wv);
            SEAM(pb + 4); }

        if (IN(pb + 5)) {
            LOAD_PTRS(); unsigned char* wl = P.ws + WS_W + (size_t)l * WL_BYTES;
            pg8::Gemm g{P.MIXED, (const bf16*)(wl + WL_OUT), S, D, D}; pg8::StaticOrder So; So.init(S, D, P.G, (int)blockIdx.x);
            EpiResid E{P.XB, P.stats + (size_t)(2 * l + 1) * S};
            pg8::gemm_phase<EpiResid, pg8::StaticOrder, true, true>(lds, g, So, E, P.wv);
            SEAM(pb + 5); }

        if (IN(pb + 6)) {
            LOAD_PTRS(); unsigned char* wl = P.ws + WS_W + (size_t)l * WL_BYTES;
            pg8::Gemm g{P.XB, (const bf16*)(wl + WL_GU), S, 2 * DFF, D}; pg8::StaticOrder So; So.init(S, 2 * DFF, P.G, (int)blockIdx.x);
            EpiGU E{P.ACT, P.stats + (size_t)(2 * l + 1) * S};
            pg8::gemm_phase<EpiGU, pg8::StaticOrder, true, true>(lds, g, So, E, P.wv);
            if (l + 1 < NL && (int)blockIdx.x >= 128) convert_items(P, lds, R_TAIL - R_T1, l + 1, R_T1, 1, 0, 0, 0, (int)blockIdx.x - 128, 128);
            SEAM(pb + 6); }

        if (IN(pb + 7)) {
            LOAD_PTRS(); unsigned char* wl = P.ws + WS_W + (size_t)l * WL_BYTES;
            pg8::Gemm g{P.ACT, (const bf16*)(wl + WL_DN), S, D, DFF}; pg8::StaticOrder So; So.init(S, D, P.G, (int)blockIdx.x);
            EpiResid E{P.XB, P.stats + (size_t)(2 * l + 2) * S};
            pg8::gemm_phase<EpiResid, pg8::StaticOrder, true, true>(lds, g, So, E, P.wv);
            SEAM(pb + 7); }

    }
    if (IN(NPH - 1)) { LOAD_PTRS(); final_norm(P); }
#undef IN
#undef SEAM
}

#ifndef MK_SPLIT
#define MK_SPLIT 0
#endif
extern "C" void kernel_launch(void* const* d_in, const int* in_sizes, int n_in, void* d_out, int out_size, void* d_ws, size_t ws_size, hipStream_t stream) {
    static int grid = 0;
    if (grid == 0) {
        if (n_in != 16 || out_size != S * D || ws_size < WS_END) { fprintf(stderr, "kernel_launch: unexpected shapes (n_in %d out %d ws %zu)\n", n_in, out_size, ws_size); grid = -1; return; }
        int dev = 0, cus = 0, per_cu = 0;
        if (hipGetDevice(&dev) != hipSuccess || hipDeviceGetAttribute(&cus, hipDeviceAttributeMultiprocessorCount, dev) != hipSuccess) { grid = -1; return; }
        if (hipFuncSetAttribute((const void*)mk_fwd, hipFuncAttributeMaxDynamicSharedMemorySize, LDS_BYTES) != hipSuccess) { fprintf(stderr, "kernel_launch: hipFuncSetAttribute failed\n"); grid = -1; return; }
        if (hipOccupancyMaxActiveBlocksPerMultiprocessor(&per_cu, (const void*)mk_fwd, NWAVES * 64, LDS_BYTES) != hipSuccess || per_cu < 1) fprintf(stderr, "kernel_launch: occupancy query says %d\n", per_cu);
        (void)hipGetLastError();
        grid = cus;
        if (cus != 256) { fprintf(stderr, "kernel_launch: built for 256 CUs, found %d\n", cus); grid = -1; return; }
    }
    if (grid < 0) return;
    if (hipMemsetAsync((char*)d_ws + WS_CTL, 0, CTL_ZERO_BYTES, stream) != hipSuccess) return;
    Args a{};
    for (int i = 0; i < 16; ++i) a.in[i] = (const float*)d_in[i];
    a.out = (float*)d_out; a.ws = (unsigned char*)d_ws; a.pad = 0;
#if MK_SPLIT
    for (int p = 0; p < NPH; ++p) { a.ph_lo = p; a.ph_hi = p + 1; a.li = 0; hipLaunchKernelGGL(mk_fwd, dim3(grid), dim3(NWAVES * 64), LDS_BYTES, stream, a); }
#else
    a.ph_lo = 0; a.ph_hi = NPH; a.li = 0;
    hipLaunchKernelGGL(mk_fwd, dim3(grid), dim3(NWAVES * 64), LDS_BYTES, stream, a);
#endif
}
```

```cpp
#include <hip/hip_runtime.h>
#include <cstdio>
#include <cstdint>
#include <cmath>
namespace pg8 {
#define PG8_LAS __attribute__((address_space(3)))
typedef unsigned short bf16_t;
typedef short bf16x8 __attribute__((ext_vector_type(8)));
typedef float f32x4 __attribute__((ext_vector_type(4)));
typedef unsigned u32x4 __attribute__((ext_vector_type(4)));
constexpr int BM = 256, BK = 64, HALF = 128, HTB = HALF * BK * 2  , STAGE_BYTES = 8 * HTB, NXCD = 8, WGM = 8;

__host__ __device__ __forceinline__ int lds_byte(int r, int c) { const int st = (r >> 4) * 2 + (c >> 5), rr = r & 15, cc = c & 31, ob = rr * 64 + cc * 2; return st * 1024 + (ob ^ (((ob >> 9) & 1) << 5)); }
__host__ __device__ __forceinline__ void stage_rc(int b, int& R, int& C) { const int st = b / 1024, sb = b % 1024, swz = sb ^ (((sb >> 9) & 1) << 5); R = (st >> 1) * 16 + swz / 64; C = (st & 1) * 32 + (swz % 64) / 2; }
__host__ __device__ __forceinline__ int perm32(int rho) { const int n = rho >> 4, i = rho & 15; return 8 * (i >> 2) + 4 * n + (i & 3); }

struct Unit { int pm, pn; };
struct Gemm { const bf16_t* A; const bf16_t* Bt; int M, N, K; };

struct StaticOrder {
    int nM, nN, nwg, G, c;
    __host__ __device__ void init(int M, int N, int G_, int c_) { nM = M / BM; nN = N / BM; nwg = nM * nN; G = G_; c = c_; }
    __host__ __device__ bool next(int i, Unit& u) const {
        const long L = (long)i * G + c; if (L >= nwg) return false;
        int wgid = (int)L; { const int q = nwg / NXCD, r = nwg % NXCD, xcd = wgid % NXCD, off = wgid / NXCD; wgid = (xcd < r ? xcd * (q + 1) : r * (q + 1) + (xcd - r) * q) + off; }
        const int nig = WGM * nN, gid = wgid / nig, fm = gid * WGM, gsz = (nM - fm) < WGM ? (nM - fm) : WGM;
        u.pm = fm + ((wgid % nig) % gsz); u.pn = (wgid % nig) / gsz; return true;
    }
    __device__ __forceinline__ void a_ready(const Unit&) const {}
    __device__ __forceinline__ void done(const Unit&) const {}
};

__device__ __forceinline__ unsigned cvt_pk_bf16(float lo, float hi) { unsigned r; asm volatile("v_cvt_pk_bf16_f32 %0, %1, %2" : "=v"(r) : "v"(lo), "v"(hi)); return r; }
template <class Epi, class Sched, bool ALIGN_EPI = false, bool SP2 = false>
__device__ __forceinline__ void gemm_phase(PG8_LAS unsigned char* lds, const Gemm g, const Sched& S, const Epi& E, int wave_sgpr) {
    int tid_; asm volatile("v_mbcnt_lo_u32_b32 %0, -1, 0\n\tv_mbcnt_hi_u32_b32 %0, -1, %0" : "=v"(tid_)); tid_ += wave_sgpr * 64;
    const int tid = tid_, wid = __builtin_amdgcn_readfirstlane(tid >> 6), lane = tid & 63, wr = wid >> 2, wc = wid & 3, fr = lane & 15, fq = lane >> 4;
    const int K = g.K, nt = K / BK;
    unsigned voffA[2], voffB[2];
#pragma unroll
    for (int i = 0; i < 2; ++i) { int R, C; stage_rc(tid * 16 + i * 8192, R, C); const int Rb = Epi::PERM ? ((R & ~31) + perm32(R & 31)) : R;
        voffA[i] = (unsigned)(R * K + C) * 2u; voffB[i] = (unsigned)(Rb * K + C) * 2u; }
    const size_t kstep = (size_t)(BK * 2);
    const size_t hstep = (size_t)HALF * K * 2;
    const size_t tstep = 2 * hstep;
    const unsigned ldsw = (unsigned)wid * 1024u;
    const int aoff = lds_byte(wr * 64 + fr, fq * 8), boff = lds_byte(wc * 32 + fr, fq * 8);
#define PG8_SA(b, h) (((b) * 2 + (h)) * HTB)
#define PG8_SB(b, h) ((4 + (b) * 2 + (h)) * HTB)
#define PG8_STAGE(bufoff, gbase, voff) do { _Pragma("unroll") for (int _i = 0; _i < 2; ++_i) \
        __builtin_amdgcn_global_load_lds((const unsigned*)((const char*)(gbase) + (voff)[_i]), (PG8_LAS unsigned*)(lds + (bufoff) + ldsw + _i * 8192), 16, 0, 0); } while (0)
#define PG8_LDA(dst, b, h) do { _Pragma("unroll") for (int m = 0; m < 4; ++m) _Pragma("unroll") for (int k = 0; k < 2; ++k) dst[m][k] = *(const PG8_LAS bf16x8*)(lds + PG8_SA(b, h) + aoff + m * 2048 + k * 1024); } while (0)
#define PG8_LDB(dst, b, h) do { _Pragma("unroll") for (int n = 0; n < 2; ++n) _Pragma("unroll") for (int k = 0; k < 2; ++k) dst[n][k] = *(const PG8_LAS bf16x8*)(lds + PG8_SB(b, h) + boff + n * 2048 + k * 1024); } while (0)
#define PG8_MMA(ai, bj, At, Bt) do { __builtin_amdgcn_s_setprio(1); _Pragma("unroll") for (int m = 0; m < 4; ++m) _Pragma("unroll") for (int n = 0; n < 2; ++n) _Pragma("unroll") for (int k = 0; k < 2; ++k) \
        acc[ai][bj][m][n] = __builtin_amdgcn_mfma_f32_16x16x32_bf16(Bt[n][k], At[m][k], acc[ai][bj][m][n], 0, 0, 0); __builtin_amdgcn_s_setprio(0); } while (0)
#define PG8_WAIT_V(n) asm volatile("s_waitcnt vmcnt(" #n ")" ::: "memory")
#define PG8_WAIT_L(n) asm volatile("s_waitcnt lgkmcnt(" #n ")" ::: "memory")
#define PG8_BAR __builtin_amdgcn_s_barrier()
#define PG8_SCHED __builtin_amdgcn_sched_barrier(0)
    Unit cur, nxt; int ui = 0;
    if (!S.next(0, cur)) return;
    typename Epi::Pre pre; E.pre(pre, cur, wr, wc, fr, fq);
    typename Epi::Ini ini; if constexpr (Epi::INIT) E.init_load(ini, cur, wr, wc, fr, fq);
    f32x4 acc[2][2][4][2];
    if constexpr (!Epi::INIT) {
#pragma unroll
    for (int a = 0; a < 2; ++a)
#pragma unroll
        for (int b = 0; b < 2; ++b)
#pragma unroll
            for (int m = 0; m < 4; ++m)
#pragma unroll
                for (int n = 0; n < 2; ++n) acc[a][b][m][n] = (f32x4){0.f, 0.f, 0.f, 0.f};
    }
    bf16x8 At[4][2], B0[2][2], B1[2][2];
    const char* cA = (const char*)g.A + (size_t)cur.pm * tstep; const char* cB = (const char*)g.Bt + (size_t)cur.pn * tstep;
    S.a_ready(cur);
    if constexpr (SP2) {
        PG8_STAGE(PG8_SB(0, 0), cB, voffB); PG8_STAGE(PG8_SB(0, 1), cB + hstep, voffB); PG8_STAGE(PG8_SA(0, 0), cA, voffA); PG8_STAGE(PG8_SA(0, 1), cA + hstep, voffA);
        if (wr == 1) PG8_BAR;
        PG8_WAIT_V(2); PG8_BAR;
        PG8_STAGE(PG8_SB(1, 0), cB + kstep, voffB); PG8_STAGE(PG8_SA(1, 0), cA + kstep, voffA); PG8_STAGE(PG8_SB(1, 1), cB + hstep + kstep, voffB);
        PG8_WAIT_V(6); PG8_BAR;
    } else {
        PG8_STAGE(PG8_SB(0, 0), cB, voffB); PG8_STAGE(PG8_SA(0, 0), cA, voffA); PG8_STAGE(PG8_SB(0, 1), cB + hstep, voffB); PG8_STAGE(PG8_SA(0, 1), cA + hstep, voffA);
        if (wr == 1) PG8_BAR;
        PG8_WAIT_V(4); PG8_BAR;
        PG8_STAGE(PG8_SB(1, 0), cB + kstep, voffB); PG8_STAGE(PG8_SA(1, 0), cA + kstep, voffA); PG8_STAGE(PG8_SB(1, 1), cB + hstep + kstep, voffB);
        PG8_WAIT_V(6); PG8_BAR;
    }
    if constexpr (Epi::INIT) E.init_apply(acc, ini);
    for (;;) {
        const bool has_next = S.next(ui + 1, nxt);
        const char* nA = has_next ? (const char*)g.A + (size_t)nxt.pm * tstep : cA; const char* nB = has_next ? (const char*)g.Bt + (size_t)nxt.pn * tstep : cB;
        for (int t = 0; t < nt; t += 2) {
            const bool last = (t == nt - 2);
            const char* a1 = cA + (size_t)(t + 1) * kstep;
            const char* a2 = last ? nA : cA + (size_t)(t + 2) * kstep; const char* b2 = last ? nB : cB + (size_t)(t + 2) * kstep;
            const char* a3 = a2 + kstep; const char* b3 = b2 + kstep;
            if (last && has_next) S.a_ready(nxt);
            if constexpr (SP2) {
            PG8_LDB(B0, 0, 0); PG8_LDB(B1, 0, 1); PG8_SCHED; PG8_LDA(At, 0, 0); PG8_STAGE(PG8_SA(1, 1), a1 + hstep, voffA);
            PG8_WAIT_V(8); PG8_WAIT_L(0); PG8_BAR; PG8_MMA(0, 0, At, B0); PG8_MMA(0, 1, At, B1); PG8_BAR; PG8_SCHED;
            PG8_LDA(At, 0, 1); PG8_STAGE(PG8_SB(0, 0), b2, voffB); PG8_STAGE(PG8_SB(0, 1), b2 + hstep, voffB); PG8_STAGE(PG8_SA(0, 0), a2, voffA);
            PG8_WAIT_V(8); PG8_WAIT_L(0); PG8_BAR; PG8_MMA(1, 0, At, B0); PG8_MMA(1, 1, At, B1); PG8_BAR; PG8_SCHED;
            PG8_LDB(B0, 1, 0); PG8_LDB(B1, 1, 1); PG8_SCHED; PG8_LDA(At, 1, 0); PG8_STAGE(PG8_SA(0, 1), a2 + hstep, voffA);
            PG8_WAIT_V(8); PG8_WAIT_L(0); PG8_BAR; PG8_MMA(0, 0, At, B0); PG8_MMA(0, 1, At, B1); PG8_BAR; PG8_SCHED;
            PG8_LDA(At, 1, 1); PG8_STAGE(PG8_SB(1, 0), b3, voffB); PG8_STAGE(PG8_SB(1, 1), b3 + hstep, voffB); PG8_STAGE(PG8_SA(1, 0), a3, voffA);
            PG8_WAIT_V(8); PG8_WAIT_L(0); PG8_BAR; PG8_MMA(1, 0, At, B0); PG8_MMA(1, 1, At, B1); PG8_BAR; PG8_SCHED;
            } else {
            PG8_LDB(B0, 0, 0); PG8_SCHED; PG8_LDA(At, 0, 0); PG8_STAGE(PG8_SA(1, 1), a1 + hstep, voffA);
            PG8_WAIT_L(8); PG8_BAR; PG8_WAIT_L(0); PG8_MMA(0, 0, At, B0); PG8_BAR; PG8_SCHED;
            PG8_LDB(B1, 0, 1); PG8_STAGE(PG8_SB(0, 0), b2, voffB);
            PG8_BAR; PG8_WAIT_L(0); PG8_MMA(0, 1, At, B1); PG8_BAR;
            PG8_LDA(At, 0, 1); PG8_STAGE(PG8_SA(0, 0), a2, voffA);
            PG8_BAR; PG8_WAIT_L(0); PG8_MMA(1, 0, At, B0); PG8_BAR; PG8_SCHED;
            PG8_STAGE(PG8_SB(0, 1), b2 + hstep, voffB);
            PG8_WAIT_V(6); PG8_BAR; PG8_MMA(1, 1, At, B1); PG8_BAR;
            PG8_LDB(B0, 1, 0); PG8_SCHED; PG8_LDA(At, 1, 0); PG8_STAGE(PG8_SA(0, 1), a2 + hstep, voffA);
            PG8_WAIT_L(8); PG8_BAR; PG8_WAIT_L(0); PG8_MMA(0, 0, At, B0); PG8_BAR; PG8_SCHED;
            PG8_LDB(B1, 1, 1); PG8_STAGE(PG8_SB(1, 0), b3, voffB);
            PG8_BAR; PG8_WAIT_L(0); PG8_MMA(0, 1, At, B1); PG8_BAR;
            PG8_LDA(At, 1, 1); PG8_STAGE(PG8_SA(1, 0), a3, voffA);
            PG8_BAR; PG8_WAIT_L(0); PG8_MMA(1, 0, At, B0); PG8_BAR; PG8_SCHED;
            PG8_STAGE(PG8_SB(1, 1), b3 + hstep, voffB);
            PG8_WAIT_V(6); PG8_BAR; PG8_MMA(1, 1, At, B1); PG8_BAR;
            }
        }
        if constexpr (ALIGN_EPI) { if (wr == 0) PG8_BAR; }
        if constexpr (!Epi::AFTER_DRAIN) { E(acc, cur, wr, wc, fr, fq, pre); S.done(cur); }
        if (!has_next) break;
        bool carry = false; if constexpr (Epi::CARRY) carry = E.carry(cur);
        if (!carry) {
        if constexpr (Epi::INIT) { E.init_load(ini, nxt, wr, wc, fr, fq); E.init_apply(acc, ini); } else {
#pragma unroll
        for (int a = 0; a < 2; ++a)
#pragma unroll
            for (int b = 0; b < 2; ++b)
#pragma unroll
                for (int m = 0; m < 4; ++m)
#pragma unroll
                    for (int n = 0; n < 2; ++n) acc[a][b][m][n] = (f32x4){0.f, 0.f, 0.f, 0.f};
        } }
        E.pre(pre, nxt, wr, wc, fr, fq);
        cur = nxt; cA = nA; cB = nB; ++ui;
        if constexpr (ALIGN_EPI) { if (wr == 1) PG8_BAR; }
    }
    PG8_WAIT_V(0);
    if constexpr (!ALIGN_EPI) { if (wr == 0) PG8_BAR; }
    PG8_BAR;
    if constexpr (Epi::AFTER_DRAIN) { E.fused(acc, cur, wr, wc, fr, fq, lds, wid, lane); S.done(cur); }
#undef PG8_SA
#undef PG8_SB
#undef PG8_STAGE
#undef PG8_LDA
#undef PG8_LDB
#undef PG8_MMA
#undef PG8_WAIT_V
#undef PG8_WAIT_L
#undef PG8_BAR
#undef PG8_SCHED
}
}
#define GAS __attribute__((address_space(1)))
#define LAS __attribute__((address_space(3)))
typedef unsigned short bf16;
typedef unsigned v4u __attribute__((ext_vector_type(4)));
typedef float f32x4 __attribute__((ext_vector_type(4)));
typedef short bf16x8 __attribute__((ext_vector_type(8)));
typedef GAS unsigned gu32;
typedef GAS unsigned long long gu64;
#define RLX_AGENT __ATOMIC_RELAXED, __HIP_MEMORY_SCOPE_AGENT
#define LDS_WAIT() asm volatile("s_waitcnt lgkmcnt(0)" ::: "memory")
#define VM_WAIT() asm volatile("s_waitcnt vmcnt(0)" ::: "memory")
__device__ __forceinline__ unsigned long long rt() { return __builtin_amdgcn_s_memrealtime(); }
__device__ __forceinline__ unsigned f2bf(float f) { unsigned u = __builtin_bit_cast(unsigned, f); return (u + 0x7fffu + ((u >> 16) & 1u)) >> 16; }
__device__ __forceinline__ unsigned pk2(float lo, float hi) { return f2bf(lo) | (f2bf(hi) << 16); }
#define XB_TMO      128
#define XB_XCNT(j)  (256  + 64 * (j))
#define XB_XSUB(j)  (1280 + 64 * (j))
#define XB_XGEN(j)  (2304 + 64 * (j))
#define XB_TOP      3328
#define XB_TOPGEN   3392
#define XCD_BAR_WORDS 3456
#define XB_SPIN_CAP (1u << 18)

__device__ __forceinline__ unsigned xb_ld(unsigned* p)              { return __hip_atomic_load(p, __ATOMIC_RELAXED, __HIP_MEMORY_SCOPE_AGENT); }
__device__ __forceinline__ unsigned xb_add(unsigned* p, unsigned v) { return __hip_atomic_fetch_add(p, v, __ATOMIC_RELAXED, __HIP_MEMORY_SCOPE_AGENT); }
__device__ __forceinline__ unsigned xb_xcc_id() { return (unsigned)__builtin_amdgcn_s_getreg((3 << 11) | 20) & 0xFu; }
#define XB_SPIN(cond, bar) do { unsigned _sp = 0; while (cond) { __builtin_amdgcn_s_sleep(1); \
    if ((++_sp & 255u) == 0u) { if (xb_ld(&(bar)[XB_TMO])) break; if (_sp > XB_SPIN_CAP) { atomicAdd(&(bar)[XB_TMO], 1u); break; } } } } while (0)

struct XcdBarrier {
    unsigned* bar; unsigned x;
    volatile LAS unsigned* st;
};

__device__ __forceinline__ XcdBarrier xcd_barrier_post(unsigned* bar, volatile LAS unsigned* st) {
    XcdBarrier b; b.bar = bar; b.x = xb_xcc_id(); b.st = st;
    if (threadIdx.x == 0) (void)xb_add(&bar[XB_XCNT(b.x)], 1u);
    return b;
}
__device__ __forceinline__ void xcd_barrier_complete(unsigned* bar, unsigned x, unsigned& nloc, unsigned& nx) {
    const unsigned G = gridDim.x * gridDim.y * gridDim.z;
    unsigned sum, cnt, mine, sp = 0u;
    for (;;) {
        sum = 0u; cnt = 0u; mine = 0u;
#pragma unroll
        for (unsigned j = 0; j < 16; ++j) { const unsigned c = xb_ld(&bar[XB_XCNT(j)]); sum += c; cnt += (c > 0u) ? 1u : 0u; mine = (j == x) ? c : mine; }
        if (sum == G) break;
        __builtin_amdgcn_s_sleep(1);
        if ((++sp & 255u) == 0u) { if (xb_ld(&bar[XB_TMO])) break; if (sp > XB_SPIN_CAP) { atomicAdd(&bar[XB_TMO], 1u); break; } }
    }
    nloc = mine > 0u ? mine : 1u; nx = cnt > 0u ? cnt : 1u;
}

__device__ __forceinline__ void xcd_barrier(const XcdBarrier& b, const bool is_thread0  ) {
    asm volatile("s_waitcnt vmcnt(0)" ::: "memory");
    __syncthreads();
    if (is_thread0) {
        unsigned* bar = b.bar;
        __builtin_amdgcn_s_waitcnt(0);
        unsigned nloc = b.st[0], nx = b.st[1];
        if (nloc == 0u) { xcd_barrier_complete(bar, b.x, nloc, nx); b.st[0] = nloc; b.st[1] = nx; }
        const unsigned old = xb_add(&bar[XB_XSUB(b.x)], 1u);
        const unsigned gen = old / nloc;
        if (old + 1u == (gen + 1u) * nloc) {
            __builtin_amdgcn_fence(__ATOMIC_RELEASE, "agent");
            asm volatile("s_waitcnt vmcnt(0)" ::: "memory");
            const unsigned og = xb_add(&bar[XB_TOP], 1u);
            const unsigned tg = og / nx;
            if (og + 1u == (tg + 1u) * nx) xb_add(&bar[XB_TOPGEN], 1u);
            else XB_SPIN(xb_ld(&bar[XB_TOPGEN]) == tg, bar);
            __builtin_amdgcn_fence(__ATOMIC_ACQUIRE, "agent");
            xb_add(&bar[XB_XGEN(b.x)], 1u);
            asm volatile("s_waitcnt vmcnt(0)" ::: "memory");
        } else {
            XB_SPIN(xb_ld(&bar[XB_XGEN(b.x)]) == gen, bar);
            __builtin_amdgcn_fence(__ATOMIC_ACQUIRE, "agent");
            asm volatile("s_waitcnt vmcnt(0)" ::: "memory");
        }
    }
    __syncthreads();
}
constexpr int S = 8192, D = 2048, NL = 4, DFF = 5632, NIN = 15376, NPROJ = 15872, LDP = 14336, NWAVES = 8;
constexpr int PC_QA = 0, PC_KA = 1024, PC_VA = 2048, PC_QG = 3072, PC_KG = 3584, PC_VG = 4096, PC_RG = 5120, PC_BG = 6144, PC_CU = 7168, PC_G = 8192;
constexpr float RMS_EPS = 1e-6f;
constexpr float FIX_SCALE = 1048576.0f;
constexpr int NPH = 34;
typedef unsigned long long u64;
#define WT_STORES 0
template <class V> __device__ __forceinline__ void st16_wt(GAS void* p, const V v) {
#if WT_STORES
    asm volatile("global_store_dwordx4 %0, %1, off sc1\n\ts_nop 1" :: "v"(p), "v"(v));
#else
    *(GAS V*)p = v;
#endif
}
#define ST16(p, v) st16_wt((GAS void*)(p), (v))
template <class V> __device__ __forceinline__ void st16_plain(GAS void* p, const V v) { *(GAS V*)p = v; }
#define ST16P(p, v) st16_plain((GAS void*)(p), (v))

constexpr size_t MiB = 1u << 20;
constexpr size_t WS_CTL = 0, CTL_ZERO_BYTES = 2 * MiB;
constexpr int CW_BAR = 4096;
constexpr size_t CTL_QKMAX = 32768;
constexpr size_t CTL_BCNT = 1572864;
constexpr size_t CTL_SELCNT = 36864;
constexpr size_t CTL_PLAN = 34816;
constexpr size_t CTL_STATS = 65536;
constexpr size_t CTL_KSUM = 1 * MiB;
static_assert(CTL_KSUM + (size_t)4 * 32 * 1024 * 4 <= CTL_ZERO_BYTES, "ctl map");
static_assert(CTL_BCNT >= CTL_KSUM + (size_t)4 * 32 * 1024 * 4 && CTL_BCNT + (size_t)NL * 3 * 32 * 32 * 4 <= CTL_ZERO_BYTES, "ctl map");
static_assert(CTL_STATS + (size_t)9 * S * 8 <= CTL_KSUM && (CW_BAR + XCD_BAR_WORDS) * 4 <= (int)CTL_STATS, "ctl map");
constexpr size_t W_IN_B = (size_t)NPROJ * D * 2, W_BR_B = (size_t)3 * D * 1024 * 2, W_OUT_B = (size_t)D * D * 2, W_GU_B = (size_t)2 * DFF * D * 2, W_DN_B = (size_t)D * DFF * 2;
constexpr size_t WL_IN = 0, WL_BR = WL_IN + W_IN_B, WL_OUT = WL_BR + W_BR_B, WL_GU = WL_OUT + W_OUT_B, WL_DN = WL_GU + W_GU_B, WL_BYTES = WL_DN + W_DN_B;
constexpr size_t WS_W = 2 * MiB;
constexpr size_t WS_XB = WS_W + NL * WL_BYTES;
constexpr size_t WS_PROJ = WS_XB + (size_t)S * D * 2;
constexpr size_t WS_LA = WS_PROJ + (size_t)S * LDP * 2;
constexpr size_t WS_A3 = WS_LA + (size_t)S * 512 * 4;
constexpr size_t WS_PML = WS_A3 + (size_t)3 * S * 1024 * 2;
constexpr size_t WS_DECAY = WS_PML + (size_t)(512 + 96) * 256 * 2 * 4;
constexpr size_t WS_KV = WS_DECAY + (size_t)4 * 128 * 128 * 4;
constexpr size_t WS_SPREV = WS_KV + (size_t)4 * 128 * 128 * 256 * 4;
constexpr size_t WS_T = WS_SPREV + (size_t)4 * 128 * 128 * 256 * 4;
constexpr int ATT_NSLOT = 512 + 96;
constexpr size_t WS_MIXED = WS_T + (size_t)ATT_NSLOT * 256 * 128 * 4;
constexpr size_t WS_ACT = WS_MIXED + (size_t)S * D * 2;
constexpr size_t WS_QKVH = WS_ACT + (size_t)S * DFF * 2;
constexpr size_t WS_SEL = WS_QKVH + (size_t)3 * 8 * S * 128 * 2;
constexpr size_t WS_RP = WS_SEL + (size_t)3 * S * 4;
constexpr size_t WS_RPML = WS_RP + (size_t)3 * S * 3 * 128 * 4;
constexpr size_t WS_END = WS_RPML + (size_t)3 * S * 3 * 2 * 4;
static_assert(WS_END < (size_t)1900 * MiB, "workspace");
static_assert(WL_BYTES % 256 == 0 && WS_XB % 256 == 0 && WS_PROJ % 256 == 0 && WS_LA % 256 == 0 && WS_A3 % 256 == 0 && WS_KV % 256 == 0 && WS_T % 256 == 0 && WS_ACT % 256 == 0, "alignment");

constexpr int RING_BYTES = 131072, LDSCTL_OFF = RING_BYTES, MISC_OFF = LDSCTL_OFF + 320, LDS_BYTES = 147456;

__device__ __forceinline__ float bflo(unsigned w) { return __uint_as_float(w << 16); }
__device__ __forceinline__ float bfhi(unsigned w) { return __uint_as_float(w & 0xffff0000u); }
__device__ __forceinline__ float bf2f(bf16 b) { return __uint_as_float(((unsigned)b) << 16); }
template <int M> __device__ __forceinline__ float xshfl(float v) {
    return __int_as_float(__builtin_amdgcn_ds_swizzle(__float_as_int(v), (M << 10) | 0x1f)); }
template <int M> __device__ __forceinline__ int xshfl_i(int v) { return __builtin_amdgcn_ds_swizzle(v, (M << 10) | 0x1f); }
__device__ __forceinline__ float swap32_sum(float v) { auto rr = __builtin_amdgcn_permlane32_swap(__float_as_uint(v), __float_as_uint(v), false, false); return __uint_as_float(rr[0]) + __uint_as_float(rr[1]); }
__device__ __forceinline__ float swap32_max(float v) { auto rr = __builtin_amdgcn_permlane32_swap(__float_as_uint(v), __float_as_uint(v), false, false); return fmaxf(__uint_as_float(rr[0]), __uint_as_float(rr[1])); }
__device__ __forceinline__ float wave_sum(float v) { v += xshfl<1>(v); v += xshfl<2>(v); v += xshfl<4>(v); v += xshfl<8>(v); v += xshfl<16>(v); return swap32_sum(v); }
__device__ __forceinline__ float wave_max(float v) { v = fmaxf(v, xshfl<1>(v)); v = fmaxf(v, xshfl<2>(v)); v = fmaxf(v, xshfl<4>(v)); v = fmaxf(v, xshfl<8>(v)); v = fmaxf(v, xshfl<16>(v)); return swap32_max(v); }
__device__ __forceinline__ float inv_rms_from(const u64 s) { return rsqrtf((float)s * (1.0f / (FIX_SCALE * (float)D)) + RMS_EPS); }
__device__ __forceinline__ float inv_rms_of(const u64* st, int row) { return rsqrtf((float)st[row] * (1.0f / (FIX_SCALE * (float)D)) + RMS_EPS); }

__device__ __forceinline__ void unpack8(const v4u w, float (&f)[8]) { f[0] = bflo(w.x); f[1] = bfhi(w.x); f[2] = bflo(w.y); f[3] = bfhi(w.y); f[4] = bflo(w.z); f[5] = bfhi(w.z); f[6] = bflo(w.w); f[7] = bfhi(w.w); }
struct EpiProj {
    static constexpr bool PERM = true, AFTER_DRAIN = false, CARRY = false;
    static constexpr bool INIT = false; struct Ini {}; struct Pre { u64 s[2][4]; };
    __device__ __forceinline__ void pre(Pre& p, const pg8::Unit& u, int wr, int, int fr, int) const { const int row0 = u.pm * 256 + wr * 64 + fr;
#pragma unroll
        for (int ai = 0; ai < 2; ++ai)
#pragma unroll
            for (int m = 0; m < 4; ++m) p.s[ai][m] = ((const GAS u64*)st)[row0 + ai * 128 + m * 16]; }
    bf16* proj; bf16* qkvh; float* la; const u64* st; const float* glab; float* ksum; unsigned* qkmax;
    __device__ __forceinline__ void operator()(const pg8::f32x4 (&acc)[2][2][4][2], const pg8::Unit& u, int wr, int wc, int fr, int fq, const Pre& pr) const {
        const int row0 = u.pm * 256 + wr * 64 + fr, pn = u.pn, cw = wc * 32 + 8 * fq;
        const bool ksumt = pn >= 4 && pn < 8; pg8::f32x4 cs[2][2]; float nmx[2] = {0.f, 0.f};
        pg8::f32x4 glv[2][2];
#pragma unroll
        for (int bj = 0; bj < 2; ++bj)
#pragma unroll
            for (int n = 0; n < 2; ++n) glv[bj][n] = pn >= 60 ? *(const pg8::f32x4*)(glab + (pn - 60) * 256 + bj * 128 + cw + 4 * n) : (pg8::f32x4){0.f, 0.f, 0.f, 0.f};
        float irs[2][4];
#pragma unroll
        for (int ai = 0; ai < 2; ++ai)
#pragma unroll
            for (int m = 0; m < 4; ++m) irs[ai][m] = inv_rms_from(pr.s[ai][m]);
#pragma unroll
        for (int bj = 0; bj < 2; ++bj) { cs[bj][0] = (pg8::f32x4){0.f, 0.f, 0.f, 0.f}; cs[bj][1] = cs[bj][0]; }
#pragma unroll
        for (int ai = 0; ai < 2; ++ai)
#pragma unroll
            for (int m = 0; m < 4; ++m) {
                const int row = row0 + ai * 128 + m * 16; const float ir = irs[ai][m];
                if (pn < 28 || (pn >= 36 && pn < 60)) {
                    const bool sig = pn >= 36;
                    bf16* rowp = pn < 12 ? qkvh + ((size_t)((pn >> 2) * 8 + 2 * (pn & 3)) * S + row) * 128 + cw
                                         : proj + (size_t)row * LDP + (sig ? PC_G + (pn - 36) * 256 : pn * 256) + cw;
                    const size_t bjstep = pn < 12 ? (size_t)S * 128 : (size_t)128;
#pragma unroll
                    for (int bj = 0; bj < 2; ++bj) { pg8::f32x4 v0 = acc[ai][bj][m][0] * ir, v1 = acc[ai][bj][m][1] * ir;
                        if (ksumt) { cs[bj][0] += v0; cs[bj][1] += v1; }
                        if (pn < 8) { float ss = (v0[0] * v0[0] + v0[1] * v0[1]) + (v0[2] * v0[2] + v0[3] * v0[3]) + (v1[0] * v1[0] + v1[1] * v1[1]) + (v1[2] * v1[2] + v1[3] * v1[3]);
                            ss += xshfl<16>(ss); ss = swap32_sum(ss); nmx[bj] = fmaxf(nmx[bj], ss); }
                        if (sig) {
#pragma unroll
                            for (int j = 0; j < 4; ++j) { v0[j] = fmaxf(__builtin_amdgcn_rcpf(1.0f + __builtin_amdgcn_exp2f(-1.4426950408889634f * v0[j])), 1e-18f); v1[j] = fmaxf(__builtin_amdgcn_rcpf(1.0f + __builtin_amdgcn_exp2f(-1.4426950408889634f * v1[j])), 1e-18f); } }
                        pg8::u32x4 w; w.x = pg8::cvt_pk_bf16(v0[0], v0[1]); w.y = pg8::cvt_pk_bf16(v0[2], v0[3]); w.z = pg8::cvt_pk_bf16(v1[0], v1[1]); w.w = pg8::cvt_pk_bf16(v1[2], v1[3]);
                        ST16P((rowp + bj * bjstep), w); }
                } else if (pn < 36) {
                    bf16* rowp = proj + (size_t)row * LDP + PC_CU + (pn - 28) * 128 + cw;
                    const pg8::f32x4 v0 = (acc[ai][0][m][0] * ir) * (acc[ai][1][m][0] * ir), v1 = (acc[ai][0][m][1] * ir) * (acc[ai][1][m][1] * ir);
                    pg8::u32x4 w; w.x = pg8::cvt_pk_bf16(v0[0], v0[1]); w.y = pg8::cvt_pk_bf16(v0[2], v0[3]); w.z = pg8::cvt_pk_bf16(v1[0], v1[1]); w.w = pg8::cvt_pk_bf16(v1[2], v1[3]);
                    ST16P(rowp, w);
                } else {
#pragma unroll
                    for (int bj = 0; bj < 2; ++bj) { const int col = (pn - 60) * 256 + bj * 128 + cw; float* rowp = la + (size_t)row * 512 + col;
#pragma unroll
                        for (int n = 0; n < 2; ++n) { const pg8::f32x4 bv = glv[bj][n]; pg8::f32x4 z = acc[ai][bj][m][n] * ir + bv, o;
#pragma unroll
                            for (int j = 0; j < 4; ++j) o[j] = (fminf(z[j], 0.f) - 0.6931471805599453f * __builtin_amdgcn_logf(1.0f + __builtin_amdgcn_exp2f(-1.4426950408889634f * fabsf(z[j])))) * 0.0625f;
                            ST16P((rowp + 4 * n), o); } }
                }
            }
        if (pn < 8) {
#pragma unroll
            for (int bj = 0; bj < 2; ++bj) { float s = nmx[bj]; s = fmaxf(s, xshfl<1>(s)); s = fmaxf(s, xshfl<2>(s)); s = fmaxf(s, xshfl<4>(s)); s = fmaxf(s, xshfl<8>(s));
                if (fr == 0 && fq == 0) atomicMax(qkmax + ((pn >> 2) * 8 + 2 * (pn & 3) + bj) * 4 + wc, __float_as_uint(s)); }
        }
        if (ksumt) {
#pragma unroll
            for (int bj = 0; bj < 2; ++bj)
#pragma unroll
                for (int n = 0; n < 2; ++n)
#pragma unroll
                    for (int j = 0; j < 4; ++j) { float s = cs[bj][n][j]; s += xshfl<1>(s); s += xshfl<2>(s); s += xshfl<4>(s); s += xshfl<8>(s);
                        if (fr == 0) atomicAdd(ksum + u.pm * 1024 + (pn - 4) * 256 + bj * 128 + cw + 4 * n + j, s); }
        }
    }
};
struct EpiBranch {
    static constexpr bool PERM = true, AFTER_DRAIN = false, CARRY = true;
    static constexpr bool INIT = false; struct Pre {}; struct Ini {};
    __device__ __forceinline__ void pre(Pre&, const pg8::Unit&, int, int, int, int) const {}
    const bf16* proj; bf16* mixed;
    __device__ __forceinline__ bool carry(const pg8::Unit& u) const { return (u.pm >> 5) < 2; }
    __device__ __forceinline__ void operator()(pg8::f32x4 (&acc)[2][2][4][2], const pg8::Unit& u, int wr, int wc, int fr, int fq, const Pre&) const {
        const int b = u.pm >> 5, pm = u.pm & 31, pn = u.pn & 7;
        const int row0 = pm * 256 + wr * 64 + fr, col0 = pn * 256 + wc * 32 + 8 * fq;
#pragma unroll
        for (int ai = 0; ai < 2; ++ai) {
            v4u ga[4][2], gb[4][2];
#pragma unroll
            for (int m = 0; m < 4; ++m)
#pragma unroll
                for (int bj = 0; bj < 2; ++bj) { const GAS bf16* gp = (const GAS bf16*)proj + (size_t)(row0 + ai * 128 + m * 16) * LDP + PC_G + b * D + col0 + bj * 128;
                    ga[m][bj] = *(const GAS v4u*)gp; gb[m][bj] = (b < 2) ? *(const GAS v4u*)(gp + D) : ga[m][bj]; }
#pragma unroll
            for (int m = 0; m < 4; ++m) { const int row = row0 + ai * 128 + m * 16;
#pragma unroll
                for (int bj = 0; bj < 2; ++bj) { const int col = col0 + bj * 128;
                    float f[8]; unpack8(ga[m][bj], f);
                    if (b < 2) { float f2[8]; unpack8(gb[m][bj], f2);
#pragma unroll
                        for (int j = 0; j < 8; ++j) f[j] *= __builtin_amdgcn_rcpf(f2[j]); }
                    pg8::f32x4 v0 = acc[ai][bj][m][0], v1 = acc[ai][bj][m][1];
                    v0[0] *= f[0]; v0[1] *= f[1]; v0[2] *= f[2]; v0[3] *= f[3]; v1[0] *= f[4]; v1[1] *= f[5]; v1[2] *= f[6]; v1[3] *= f[7];
                    if (b < 2) { acc[ai][bj][m][0] = v0; acc[ai][bj][m][1] = v1; }
                    else { pg8::u32x4 w; w.x = pg8::cvt_pk_bf16(v0[0], v0[1]); w.y = pg8::cvt_pk_bf16(v0[2], v0[3]); w.z = pg8::cvt_pk_bf16(v1[0], v1[1]); w.w = pg8::cvt_pk_bf16(v1[2], v1[3]);
                        ST16(((GAS bf16*)mixed + (size_t)row * D + col), w); } } }
            asm volatile("" ::: "memory"); }
    }
};
struct BranchOrder {
    pg8::StaticOrder so;
    __device__ bool next(int i, pg8::Unit& u) const { pg8::Unit t; if (!so.next(i / 3, t)) return false; const int b = i % 3; u.pm = b * 32 + t.pm; u.pn = b * 8 + t.pn; return true; }
    __device__ __forceinline__ void a_ready(const pg8::Unit&) const {}
    __device__ __forceinline__ void done(const pg8::Unit&) const {}
};
struct EpiResid {
    static constexpr bool PERM = true, AFTER_DRAIN = false, CARRY = false, INIT = true;
    struct Pre {}; struct Ini { v4u xv[2][4][2]; };
    bf16* XB; u64* st;
    __device__ __forceinline__ void pre(Pre&, const pg8::Unit&, int, int, int, int) const {}
    __device__ __forceinline__ void init_load(Ini& I, const pg8::Unit& u, int wr, int wc, int fr, int fq) const {
        const int row0 = u.pm * 256 + wr * 64 + fr, col0 = u.pn * 256 + wc * 32 + 8 * fq;
#pragma unroll
        for (int ai = 0; ai < 2; ++ai)
#pragma unroll
            for (int m = 0; m < 4; ++m)
#pragma unroll
                for (int bj = 0; bj < 2; ++bj) I.xv[ai][m][bj] = *(const GAS v4u*)((const GAS bf16*)XB + (size_t)(row0 + ai * 128 + m * 16) * D + col0 + bj * 128);
    }
    __device__ __forceinline__ void init_apply(pg8::f32x4 (&acc)[2][2][4][2], const Ini& I) const {
#pragma unroll
        for (int ai = 0; ai < 2; ++ai)
#pragma unroll
            for (int m = 0; m < 4; ++m)
#pragma unroll
                for (int bj = 0; bj < 2; ++bj) { float x[8]; unpack8(I.xv[ai][m][bj], x);
                    acc[ai][bj][m][0] = (pg8::f32x4){x[0], x[1], x[2], x[3]}; acc[ai][bj][m][1] = (pg8::f32x4){x[4], x[5], x[6], x[7]}; }
    }
    __device__ __forceinline__ void operator()(const pg8::f32x4 (&acc)[2][2][4][2], const pg8::Unit& u, int wr, int wc, int fr, int fq, const Pre&) const {
        const int row0 = u.pm * 256 + wr * 64 + fr, col0 = u.pn * 256 + wc * 32 + 8 * fq;
#pragma unroll
        for (int ai = 0; ai < 2; ++ai) {
#pragma unroll
            for (int m = 0; m < 4; ++m) { const int row = row0 + ai * 128 + m * 16; float ss = 0.f;
#pragma unroll
                for (int bj = 0; bj < 2; ++bj) { const int col = col0 + bj * 128;
                    const pg8::f32x4 a0 = acc[ai][bj][m][0], a1 = acc[ai][bj][m][1];
                    ss += (a0[0] * a0[0] + a0[1] * a0[1]) + (a0[2] * a0[2] + a0[3] * a0[3]) + (a1[0] * a1[0] + a1[1] * a1[1]) + (a1[2] * a1[2] + a1[3] * a1[3]);
                    pg8::u32x4 w; w.x = pg8::cvt_pk_bf16(a0[0], a0[1]); w.y = pg8::cvt_pk_bf16(a0[2], a0[3]); w.z = pg8::cvt_pk_bf16(a1[0], a1[1]); w.w = pg8::cvt_pk_bf16(a1[2], a1[3]);
                    ST16P(((GAS bf16*)XB + (size_t)row * D + col), w); }
                ss += xshfl<16>(ss); ss = swap32_sum(ss);
                if (fq == 0) __hip_atomic_fetch_add(st + row, (u64)(ss * FIX_SCALE + 0.5f), __ATOMIC_RELAXED, __HIP_MEMORY_SCOPE_AGENT); } }
    }
};
struct EpiGU {
    static constexpr bool PERM = true, AFTER_DRAIN = false, CARRY = false;
    static constexpr bool INIT = false; struct Ini {}; struct Pre { u64 s[2][4]; };
    __device__ __forceinline__ void pre(Pre& p, const pg8::Unit& u, int wr, int, int fr, int) const { const int row0 = u.pm * 256 + wr * 64 + fr;
#pragma unroll
        for (int ai = 0; ai < 2; ++ai)
#pragma unroll
            for (int m = 0; m < 4; ++m) p.s[ai][m] = ((const GAS u64*)st)[row0 + ai * 128 + m * 16]; }
    bf16* act; const u64* st;
    __device__ __forceinline__ void operator()(const pg8::f32x4 (&acc)[2][2][4][2], const pg8::Unit& u, int wr, int wc, int fr, int fq, const Pre& pr) const {
        const int row0 = u.pm * 256 + wr * 64 + fr, col0 = u.pn * 128 + wc * 32 + 8 * fq;
        float irs[2][4];
#pragma unroll
        for (int ai = 0; ai < 2; ++ai)
#pragma unroll
            for (int m = 0; m < 4; ++m) irs[ai][m] = inv_rms_from(pr.s[ai][m]);
#pragma unroll
        for (int ai = 0; ai < 2; ++ai)
#pragma unroll
            for (int m = 0; m < 4; ++m) { const int row = row0 + ai * 128 + m * 16; const float ir = irs[ai][m];
                pg8::f32x4 o[2];
#pragma unroll
                for (int n = 0; n < 2; ++n) { const pg8::f32x4 g = acc[ai][0][m][n] * ir, uu = acc[ai][1][m][n] * ir;
#pragma unroll
                    for (int j = 0; j < 4; ++j) o[n][j] = g[j] * __builtin_amdgcn_rcpf(1.0f + __builtin_amdgcn_exp2f(-1.4426950408889634f * g[j])) * uu[j]; }
                pg8::u32x4 w; w.x = pg8::cvt_pk_bf16(o[0][0], o[0][1]); w.y = pg8::cvt_pk_bf16(o[0][2], o[0][3]); w.z = pg8::cvt_pk_bf16(o[1][0], o[1][1]); w.w = pg8::cvt_pk_bf16(o[1][2], o[1][3]);
                ST16P((act + (size_t)row * DFF + col0), w); }
    }
};


struct Args { const float* in[16]; float* out; unsigned char* ws; int ph_lo, ph_hi, li, pad; };
struct Ptrs {
    const float *x, *norm1_w, *w_in, *gla_w_up, *gla_b, *gla_norm_w, *conv_w, *w_br0, *w_br1, *w_br2, *w_out, *norm2_w, *w_gate, *w_up, *w_down, *final_w;
    float* X; unsigned char* ws; u64* stats;
    bf16 *XB, *PROJ, *A3, *MIXED, *ACT, *QKVH; float *LA, *KSUM, *DECAY, *T, *PML; bf16 *KVT, *SPT; unsigned* QKMAX; int* PLAN; int* SELCNT; int* BCNT; unsigned* SEL; float *RP, *RPML;
    int G, vcu, wv;
};
#define OPAQUE_TID() int lane_v_; asm volatile("v_mbcnt_lo_u32_b32 %0, -1, 0\n\tv_mbcnt_hi_u32_b32 %0, -1, %0" : "=v"(lane_v_)); const int lane = lane_v_, wave = P.wv, tid = wave * 64 + lane; (void)lane; (void)wave; (void)tid

typedef const __attribute__((address_space(4))) unsigned char* KPTR;
__device__ __forceinline__ void fill_ptrs(Ptrs& P, KPTR kp, int wv) {
    const __attribute__((address_space(4))) Args* a = (const __attribute__((address_space(4))) Args*)kp;
    P.wv = wv; P.G = gridDim.x; { const int bx = blockIdx.x; P.vcu = (P.G % 8 == 0) ? (bx % 8) * (P.G / 8) + bx / 8 : bx; }
    P.x = a->in[0]; P.norm1_w = a->in[1]; P.w_in = a->in[2]; P.gla_w_up = a->in[3]; P.gla_b = a->in[4]; P.gla_norm_w = a->in[5]; P.conv_w = a->in[6];
    P.w_br0 = a->in[7]; P.w_br1 = a->in[8]; P.w_br2 = a->in[9]; P.w_out = a->in[10]; P.norm2_w = a->in[11]; P.w_gate = a->in[12]; P.w_up = a->in[13]; P.w_down = a->in[14]; P.final_w = a->in[15];
    P.X = a->out; unsigned char* ws = a->ws; P.ws = ws;
    P.stats = (u64*)(ws + WS_CTL + CTL_STATS);
    P.XB = (bf16*)(ws + WS_XB); P.PROJ = (bf16*)(ws + WS_PROJ); P.LA = (float*)(ws + WS_LA); P.A3 = (bf16*)(ws + WS_A3); P.KSUM = (float*)(ws + WS_CTL + CTL_KSUM); P.QKMAX = (unsigned*)(ws + WS_CTL + CTL_QKMAX); P.PLAN = (int*)(ws + WS_CTL + CTL_PLAN); P.SELCNT = (int*)(ws + WS_CTL + CTL_SELCNT); P.BCNT = (int*)(ws + WS_CTL + CTL_BCNT); P.SEL = (unsigned*)(ws + WS_SEL); P.RP = (float*)(ws + WS_RP); P.RPML = (float*)(ws + WS_RPML); P.PML = (float*)(ws + WS_PML); P.DECAY = (float*)(ws + WS_DECAY);
    P.KVT = (bf16*)(ws + WS_KV); P.SPT = (bf16*)(ws + WS_SPREV); P.T = (float*)(ws + WS_T); P.MIXED = (bf16*)(ws + WS_MIXED); P.ACT = (bf16*)(ws + WS_ACT); P.QKVH = (bf16*)(ws + WS_QKVH);
}
__device__ __forceinline__ void xpose_store(LAS float* scr, bf16* dst, int K, int lane, const f32x4 s0, const f32x4 s1) {
    LDS_WAIT(); asm volatile("" ::: "memory");
    const int c = lane & 7;
#pragma unroll
    for (int j = 0; j < 4; ++j) { const int n = (lane >> 3) + 8 * j; const LAS float* s = scr + (8 * c) * 33 + n;
        v4u o; o.x = pk2(s[0 * 33] * s0.x, s[1 * 33] * s0.y); o.y = pk2(s[2 * 33] * s0.z, s[3 * 33] * s0.w); o.z = pk2(s[4 * 33] * s1.x, s[5 * 33] * s1.y); o.w = pk2(s[6 * 33] * s1.z, s[7 * 33] * s1.w);
        *(GAS v4u*)(dst + (size_t)n * K + 8 * c) = o; }
    LDS_WAIT(); asm volatile("" ::: "memory");
}
constexpr int IT_IN = 496 * 32, IT_BR = 3 * 64 * 16, IT_OUT = 64 * 32, IT_GU = 352 * 32, IT_DN = 64 * 88, IT_L = IT_IN + IT_BR + IT_OUT + IT_GU + IT_DN;
constexpr int R_T1 = 4096, R_TAIL = 4096 + 9216;
struct CvtD { const float* b0; const float* b1; const float* scale; bf16* dst; unsigned st0, st1, hs0, ls0, hs1, ls1; int K; int z; bool hs; };
__device__ __forceinline__ void cvt_copy(CvtD& d, const float* src, unsigned ld, const float* scale, bf16* dst, int K) {
    d.b0 = src; d.b1 = src + (size_t)32 * ld; d.st0 = d.st1 = 2 * ld; d.hs0 = d.hs1 = ld; d.ls0 = d.ls1 = 1; d.dst = dst; d.K = K; d.z = -1; d.hs = scale != nullptr; if (scale) d.scale = scale;
}
__device__ __forceinline__ void cvt_decode(const Ptrs& P, int it0, int nA, int lA, int rA0, int nB, int lB0, int rB0, CvtD& d) {
    int l, r; if (it0 < nA) { l = lA; r = rA0 + it0; } else { const int q = it0 - nA; l = lB0 + q / nB; r = rB0 + q % nB; }
    unsigned char* wl = P.ws + WS_W + (size_t)l * WL_BYTES;
    d.scale = P.norm1_w;
    if (r < IT_IN) {
        const int kb = r / 496, g = r % 496, k0 = 64 * kb;
        const float* win = P.w_in + (size_t)l * D * NIN; const float* sc = P.norm1_w + l * D + k0;
        bf16* dst = (bf16*)(wl + WL_IN) + (size_t)(32 * g) * D + k0;
        int c0;
        if (g < 192) c0 = 32 * g;
        else if (g < 224) c0 = 6160 + 32 * (g - 192);
        else if (g < 288) { const int t = (g - 224) >> 3, sub = (g - 224) & 7; c0 = (sub < 4 ? 7184 : 8208) + 128 * t + 32 * (sub & 3); }
        else if (g < 480) c0 = 9232 + 32 * (g - 288);
        else c0 = 6144;
        cvt_copy(d, win + (size_t)k0 * NIN + c0, NIN, sc, dst, D);
        if (g >= 480) { d.z = 32 * (g - 480); d.st0 = 1; d.hs0 = 32 * NIN; d.ls0 = NIN; d.b1 = P.gla_w_up + (size_t)l * 16 * 512 + 32 * (g - 480); d.st1 = 512; d.hs1 = 0; d.ls1 = 1; }
        return;
    }
    r -= IT_IN;
    if (r < 1024) { const int kb = r / 64, g = r % 64, k0 = 64 * kb;
        cvt_copy(d, P.w_br0 + (size_t)l * 1024 * D + (size_t)k0 * D + 32 * g, D, nullptr, (bf16*)(wl + WL_BR) + (size_t)(0 * D + 32 * g) * 1024 + k0, 1024); return; }
    r -= 1024;
    if (r < 1024) { const int kb = r / 64, g = r % 64, k0 = 64 * kb;
        cvt_copy(d, P.w_br1 + (size_t)l * 1024 * D + (size_t)k0 * D + 32 * g, D, nullptr, (bf16*)(wl + WL_BR) + (size_t)(1 * D + 32 * g) * 1024 + k0, 1024); return; }
    r -= 1024;
    if (r < 1024) { const int kb = r / 64, g = r % 64, k0 = 64 * kb;
        cvt_copy(d, P.w_br2 + (size_t)l * 1024 * D + (size_t)k0 * D + 32 * g, D, nullptr, (bf16*)(wl + WL_BR) + (size_t)(2 * D + 32 * g) * 1024 + k0, 1024); return; }
    r -= 1024;
    if (r < IT_OUT) { const int kb = r / 64, g = r % 64, k0 = 64 * kb;
        cvt_copy(d, P.w_out + (size_t)l * D * D + (size_t)k0 * D + 32 * g, D, nullptr, (bf16*)(wl + WL_OUT) + (size_t)(32 * g) * D + k0, D); return; }
    r -= IT_OUT;
    if (r < IT_GU) { const int kb = r / 352, g = r % 352, k0 = 64 * kb, t = g >> 3, sub = g & 7;
        cvt_copy(d, (sub < 4 ? P.w_gate : P.w_up) + (size_t)l * D * DFF + (size_t)k0 * DFF + 128 * t + 32 * (sub & 3), DFF, P.norm2_w + l * D + k0, (bf16*)(wl + WL_GU) + (size_t)(32 * g) * D + k0, D); return; }
    r -= IT_GU;
    { const int kb = r / 64, g = r % 64, k0 = 64 * kb;
        cvt_copy(d, P.w_down + (size_t)l * DFF * D + (size_t)k0 * D + 32 * g, D, nullptr, (bf16*)(wl + WL_DN) + (size_t)(32 * g) * DFF + k0, DFF); }
}
#define CVT_ISSUE(d, v, s0, s1) do { \
    { const GAS float* p_ = (const GAS float*)(d).b0 + ((lane >> 5) * (d).hs0 + (lane & 31) * (d).ls0); \
      _Pragma("unroll") for (int i_ = 0; i_ < 16; ++i_) { v[i_] = *p_; p_ += (d).st0; asm volatile("" : "+v"(p_)); } } \
    { const GAS float* p_ = (const GAS float*)(d).b1 + ((lane >> 5) * (d).hs1 + (lane & 31) * (d).ls1); \
      _Pragma("unroll") for (int i_ = 0; i_ < 16; ++i_) { v[16 + i_] = *p_; p_ += (d).st1; asm volatile("" : "+v"(p_)); } } \
    s0 = *(const GAS f32x4*)((const GAS float*)(d).scale + 8 * (lane & 7)); s1 = *(const GAS f32x4*)((const GAS float*)(d).scale + 8 * (lane & 7) + 4); } while (0)
#define CVT_FINISH(d, v, s0, s1) do { \
    const f32x4 one_ = {1.f, 1.f, 1.f, 1.f}; const f32x4 t0_ = (d).hs ? s0 : one_, t1_ = (d).hs ? s1 : one_; \
    if ((d).z < 0) { _Pragma("unroll") for (int i_ = 0; i_ < 32; ++i_) scr[(2 * i_ + (lane >> 5)) * 33 + (lane & 31)] = v[i_]; } \
    else { LAS f32x4* st_ = (LAS f32x4*)(scr + 64 * 33 + 16); \
        _Pragma("unroll") for (int q_ = 0; q_ < 4; ++q_) st_[lane * 4 + q_] = f32x4{v[4 * q_], v[4 * q_ + 1], v[4 * q_ + 2], v[4 * q_ + 3]}; \
        LDS_WAIT(); asm volatile("" ::: "memory"); \
        _Pragma("unroll 4") for (int i_ = 0; i_ < 32; ++i_) { const int kk_ = 2 * i_ + (lane >> 5); const f32x4 a0 = st_[kk_ * 4], a1 = st_[kk_ * 4 + 1], a2 = st_[kk_ * 4 + 2], a3 = st_[kk_ * 4 + 3]; \
            scr[kk_ * 33 + (lane & 31)] = ((a0.x * v[16] + a0.y * v[17]) + (a0.z * v[18] + a0.w * v[19])) + ((a1.x * v[20] + a1.y * v[21]) + (a1.z * v[22] + a1.w * v[23])) \
                                        + ((a2.x * v[24] + a2.y * v[25]) + (a2.z * v[26] + a2.w * v[27])) + ((a3.x * v[28] + a3.y * v[29]) + (a3.z * v[30] + a3.w * v[31])); } } \
    xpose_store(scr, (d).dst, (d).K, lane, t0_, t1_); } while (0)
__device__ __forceinline__ void convert_items(const Ptrs& P, LAS unsigned char* lds, int nA, int lA, int rA0, int nB, int nrep, int lB0, int rB0, int worker0, int nworkers) {
    OPAQUE_TID();
    LAS float* scr = (LAS float*)(lds + wave * 16384);
    const int tot = nA + nrep * nB, stride = nworkers * NWAVES;
    int it = worker0 * NWAVES + wave;
    if (it >= tot) return;
    CvtD a, b; float va[32], vb[32]; f32x4 sa0, sa1, sb0, sb1;
    cvt_decode(P, it, nA, lA, rA0, nB, lB0, rB0, a); CVT_ISSUE(a, va, sa0, sa1);
    for (;;) {
        const int itb = it + stride; const bool hb = itb < tot;
        cvt_decode(P, hb ? itb : it, nA, lA, rA0, nB, lB0, rB0, b); CVT_ISSUE(b, vb, sb0, sb1);
        CVT_FINISH(a, va, sa0, sa1);
        if (!hb) break;
        it = itb + stride; const bool ha = it < tot;
        cvt_decode(P, ha ? it : itb, nA, lA, rA0, nB, lB0, rB0, a); CVT_ISSUE(a, va, sa0, sa1);
        CVT_FINISH(b, vb, sb0, sb1);
        if (!ha) break;
    }
}
__device__ __forceinline__ void p0_prologue(const Ptrs& P, LAS unsigned char* lds) {
    convert_items(P, lds, IT_L, 0, 0, IT_L - R_TAIL, NL - 1, 1, R_TAIL, P.vcu, P.G);
    OPAQUE_TID();
    const int gw = P.vcu * NWAVES + wave, NGW = P.G * NWAVES;
    for (int m = gw; m < S; m += NGW) {
        const GAS f32x4* xr = (const GAS f32x4*)(P.x + (size_t)m * D) + lane;
        GAS unsigned long long* xb = (GAS unsigned long long*)(P.XB + (size_t)m * D) + lane;
        float ss = 0.f;
#pragma unroll
        for (int j = 0; j < 8; ++j) { const f32x4 v = xr[64 * j]; ss += (v.x * v.x + v.y * v.y) + (v.z * v.z + v.w * v.w);
            xb[64 * j] = (unsigned long long)pk2(v.x, v.y) | ((unsigned long long)pk2(v.z, v.w) << 32); }
        ss = wave_sum(ss);
        if (lane == 0) P.stats[m] = (u64)(ss * FIX_SCALE + 0.5f);
    }
}
__device__ __forceinline__ void final_norm(const Ptrs& P) {
    OPAQUE_TID();
    const int gw = P.vcu * NWAVES + wave, NGW = P.G * NWAVES;
    f32x4 w[4][2];
#pragma unroll
    for (int j = 0; j < 4; ++j) { const GAS f32x4* wf = (const GAS f32x4*)(P.final_w + 512 * j + 8 * lane); w[j][0] = wf[0]; w[j][1] = wf[1]; }
    for (int m0 = gw; m0 < S; m0 += 4 * NGW) {
        v4u xv[4][4];
#pragma unroll
        for (int r = 0; r < 4; ++r) { const int m = m0 + r * NGW; const GAS v4u* xr = (const GAS v4u*)(P.XB + (size_t)(m < S ? m : m0) * D) + lane;
#pragma unroll
            for (int j = 0; j < 4; ++j) xv[r][j] = xr[64 * j]; }
#pragma unroll
        for (int r = 0; r < 4; ++r) { const int m = m0 + r * NGW; float x[4][8]; float ss = 0.f;
#pragma unroll
            for (int j = 0; j < 4; ++j) { unpack8(xv[r][j], x[j]);
#pragma unroll
                for (int q = 0; q < 8; ++q) ss += x[j][q] * x[j][q]; }
            const float ir = rsqrtf(wave_sum(ss) * (1.0f / D) + RMS_EPS);
            if (m < S) {
#pragma unroll
                for (int j = 0; j < 4; ++j) { GAS f32x4* op = (GAS f32x4*)(P.X + (size_t)m * D + 512 * j + 8 * lane); const f32x4 w0 = w[j][0], w1 = w[j][1];
                    op[0] = (f32x4){x[j][0] * ir * w0.x, x[j][1] * ir * w0.y, x[j][2] * ir * w0.z, x[j][3] * ir * w0.w};
                    op[1] = (f32x4){x[j][4] * ir * w1.x, x[j][5] * ir * w1.y, x[j][6] * ir * w1.z, x[j][7] * ir * w1.w}; } } }
    }
}

__device__ __forceinline__ void att_plan_write(const unsigned* qkmax, int* plan, int lane);
__device__ __forceinline__ void m1_kmean_conv(const Ptrs& P, int l) {
    OPAQUE_TID();
    if ((int)blockIdx.x == P.G - 97 && wave == 0) att_plan_write(P.QKMAX + l * 64, P.PLAN + l * 32, lane);
    const GAS float* cw = (const GAS float*)P.conv_w + (size_t)l * 3 * 1024;
    if ((int)blockIdx.x >= P.G - 96) return;
    for (int item = blockIdx.x * 512 + tid; item < (S / 8) * 128; item += (P.G - 96) * 512) { const int c8 = (item & 127) * 8, t0 = (item >> 7) * 8;
        const GAS bf16* pr = (const GAS bf16*)P.PROJ + c8;
        v4u x[10], bgv[8]; f32x4 w[3][2];
#pragma unroll
        for (int i = 0; i < 10; ++i) { const int t = t0 + i - 2; x[i] = *(const GAS v4u*)(pr + (size_t)(t < 0 ? 0 : t) * LDP + PC_CU); }
#pragma unroll
        for (int i = 0; i < 8; ++i) bgv[i] = *(const GAS v4u*)(pr + (size_t)(t0 + i) * LDP + PC_BG);
#pragma unroll
        for (int k = 0; k < 3; ++k) { w[k][0] = *(const GAS f32x4*)(cw + k * 1024 + c8); w[k][1] = *(const GAS f32x4*)(cw + k * 1024 + c8 + 4); }
        if (t0 == 0) { x[0] = v4u{0u, 0u, 0u, 0u}; x[1] = x[0]; }
#pragma unroll
        for (int i = 0; i < 8; ++i) {
            float f2[8], f1[8], f0[8], fb[8], y[8]; unpack8(x[i], f2); unpack8(x[i + 1], f1); unpack8(x[i + 2], f0); unpack8(bgv[i], fb);
#pragma unroll
            for (int j = 0; j < 8; ++j) y[j] = fb[j] * (w[0][j >> 2][j & 3] * f2[j] + w[1][j >> 2][j & 3] * f1[j] + w[2][j >> 2][j & 3] * f0[j]);
            v4u o; o.x = pk2(y[0], y[1]); o.y = pk2(y[2], y[3]); o.z = pk2(y[4], y[5]); o.w = pk2(y[6], y[7]);
            ST16P((P.A3 + (size_t)2 * S * 1024 + (size_t)(t0 + i) * 1024 + c8), o); } }
}
typedef short s16x4 __attribute__((ext_vector_type(4)));
typedef float f32x16 __attribute__((ext_vector_type(16)));
__device__ __forceinline__ int crow(int r, int h) { return (r & 3) + 8 * (r >> 2) + 4 * h; }
__device__ __forceinline__ bf16x8 tr_frag(LAS const unsigned char* tile, int stride, int k0, int col0, int lane) {
    const int h = lane >> 5, blk = (lane >> 4) & 1, q = (lane & 15) >> 2, p = lane & 3;
    LAS const unsigned char* a = tile + (k0 + 8 * h + q) * stride + (col0 + 16 * blk + 4 * p) * 2;
    const s16x4 lo = __builtin_amdgcn_ds_read_tr16_b64_v4i16((LAS s16x4*)a);
    const s16x4 hi = __builtin_amdgcn_ds_read_tr16_b64_v4i16((LAS s16x4*)(a + 4 * stride));
    return (bf16x8){lo[0], lo[1], lo[2], lo[3], hi[0], hi[1], hi[2], hi[3]};
}
__device__ __forceinline__ bf16x8 row_frag(LAS const unsigned char* tile, int stride, int row0, int k0, int lane) {
    return *(LAS const bf16x8*)(tile + (row0 + (lane & 31)) * stride + (k0 + 8 * (lane >> 5)) * 2);
}
constexpr int GL_VL_STRIDE = 576, GL_QK_STRIDE = 272, GL_KD_STRIDE = 320, GL_XS_STRIDE = 144, GL_OL_STRIDE = 1040;
__device__ __forceinline__ void gla_cumsum(float (&la)[16], int tid, LAS float* tot, LAS float* bcum) {
    const int d = tid & 127, g = tid >> 7; float a = 0.f;
#pragma unroll
    for (int i = 0; i < 16; ++i) { a += la[i]; la[i] = a; }
    tot[g * 128 + d] = a;
    __syncthreads();
    const float t0v = tot[d], t1v = tot[128 + d], t2v = tot[256 + d];
    const float off = (g > 0 ? t0v : 0.f) + (g > 1 ? t1v : 0.f) + (g > 2 ? t2v : 0.f);
#pragma unroll
    for (int i = 0; i < 16; ++i) bcum[(16 * g + i) * 128 + d] = la[i] + off;
    __syncthreads();
}
__device__ __forceinline__ void m1_gla_local(const Ptrs& P, LAS unsigned char* lds) {
    OPAQUE_TID();
    LAS float* bcum = (LAS float*)lds; LAS unsigned char* KD = lds + 32768; LAS unsigned char* VL = lds + 65536; LAS float* tot = (LAS float*)(lds + 102400);
    LAS unsigned char* stg = lds + wave * 8192;
    for (int unit = blockIdx.x; unit < 512; unit += P.G) { const int h = unit >> 7, n = unit & 127, t0 = n * 64;
        float la[16]; { const GAS float* p = (const GAS float*)P.LA + (size_t)(t0 + 16 * (tid >> 7)) * 512 + h * 128 + (tid & 127);
#pragma unroll
            for (int i = 0; i < 16; ++i) la[i] = p[(size_t)i * 512]; }
        v4u kq[2], vv[4];
#pragma unroll
        for (int i = 0; i < 2; ++i) { const int idx = tid + 512 * i, s = idx >> 4, ch = idx & 15; kq[i] = *(const GAS v4u*)((const GAS bf16*)P.PROJ + (size_t)(t0 + s) * LDP + PC_KG + h * 128 + 8 * ch); }
#pragma unroll
        for (int j = 0; j < 4; ++j) { const int idx = tid + 512 * j, s = idx >> 5, ch = idx & 31; vv[j] = *(const GAS v4u*)((const GAS bf16*)P.PROJ + (size_t)(t0 + s) * LDP + PC_VG + h * 256 + 8 * ch); }
        gla_cumsum(la, tid, tot, bcum);
        if (tid < 128) P.DECAY[(h * 128 + n) * 128 + tid] = __expf(bcum[63 * 128 + tid]);
#pragma unroll
        for (int i = 0; i < 2; ++i) { const int idx = tid + 512 * i, s = idx >> 4, ch = idx & 15;
            const f32x4 b0 = *(const LAS f32x4*)(bcum + s * 128 + 8 * ch), b1 = *(const LAS f32x4*)(bcum + s * 128 + 8 * ch + 4), l0 = *(const LAS f32x4*)(bcum + 63 * 128 + 8 * ch), l1 = *(const LAS f32x4*)(bcum + 63 * 128 + 8 * ch + 4);
            float k[8]; unpack8(kq[i], k);
            v4u w; w.x = pk2(k[0] * __expf(l0.x - b0.x), k[1] * __expf(l0.y - b0.y)); w.y = pk2(k[2] * __expf(l0.z - b0.z), k[3] * __expf(l0.w - b0.w));
            w.z = pk2(k[4] * __expf(l1.x - b1.x), k[5] * __expf(l1.y - b1.y)); w.w = pk2(k[6] * __expf(l1.z - b1.z), k[7] * __expf(l1.w - b1.w));
            *(LAS v4u*)(KD + s * GL_KD_STRIDE + ch * 16) = w; }
#pragma unroll
        for (int j = 0; j < 4; ++j) { const int idx = tid + 512 * j, s = idx >> 5, ch = idx & 31; *(LAS v4u*)(VL + s * GL_VL_STRIDE + ch * 16) = vv[j]; }
        __syncthreads();
        f32x16 acc[4];
#pragma unroll
        for (int dt = 0; dt < 4; ++dt)
#pragma unroll
            for (int r = 0; r < 16; ++r) acc[dt][r] = 0.f;
#pragma unroll
        for (int ks = 0; ks < 4; ++ks) { const bf16x8 a = tr_frag(VL, GL_VL_STRIDE, 16 * ks, 32 * wave, lane);
#pragma unroll
            for (int dt = 0; dt < 4; ++dt) { const bf16x8 bb = tr_frag(KD, GL_KD_STRIDE, 16 * ks, 32 * dt, lane); acc[dt] = __builtin_amdgcn_mfma_f32_32x32x16_bf16(a, bb, acc[dt], 0, 0, 0); } }
        __syncthreads();
#pragma unroll
        for (int r = 0; r < 16; ++r) { LAS unsigned char* rowp = stg + crow(r, lane >> 5) * 256 + (lane & 31) * 2;
#pragma unroll
            for (int dt = 0; dt < 4; ++dt) *(LAS bf16*)(rowp + dt * 64) = (bf16)f2bf(acc[dt][r]); }
        LDS_WAIT();
        { GAS bf16* kvt = (GAS bf16*)P.KVT + ((size_t)(h * 128 + n) * 256 + 32 * wave) * 128;
#pragma unroll
            for (int i = 0; i < 8; ++i) { const int row = 4 * i + (lane >> 4); ST16((kvt + (size_t)row * 128 + 8 * (lane & 15)), *(const LAS v4u*)(stg + row * 256 + (lane & 15) * 16)); } }
        __syncthreads();
    }
}
typedef float f32x2v __attribute__((ext_vector_type(2)));
__device__ __forceinline__ void m2_gla_scan(const Ptrs& P) {
    OPAQUE_TID();
    if (tid < 256) for (int gid = blockIdx.x * 256 + tid; gid < 4 * 16384; gid += P.G * 256) { const int h = gid >> 14, rem = gid & 16383, e = rem >> 6, d = (rem & 63) * 2; float s0 = 0.f, s1 = 0.f;
        const GAS bf16* kp = (const GAS bf16*)P.KVT + ((size_t)(h * 128) * 256 + e) * 128 + d; GAS bf16* sp = (GAS bf16*)P.SPT + ((size_t)(h * 128) * 256 + e) * 128 + d; const GAS float* dp = (const GAS float*)P.DECAY + (h * 128) * 128 + d;
        unsigned kvA[16], kvB[16]; f32x2v dA[16], dB[16];
#define SCAN_LOAD(KV, DD, N0) do { _Pragma("unroll") for (int j = 0; j < 16; ++j) { KV[j] = *(const GAS unsigned*)(kp + (size_t)((N0) + j) * 32768); DD[j] = *(const GAS f32x2v*)(dp + ((N0) + j) * 128); } } while (0)
#define SCAN_STEP(KV, DD, N0) do { _Pragma("unroll") for (int j = 0; j < 16; ++j) { *(GAS unsigned*)(sp + (size_t)((N0) + j) * 32768) = pk2(s0, s1); s0 = DD[j].x * s0 + bflo(KV[j]); s1 = DD[j].y * s1 + bfhi(KV[j]); } } while (0)
        SCAN_LOAD(kvA, dA, 0);
#pragma unroll 1
        for (int n0 = 0; n0 < 96; n0 += 32) { SCAN_LOAD(kvB, dB, n0 + 16); SCAN_STEP(kvA, dA, n0); SCAN_LOAD(kvA, dA, n0 + 32); SCAN_STEP(kvB, dB, n0 + 16); }
        SCAN_LOAD(kvB, dB, 112); SCAN_STEP(kvA, dA, 96); SCAN_STEP(kvB, dB, 112);
#undef SCAN_LOAD
#undef SCAN_STEP
    }
}
namespace mo {
constexpr float SCALE = 0.08838834764831845f, THR = 8.f;
constexpr int NW = 8, QBLK = 32, KVBLK = 64, QB = 256, DH = 128, LDQ = 128, LDO = 1024;
constexpr int SHM_V = KVBLK * DH * 2, SHM_K = KVBLK * DH * 2, ATT_STG = 2 * SHM_V + 2 * SHM_K  , ATT_WS = RING_BYTES + 1024  ;
constexpr int ATT_RL = RING_BYTES + 4096  , ATT_SL = RING_BYTES + 5120  ;
static_assert(ATT_STG + NW * 8192 <= RING_BYTES && ATT_WS + NW * 256 <= ATT_RL && ATT_SL + 1024 <= LDS_BYTES && ATT_WS >= MISC_OFF + 128, "attention LDS");
typedef short s16x4 __attribute__((ext_vector_type(4)));
typedef float f32x16 __attribute__((ext_vector_type(16)));
typedef unsigned u32x4 __attribute__((ext_vector_type(4)));
#define KSWZ(row, colB) ((row) * 256 + ((colB) ^ (((row) & 7) << 4)))
#define SBAR() __builtin_amdgcn_sched_barrier(0)
__device__ __forceinline__ int v_st(int k, int c) { const int kk = (k & ~0xC) | ((k & 4) << 1) | ((k & 8) >> 1); return ((kk >> 3) * 4 + (c >> 5)) * 512 + ((kk & 7) * 32 + (c & 31)) * 2; }
__device__ __forceinline__ int v_rd_base(int lane) { return ((lane & 3) << 3) | (((lane >> 2) & 3) << 6) | (((lane >> 4) & 1) << 5) | (((lane >> 5) & 1) << 8); }
constexpr int v_rd_off(int d0, int ks, int half) { return d0 * 512 + ks * 4096 + half * 2048; }
__device__ __forceinline__ int crow(int r, int hi) { return (r & 3) + 8 * (r >> 2) + 4 * hi; }
__device__ __forceinline__ unsigned cvtpk(float lo, float hi) { unsigned r; asm volatile("v_cvt_pk_bf16_f32 %0, %1, %2" : "=v"(r) : "v"(lo), "v"(hi)); return r; }
__device__ __forceinline__ bf16x8 pack8(f32x4 a, f32x4 b) { u32x4 w = {cvtpk(a[0], a[1]), cvtpk(a[2], a[3]), cvtpk(b[0], b[1]), cvtpk(b[2], b[3])}; return *reinterpret_cast<bf16x8*>(&w); }
__device__ __forceinline__ bf16x8 load8(const GAS bf16* p) { return *reinterpret_cast<const GAS bf16x8*>(p); }
__device__ __forceinline__ void mask_tile(f32x16& p0, f32x16& p1, int dq) {
    const float NEG = -__builtin_inff();
#pragma unroll
    for (int r = 0; r < 16; ++r) { const int c = (r & 3) + 8 * (r >> 2); if (dq - c < 0) p0[r] = NEG; if (dq - c - 32 < 0) p1[r] = NEG; }
}
__device__ __forceinline__ void partialSM(f32x16& p0, f32x16& p1, float& m_reg, float& mn, float& alpha) {
    float pmax = p0[0]; for (int r = 1; r < 16; ++r) pmax = fmaxf(pmax, p0[r]); for (int r = 0; r < 16; ++r) pmax = fmaxf(pmax, p1[r]);
    { auto rr = __builtin_amdgcn_permlane32_swap(__float_as_uint(pmax), __float_as_uint(pmax), false, false);
      pmax = fmaxf(__uint_as_float(rr[0]), __uint_as_float(rr[1])); }
    constexpr float C2 = 1.4426950408889634f * SCALE;
    if (__builtin_expect(__all((pmax - m_reg) * SCALE <= THR), 1)) { mn = m_reg; alpha = 1.f; }
    else { mn = fmaxf(m_reg, pmax); alpha = __builtin_amdgcn_exp2f((m_reg - mn) * C2); m_reg = mn; }
    const float mnL = -mn * C2;
    for (int r = 0; r < 16; ++r) p0[r] = fmaf(p0[r], C2, mnL); for (int r = 0; r < 16; ++r) p1[r] = fmaf(p1[r], C2, mnL);
    for (int r = 0; r < 16; ++r) p0[r] = __builtin_amdgcn_exp2f(p0[r]);
}
__device__ __forceinline__ void finishSM(f32x16& p0, f32x16& p1, float alpha, float& l_reg, bf16x8& pa0, bf16x8& pa1, bf16x8& pa2, bf16x8& pa3) {
    for (int r = 0; r < 16; ++r) p1[r] = __builtin_amdgcn_exp2f(p1[r]);
    float ps = 0; for (int r = 0; r < 16; ++r) ps += p0[r]; for (int r = 0; r < 16; ++r) ps += p1[r];
    { auto rr = __builtin_amdgcn_permlane32_swap(__float_as_uint(ps), __float_as_uint(ps), false, false);
      ps = __uint_as_float(rr[0]) + __uint_as_float(rr[1]); }
    l_reg = l_reg * alpha + ps;
#define PK4(P, B_, OUT) do { unsigned a0 = cvtpk(P[B_+0], P[B_+1]), a1 = cvtpk(P[B_+2], P[B_+3]);                          \
        unsigned b0 = cvtpk(P[B_+4], P[B_+5]), b1 = cvtpk(P[B_+6], P[B_+7]);                                             \
        auto r0 = __builtin_amdgcn_permlane32_swap(a0, b0, false, false); auto r1 = __builtin_amdgcn_permlane32_swap(a1, b1, false, false); \
        u32x4 w = {r0[0], r1[0], r0[1], r1[1]}; OUT = *reinterpret_cast<bf16x8*>(&w); } while (0)
    PK4(p0, 0, pa0); PK4(p0, 8, pa1); PK4(p1, 0, pa2); PK4(p1, 8, pa3);
#undef PK4
}
template <int KB>
__device__ __forceinline__ void qkt(f32x16& p0, f32x16& p1, const char* K_lds, int r32, int hi, const bf16x8* qr, float base, float sl) {
    { const float sl8 = 8.f * sl, sl32 = 32.f * sl; float gb = base;
#pragma unroll
        for (int g4 = 0; g4 < 4; ++g4) { float t = gb;
#pragma unroll
            for (int i = 0; i < 4; ++i) { p0[4 * g4 + i] = t; p1[4 * g4 + i] = t + sl32; t += sl; }
            gb += sl8; } }
    const char* kb[4];
#pragma unroll
    for (int dd = 0; dd < 4; ++dd) kb[dd] = K_lds + KB * SHM_K + KSWZ(r32, (dd * 16 + hi * 8) * 2);
#pragma unroll
    for (int d0 = 0; d0 < 8; ++d0) { const char* a = kb[d0 & 3] + (d0 >> 2) * 128;
        bf16x8 b0 = *reinterpret_cast<const bf16x8*>(a);
        bf16x8 b1 = *reinterpret_cast<const bf16x8*>(a + 32 * 256);
        p0 = __builtin_amdgcn_mfma_f32_32x32x16_bf16(b0, qr[d0], p0, 0, 0, 0);
        p1 = __builtin_amdgcn_mfma_f32_32x32x16_bf16(b1, qr[d0], p1, 0, 0, 0); }
}
template <int VB>
__device__ __forceinline__ void pv_tile(f32x16* o, int vb0, bf16x8 pa0, bf16x8 pa1, bf16x8 pa2, bf16x8 pa3) {
#define TRRD(dst, off) asm volatile("ds_read_b64_tr_b16 %0, %1 offset:%2" : "=&v"(dst) : "v"(vb0), "i"(off) : "memory")
#define PV_D0(d0) do { s16x4 l0, l1, l2, l3, h0, h1, h2, h3; constexpr int b_ = VB * SHM_V + v_rd_off(d0, 0, 0); \
        TRRD(l0, b_); TRRD(h0, b_ + 2048); TRRD(l1, b_ + 4096); TRRD(h1, b_ + 6144); TRRD(l2, b_ + 8192); TRRD(h2, b_ + 10240); TRRD(l3, b_ + 12288); TRRD(h3, b_ + 14336); \
        asm volatile("s_waitcnt lgkmcnt(0)" ::: "memory"); SBAR();   \
        o[d0] = __builtin_amdgcn_mfma_f32_32x32x16_bf16(pa0, (bf16x8){l0[0], l0[1], l0[2], l0[3], h0[0], h0[1], h0[2], h0[3]}, o[d0], 0, 0, 0);   \
        o[d0] = __builtin_amdgcn_mfma_f32_32x32x16_bf16(pa1, (bf16x8){l1[0], l1[1], l1[2], l1[3], h1[0], h1[1], h1[2], h1[3]}, o[d0], 0, 0, 0);   \
        o[d0] = __builtin_amdgcn_mfma_f32_32x32x16_bf16(pa2, (bf16x8){l2[0], l2[1], l2[2], l2[3], h2[0], h2[1], h2[2], h2[3]}, o[d0], 0, 0, 0);   \
        o[d0] = __builtin_amdgcn_mfma_f32_32x32x16_bf16(pa3, (bf16x8){l3[0], l3[1], l3[2], l3[3], h3[0], h3[1], h3[2], h3[3]}, o[d0], 0, 0, 0); } while (0)
    PV_D0(0); PV_D0(1); PV_D0(2); PV_D0(3);
#undef PV_D0
#undef TRRD
}
struct Seg { int P0, jb, je, slot; };
struct Head { unsigned char* ws; int h, l; float sl;
    __device__ __forceinline__ const GAS bf16* HB(int type) const { return (const GAS bf16*)(ws + WS_QKVH) + (size_t)(type * 8 + h) * S * 128; }
    __device__ __forceinline__ const GAS float* KM() const { unsigned char* w = ws; asm volatile("" : "+s"(w)); return (const GAS float*)(w + WS_CTL + CTL_KSUM) + (size_t)l * 32 * 1024 + h * 128; }
    __device__ __forceinline__ GAS bf16* OB() const { unsigned char* w = ws; asm volatile("" : "+s"(w)); return (GAS bf16*)(w + WS_A3) + h * 128; }
    __device__ __forceinline__ GAS float* PO() const { unsigned char* w = ws; asm volatile("" : "+s"(w)); return (GAS float*)(w + WS_T); }
    __device__ __forceinline__ GAS float* PML() const { unsigned char* w = ws; asm volatile("" : "+s"(w)); return (GAS float*)(w + WS_PML); }
    __device__ __forceinline__ GAS float* RP() const { unsigned char* w = ws; asm volatile("" : "+s"(w)); return (GAS float*)(w + WS_RP) + (size_t)(h - 5) * S * 3 * 128; }
    __device__ __forceinline__ GAS float* RPML() const { unsigned char* w = ws; asm volatile("" : "+s"(w)); return (GAS float*)(w + WS_RPML) + (size_t)(h - 5) * S * 3 * 2; }
};
struct Seam { bf16x8 qr[8]; bf16x8 st_v0, st_v1, st_k0, st_k1; };
#define ROW(p, k0, rr) ((const GAS bf16*)((const GAS char*)(p) + (unsigned)((((k0) + (rr)) * LDQ + sc) * 2)))
#define VMW() asm volatile("s_waitcnt vmcnt(0)" ::: "memory")
#define VMWN(n) asm volatile("s_waitcnt vmcnt(%0)" :: "i"(n) : "memory")
#define SLOAD_H(Kp, Vp, k0) do { S.st_v0 = load8(ROW(Vp, k0, sr)); S.st_v1 = load8(ROW(Vp, k0, 32 + sr)); S.st_k0 = load8(ROW(Kp, k0, sr)); S.st_k1 = load8(ROW(Kp, k0, 32 + sr)); } while (0)
#define SWRITE_HK(bf) do { *(bf16x8*)(K_lds + (bf) * SHM_K + kws) = S.st_k0; *(bf16x8*)(K_lds + (bf) * SHM_K + kws + 32 * 256) = S.st_k1; } while (0)
#define SWRITE_HV(bf) do { *(bf16x8*)(V_lds + (bf) * SHM_V + vst0) = S.st_v0; *(bf16x8*)(V_lds + (bf) * SHM_V + vst1) = S.st_v1; } while (0)
#define SWRITE_H(bf) do { SWRITE_HV(bf); SWRITE_HK(bf); } while (0)
template <bool G> __device__ __forceinline__ void att_prime(const Head& H, const Seg& cur, char* lds, LAS unsigned char* lds3, Seam& S, int wave_sgpr) {
    int tid; asm volatile("v_mbcnt_lo_u32_b32 %0, -1, 0\n\tv_mbcnt_hi_u32_b32 %0, -1, %0" : "=v"(tid)); tid += wave_sgpr * 64;
    const int wid = __builtin_amdgcn_readfirstlane(tid >> 6), lane = tid & 63, r32 = lane & 31, hi = lane >> 5;
    const int sr = tid >> 4, sc = (tid & 15) * 8, kws = KSWZ(sr, sc * 2); char* K_lds = lds + 2 * SHM_V;
    const int kb0 = cur.jb * KVBLK;
    const int qrow = G ? ((const LAS int*)(lds3 + ATT_RL))[wid * QBLK + r32] : cur.P0 + wid * QBLK + r32;
#pragma unroll
    for (int d0 = 0; d0 < 8; ++d0) S.qr[d0] = load8(H.HB(0) + (size_t)qrow * LDQ + d0 * 16 + hi * 8);
    SLOAD_H(H.HB(1), H.HB(2), kb0); VMW(); SWRITE_HK(0);
    __syncthreads();
}
template <bool G> __device__ __forceinline__ void att_block(const Head& H, const Seg& cur, const Seg& nxt, char* lds, LAS unsigned char* lds3, Seam& S, int tid_in) {
    int tid; asm volatile("v_mbcnt_lo_u32_b32 %0, -1, 0\n\tv_mbcnt_hi_u32_b32 %0, -1, %0" : "=v"(tid)); tid += tid_in * 64;
    const int wid = __builtin_amdgcn_readfirstlane(tid >> 6), lane = tid & 63, r32 = lane & 31, hi = lane >> 5;
    const int NT = cur.je - cur.jb, kbn = nxt.jb * KVBLK;
    const int qlo = G ? (1 << 28) : cur.P0 + wid * QBLK, qm = qlo + r32 - 4 * hi, own = cur.P0 >> 8;
    const int tl = G ? ((const LAS int*)(lds3 + ATT_RL))[wid * QBLK + r32] : 0;
    char* V_lds = lds; char* K_lds = lds + 2 * SHM_V;
    float* ws = (float*)(lds + ATT_WS) + wid * 64; float* li_l = ws, * al_l = ws + 32;
    float m_reg = -1e30f, l_reg = 0; f32x16 o[4] = {};
    const int sr = tid >> 4, sc = (tid & 15) * 8, vst0 = v_st(sr, sc), vst1 = v_st(32 + sr, sc), kws = KSWZ(sr, sc * 2);
    const int vb0 = (int)(uintptr_t)V_lds + v_rd_base(lane);
    const GAS bf16* Kh = H.HB(1); const GAS bf16* Vh = H.HB(2); const float sl = H.sl;
    unsigned selm = 0u;
    if constexpr (!G) { f32x16 g = {};
#pragma unroll
        for (int d0 = 0; d0 < 8; ++d0) { const GAS float* kp = H.KM() + (size_t)r32 * 1024 + d0 * 16 + hi * 8; const f32x4 a = *(const GAS f32x4*)kp, b = *(const GAS f32x4*)(kp + 4);
            const bf16x8 kh = pack8(a, b); const unsigned short* khs = reinterpret_cast<const unsigned short*>(&kh);
            f32x4 ra, rb; ra[0] = a[0] - bf2f(khs[0]); ra[1] = a[1] - bf2f(khs[1]); ra[2] = a[2] - bf2f(khs[2]); ra[3] = a[3] - bf2f(khs[3]);
            rb[0] = b[0] - bf2f(khs[4]); rb[1] = b[1] - bf2f(khs[5]); rb[2] = b[2] - bf2f(khs[6]); rb[3] = b[3] - bf2f(khs[7]);
            g = __builtin_amdgcn_mfma_f32_32x32x16_bf16(kh, S.qr[d0], g, 0, 0, 0); g = __builtin_amdgcn_mfma_f32_32x32x16_bf16(pack8(ra, rb), S.qr[d0], g, 0, 0, 0); }
        const float NEG = -__builtin_inff();
#pragma unroll
        for (int k = 0; k < 3; ++k) { float bv = NEG; int bi = 64;
#pragma unroll
            for (int r = 0; r < 16; ++r) { const int n = crow(r, hi); const float v = (n < own && !((selm >> n) & 1u)) ? g[r] : NEG; if (v > bv) { bv = v; bi = n; } }
            float ov; int oi; { auto rv = __builtin_amdgcn_permlane32_swap(__float_as_uint(bv), __float_as_uint(bv), false, false); auto ri = __builtin_amdgcn_permlane32_swap((unsigned)bi, (unsigned)bi, false, false);
                ov = __uint_as_float(hi ? rv[0] : rv[1]); oi = (int)(hi ? ri[0] : ri[1]); }
            if (ov > bv || (ov == bv && oi < bi)) { bv = ov; bi = oi; }
            if (bv > NEG) selm |= 1u << bi; } }
#define RESC(a) do { if (__any((a) < 1.f)) { if (hi == 0) al_l[r32] = (a); asm volatile("s_waitcnt lgkmcnt(0)" ::: "memory");              \
                     for (int d_ = 0; d_ < 4; ++d_) for (int r = 0; r < 16; ++r) o[d_][r] *= al_l[crow(r, hi)]; } } while (0)
#define KBASE(t) ((cur.jb + (t)) * KVBLK)
#define TBASE(t) (G ? sl * (float)(KBASE(t) + 4 * hi - (tl & ~255))   : (((KBASE(t) >> 8) == own || ((selm >> (KBASE(t) >> 8)) & 1u)) ? sl * (float)(KBASE(t) - cur.P0 + 4 * hi) : -__builtin_inff()))
#define MASKT(P0_, P1_, t) do { const int kb_ = KBASE(t); if (kb_ + KVBLK - 1 > qlo) mask_tile(P0_, P1_, qm - kb_); } while (0)
#define SEAM_K0() do { if constexpr (!G) { VMWN(8); SWRITE_HK(0); } SBAR(); } while (0)
    f32x16 pA0, pA1, pB0, pB1; float mnA, mnB, alA, alB; bf16x8 pa0, pa1, pa2, pa3;
    SWRITE_HV(0); SBAR();
    if (NT > 1) SLOAD_H(Kh, Vh, KBASE(1));
    SBAR(); qkt<0>(pA0, pA1, K_lds, r32, hi, S.qr, TBASE(0), sl);
    MASKT(pA0, pA1, 0); partialSM(pA0, pA1, m_reg, mnA, alA);
    if (NT > 1) { VMW(); SWRITE_H(1); }
    __syncthreads();
#define HALF_STEP(PX0, PX1, mnX, alX, PY0, PY1, alY, t, KB, VB, SB) do {                                                      \
        SBAR(); qkt<KB>(PX0, PX1, K_lds, r32, hi, S.qr, TBASE(t), sl);                                                        \
        finishSM(PY0, PY1, alY, l_reg, pa0, pa1, pa2, pa3); SBAR();                                                           \
        if ((t) + 1 < NT) { SLOAD_H(Kh, Vh, KBASE((t) + 1)); SBAR(); }                                                        \
        pv_tile<VB>(o, vb0, pa0, pa1, pa2, pa3); MASKT(PX0, PX1, (t)); partialSM(PX0, PX1, m_reg, mnX, alX);                  \
        __syncthreads();                                                                                                      \
        if ((t) + 1 < NT) { VMW(); SWRITE_H(SB); }                                                                            \
        RESC(alX); __syncthreads(); } while (0)
    for (int t = 1; t + 1 < NT; t += 2) {
        HALF_STEP(pB0, pB1, mnB, alB, pA0, pA1, alA, t, 1, 0, 0);
        HALF_STEP(pA0, pA1, mnA, alA, pB0, pB1, alB, t + 1, 0, 1, 1);
    }
    const bool even = (NT & 1) == 0;
    if (even) { SBAR(); qkt<1>(pB0, pB1, K_lds, r32, hi, S.qr, TBASE(NT - 1), sl); SBAR(); }
    if constexpr (!G) { SLOAD_H(Kh, Vh, kbn); } SBAR();
    int r32_t = r32, hi_t = hi; asm volatile("" : "+v"(r32_t), "+v"(hi_t));
#pragma unroll
    for (int d0 = 0; d0 < 8; ++d0) if constexpr (!G) S.qr[d0] = load8(H.HB(0) + (size_t)(nxt.P0 + wid * QBLK + r32_t) * LDQ + d0 * 16 + hi_t * 8);
    SBAR();
    finishSM(pA0, pA1, alA, l_reg, pa0, pa1, pa2, pa3); SBAR();
    pv_tile<0>(o, vb0, pa0, pa1, pa2, pa3);
    if (even) { MASKT(pB0, pB1, NT - 1); partialSM(pB0, pB1, m_reg, mnB, alB); __syncthreads(); RESC(alB);
        finishSM(pB0, pB1, alB, l_reg, pa0, pa1, pa2, pa3); SBAR(); pv_tile<1>(o, vb0, pa0, pa1, pa2, pa3); }
    SBAR(); SEAM_K0();
    int hi_e = hi, r32_e = r32; asm volatile("" : "+v"(hi_e), "+v"(r32_e));
    LAS unsigned char* stg = lds3 + ATT_STG + wid * 8192;
    if constexpr (G) {
        const LAS int* rl = (const LAS int*)(lds3 + ATT_RL); const LAS int* sll = (const LAS int*)(lds3 + ATT_SL);
        GAS float* rp = H.RP();
#pragma unroll
        for (int ps = 0; ps < 2; ++ps) {
#pragma unroll
            for (int r = 0; r < 16; ++r) { LAS unsigned char* rowp = stg + crow(r, hi_e) * 256 + r32_e * 4; *(LAS float*)rowp = o[2 * ps][r]; *(LAS float*)(rowp + 128) = o[2 * ps + 1][r]; }
            asm volatile("s_waitcnt lgkmcnt(0)" ::: "memory");
#pragma unroll
            for (int i = 0; i < 8; ++i) { const int row = 4 * i + (lane >> 4), rr = wid * QBLK + row, t = rl[rr], sq = sll[rr];
                if (sq >= 0) ST16((rp + ((size_t)t * 3 + sq) * 128 + 64 * ps + 4 * (lane & 15)), *(const LAS f32x4*)(stg + row * 256 + (lane & 15) * 16)); }
            asm volatile("s_waitcnt lgkmcnt(0)" ::: "memory"); }
        if (hi_e == 0) { const int rr = wid * QBLK + r32_e, t = rl[rr], sq = sll[rr]; if (sq >= 0) { GAS float* ml = H.RPML() + ((size_t)t * 3 + sq) * 2; ml[0] = m_reg; ml[1] = l_reg; } }
    } else
    if (cur.slot < 0) {
        if (hi_e == 0) li_l[r32_e] = l_reg; asm volatile("s_waitcnt lgkmcnt(0)" ::: "memory");
        float rli[16];
#pragma unroll
        for (int r = 0; r < 16; ++r) rli[r] = __builtin_amdgcn_rcpf(li_l[crow(r, hi_e)]);
#pragma unroll
        for (int r = 0; r < 16; ++r) { LAS unsigned char* rowp = stg + crow(r, hi_e) * 256 + r32_e * 2;
#pragma unroll
            for (int d0 = 0; d0 < 4; ++d0) *(LAS bf16*)(rowp + d0 * 64) = (bf16)f2bf(o[d0][r] * rli[r]); }
        asm volatile("s_waitcnt lgkmcnt(0)" ::: "memory");
        GAS bf16* Ow = H.OB() + (size_t)(cur.P0 + wid * QBLK) * LDO;
#pragma unroll
        for (int i = 0; i < 8; ++i) { const int row = 4 * i + (lane >> 4); ST16((Ow + (size_t)row * LDO + 8 * (lane & 15)), *(const LAS u32x4*)(stg + row * 256 + (lane & 15) * 16)); }
    } else {
        GAS float* Pw = H.PO() + ((size_t)cur.slot * 256 + wid * QBLK) * DH;
#pragma unroll
        for (int ps = 0; ps < 2; ++ps) {
#pragma unroll
            for (int r = 0; r < 16; ++r) { LAS unsigned char* rowp = stg + crow(r, hi_e) * 256 + r32_e * 4; *(LAS float*)rowp = o[2 * ps][r]; *(LAS float*)(rowp + 128) = o[2 * ps + 1][r]; }
            asm volatile("s_waitcnt lgkmcnt(0)" ::: "memory");
#pragma unroll
            for (int i = 0; i < 8; ++i) { const int row = 4 * i + (lane >> 4); ST16((Pw + (size_t)row * DH + 64 * ps + 4 * (lane & 15)), *(const LAS f32x4*)(stg + row * 256 + (lane & 15) * 16)); }
            asm volatile("s_waitcnt lgkmcnt(0)" ::: "memory"); }
        if (hi_e == 0) { GAS float* ml = H.PML() + ((size_t)cur.slot * 256 + wid * QBLK + r32_e) * 2; ml[0] = m_reg; ml[1] = l_reg; }
    }
    __syncthreads();
#undef RESC
#undef KBASE
#undef TBASE
#undef MASKT
#undef SEAM_K0
#undef HALF_STEP
}
#undef ROW
#undef VMW
#undef VMWN
#undef SLOAD_H
#undef SWRITE_HK
#undef SWRITE_HV
#undef SWRITE_H
#undef KSWZ
#undef SBAR
}

constexpr float ATT_CUT = 26.f;
constexpr int ATT_BLK_COST = 2, ATT_MAXP = 8;
constexpr int ATT_NG = 99, ATT_ND = 256 - ATT_NG;
struct AttPlan { int rt, T, W, w, h, vbase; };
__device__ __forceinline__ int att_rt(const unsigned qk, int h) {
    float q2 = 0.f, k2 = 0.f;
#pragma unroll
    for (int j = 0; j < 4; ++j) { q2 += __uint_as_float(__builtin_amdgcn_readlane(qk, h * 4 + j)); k2 += __uint_as_float(__builtin_amdgcn_readlane(qk, 32 + h * 4 + j)); }
    const float B = sqrtf(q2 * k2) * mo::SCALE * 1.02f;
    const float R = (2.f * B + ATT_CUT) * exp2f((float)(h + 1));
    const float rtf = floorf((R + 63.f) * (1.0f / 64.f));
    return rtf >= 128.f ? 128 : (int)rtf;
}
__device__ __forceinline__ int att_tiles(int rt) { int t = 0; for (int b = 0; b < 32; ++b) { const int jl = 4 * b - rt; t += 4 * (b + 1) - (jl > 0 ? jl : 0); } return t; }
__device__ __forceinline__ void att_plan_write(const unsigned* qkmax, int* plan, int lane) {
    int rt[8], T[8], cum[9]; cum[0] = 0; const unsigned qk = __hip_atomic_load(qkmax + lane, __ATOMIC_RELAXED, __HIP_MEMORY_SCOPE_AGENT);
#pragma unroll
    for (int h = 0; h < 8; ++h) { rt[h] = h >= 5 ? 0 : __builtin_amdgcn_readfirstlane(att_rt(qk, h)); T[h] = att_tiles(rt[h]); cum[h + 1] = cum[h] + T[h] + 32 * ATT_BLK_COST; }
    int prev = 0;
#pragma unroll
    for (int h = 0; h < 8; ++h) { int bnd = (ATT_ND * cum[h + 1] + cum[8] / 2) / cum[8]; if (bnd <= prev) bnd = prev + 1; if (h == 7) bnd = ATT_ND;
        if (lane == 0) { __hip_atomic_store(plan + 4 * h, rt[h], RLX_AGENT); __hip_atomic_store(plan + 4 * h + 1, T[h], RLX_AGENT); __hip_atomic_store(plan + 4 * h + 2, prev, RLX_AGENT); __hip_atomic_store(plan + 4 * h + 3, bnd - prev, RLX_AGENT); }
        prev = bnd; }
}
__device__ __forceinline__ AttPlan att_plan(const int* plan, int v, int lane) {
    const int val = __hip_atomic_load(plan + (lane & 31), RLX_AGENT);
    AttPlan p; p.h = 0; p.vbase = 0; p.rt = 0; p.T = 1; p.W = 1; p.w = 0;
#pragma unroll
    for (int h = 0; h < 8; ++h) { const int rt = __builtin_amdgcn_readlane(val, 4 * h), T = __builtin_amdgcn_readlane(val, 4 * h + 1), vb = __builtin_amdgcn_readlane(val, 4 * h + 2), W = __builtin_amdgcn_readlane(val, 4 * h + 3);
        if (v >= vb && v < vb + W) { p.h = h; p.vbase = vb; p.rt = rt; p.T = T; p.W = W; p.w = v - vb; } }
    return p;
}
struct SegIter { int b, pre, lo, hi, rt, v, h;
    __device__ __forceinline__ bool next(mo::Seg& s) {
        while (b < 32) { const int jl0 = 4 * b - rt, jl = jl0 > 0 ? jl0 : 0, nb = 4 * (b + 1) - jl, pb = pre, bb = b; pre += nb; ++b;
            const int s0 = lo > pb ? lo : pb, e0 = hi < pb + nb ? hi : pb + nb;
            if (e0 > s0) { s.P0 = bb * 256; s.jb = jl + (s0 - pb); s.je = jl + (e0 - pb); s.slot = (s0 == pb && e0 == pb + nb) ? (h >= 5 ? 512 + (h - 5) * 32 + bb : -1) : (pb < lo ? 2 * v : 2 * v + 1); return true; }
            if (pb + nb >= hi) b = 32; }
        return false; }
};
__device__ __forceinline__ void m1_att_select(const Ptrs& P, int l) {
    OPAQUE_TID();
    const int u = (int)blockIdx.x - (P.G - 96); if (u < 0) return;
    const int hs = u >> 5, b = u & 31, h = 5 + hs, r32 = lane & 31, hi = lane >> 5, row = b * 256 + wave * 32 + r32;
    const GAS bf16* qp = (const GAS bf16*)P.QKVH + ((size_t)h * S + row) * 128 + hi * 8; const GAS float* km = (const GAS float*)P.KSUM + (size_t)l * 32 * 1024 + h * 128 + (size_t)r32 * 1024 + hi * 8;
    mo::f32x16 g = {};
#pragma unroll
    for (int d0 = 0; d0 < 8; ++d0) { const bf16x8 q = *(const GAS bf16x8*)(qp + d0 * 16); const f32x4 a = *(const GAS f32x4*)(km + d0 * 16), c = *(const GAS f32x4*)(km + d0 * 16 + 4);
        const bf16x8 kh = mo::pack8(a, c); const unsigned short* khs = reinterpret_cast<const unsigned short*>(&kh);
        f32x4 ra, rb; ra[0] = a[0] - bf2f(khs[0]); ra[1] = a[1] - bf2f(khs[1]); ra[2] = a[2] - bf2f(khs[2]); ra[3] = a[3] - bf2f(khs[3]);
        rb[0] = c[0] - bf2f(khs[4]); rb[1] = c[1] - bf2f(khs[5]); rb[2] = c[2] - bf2f(khs[6]); rb[3] = c[3] - bf2f(khs[7]);
        g = __builtin_amdgcn_mfma_f32_32x32x16_bf16(kh, q, g, 0, 0, 0); g = __builtin_amdgcn_mfma_f32_32x32x16_bf16(mo::pack8(ra, rb), q, g, 0, 0, 0); }
    unsigned selm = 0u; const float NEG = -__builtin_inff();
#pragma unroll
    for (int k = 0; k < 3; ++k) { float bv = NEG; int bi = 64;
#pragma unroll
        for (int r = 0; r < 16; ++r) { const int n = mo::crow(r, hi); const float v = (n < b && !((selm >> n) & 1u)) ? g[r] : NEG; if (v > bv) { bv = v; bi = n; } }
        float ov; int oi; { auto rv = __builtin_amdgcn_permlane32_swap(__float_as_uint(bv), __float_as_uint(bv), false, false); auto ri = __builtin_amdgcn_permlane32_swap((unsigned)bi, (unsigned)bi, false, false);
            ov = __uint_as_float(hi ? rv[0] : rv[1]); oi = (int)(hi ? ri[0] : ri[1]); }
        if (ov > bv || (ov == bv && oi < bi)) { bv = ov; bi = oi; }
        if (bv > NEG) selm |= 1u << bi; }
    if (hi == 0) P.SEL[hs * S + row] = selm;
    int mine = 0;
    for (int n = 0; n < 31; ++n) { const int c = __popcll(__ballot(hi == 0 && ((selm >> n) & 1u))); if (lane == n) mine = c; }
    if (lane < 31 && mine) { atomicAdd(P.SELCNT + (l * 3 + hs) * 32 + lane, mine); atomicAdd(P.BCNT + ((l * 3 + hs) * 32 + lane) * 32 + b, mine); }
}
__device__ __forceinline__ void att_rowlist(const Ptrs& P, LAS unsigned char* lds3, int l, int hs, int n, int j, int tid) {
    const int lane = tid & 63, wave = tid >> 6;
    LAS int* rl = (LAS int*)(lds3 + mo::ATT_RL); LAS int* sll = (LAS int*)(lds3 + mo::ATT_SL); LAS int* wtot = (LAS int*)(lds3 + mo::ATT_WS);
    if (tid < 256) { rl[tid] = S - 1; sll[tid] = -1; }
    const int bc = __hip_atomic_load(P.BCNT + ((l * 3 + hs) * 32 + n) * 32 + (lane & 31), RLX_AGENT);
    int pre = 0, b0 = -1, b1 = 0, skip = 0;
    for (int bq = 0; bq < 32; ++bq) { const int c = __builtin_amdgcn_readlane(bc, bq); const int lo = pre, hi = pre + c; pre = hi;
        if (c > 0 && hi > 256 * j && lo < 256 * j + 256) { if (b0 < 0) { b0 = bq; skip = lo; } b1 = bq + 1; } }
    if (b0 < 0) { b0 = 31; b1 = 32; skip = 0; }
    const int base = 256 * b0, R = 256 * (b1 - b0), per = (R + 511) / 512;
    const GAS char* selp = (const GAS char*)((const GAS unsigned*)P.SEL + hs * S);
#define SELLD(r_) (*(const GAS unsigned*)(selp + (unsigned)(((r_) < S ? (r_) : S - 1) * 4)))
    int cnt = 0;
#pragma unroll 4
    for (int i = 0; i < 16; ++i) { const int r = base + tid * per + i; const unsigned x = SELLD(r); cnt += (i < per && tid * per + i < R) ? ((x >> n) & 1u) : 0u; }
    int inc = cnt;
#pragma unroll
    for (int o = 1; o < 64; o <<= 1) { const int t = __builtin_amdgcn_ds_bpermute(((lane - o) & 63) << 2, inc); if (lane >= o) inc += t; }
    if (lane == 63) wtot[wave] = inc;
    __syncthreads();
    int woff = 0;
#pragma unroll
    for (int w = 0; w < 8; ++w) { const int a = wtot[w]; if (w < wave) woff += a; }
    int rank = skip + woff + inc - cnt - 256 * j;
    int tid2 = tid; asm volatile("" : "+v"(tid2));
#pragma unroll 4
    for (int i = 0; i < 16; ++i) { const int r = base + tid2 * per + i; const unsigned x = SELLD(r);
        if (i < per && tid2 * per + i < R && ((x >> n) & 1u)) { if (rank >= 0 && rank < 256) { rl[rank] = r; sll[rank] = __popc(x & ((1u << n) - 1u)); } ++rank; } }
    __syncthreads();
#undef SELLD
}
__device__ __forceinline__ void m2_attn(const Ptrs& P, char* lds, LAS unsigned char* lds3, int l) {
    { const int v0 = blockIdx.x; if (v0 >= 256) return;
        const int v = (v0 & 7) * 32 + (v0 >> 3);
        int lane_p_; asm volatile("v_mbcnt_lo_u32_b32 %0, -1, 0\n\tv_mbcnt_hi_u32_b32 %0, -1, %0" : "=v"(lane_p_));
        if (v >= ATT_ND) {
            const int g = v - ATT_ND;
            LAS int* cntl = (LAS int*)(lds3 + RING_BYTES + 6144);
            { const int c0 = __hip_atomic_load(P.SELCNT + l * 96 + lane_p_, RLX_AGENT), c1 = __hip_atomic_load(P.SELCNT + l * 96 + 64 + (lane_p_ & 31), RLX_AGENT);
              if (P.wv == 0) { cntl[lane_p_] = c0; if (lane_p_ < 32) cntl[64 + lane_p_] = c1; } }
            __syncthreads();
            int ui = 0;
            for (int e = 0; e < 96; ++e) { if ((e & 31) == 31) continue; const int c = __builtin_amdgcn_readfirstlane(cntl[e]); const int nu = (c + 255) >> 8;
                int j = (g - ui % ATT_NG + ATT_NG) % ATT_NG;
                for (; j < nu; j += ATT_NG) {
                    const int hs = e >> 5, n = e & 31;
                    att_rowlist(P, lds3, l, hs, n, j, P.wv * 64 + lane_p_);
                    mo::Head H; H.ws = P.ws; H.h = 5 + hs; H.l = l; H.sl = exp2f(-(float)(6 + hs)) * (1.0f / mo::SCALE);
                    mo::Seg sg; sg.P0 = 0; sg.jb = 4 * n; sg.je = 4 * n + 4; sg.slot = 0;
                    mo::Seam Sm;
                    mo::att_prime<true>(H, sg, lds, lds3, Sm, P.wv);
                    mo::att_block<true>(H, sg, sg, lds, lds3, Sm, P.wv); }
                ui += nu; }
            return; }
        const AttPlan pl = att_plan(P.PLAN + l * 32, v, lane_p_); const int h = pl.h;
        mo::Head H; H.ws = P.ws; H.h = h; H.l = l; H.sl = exp2f(-(float)(h + 1)) * (1.0f / mo::SCALE);
        SegIter it; it.b = 0; it.pre = 0; it.lo = (pl.w * pl.T) / pl.W; it.hi = ((pl.w + 1) * pl.T) / pl.W; it.rt = pl.rt; it.v = v; it.h = h;
        mo::Seg cur, nxt; if (!it.next(cur)) return;
        bool more = it.next(nxt);
        mo::Seam Sm;
        mo::att_prime<false>(H, cur, lds, lds3, Sm, P.wv);
        for (;;) { const mo::Seg nx = more ? nxt : cur; mo::att_block<false>(H, cur, nx, lds, lds3, Sm, P.wv); if (!more) break; cur = nxt; more = it.next(nxt); }
    }
}
__device__ __forceinline__ void m3_attn_merge(const Ptrs& P, int l) {
    OPAQUE_TID();
    constexpr float C2 = 1.4426950408889634f * mo::SCALE;
    for (int s = blockIdx.x; s < 1024; s += P.G) { const int hb = s < 384 ? 160 + (s >> 2) : ((s - 384) >> 2), qt = s & 3; const int h = hb >> 5, b = hb & 31;
        int rt = 0, T = 1, W = 1, vbase = 0;
        { const int val = __hip_atomic_load(P.PLAN + l * 32 + (lane & 31), RLX_AGENT);
#pragma unroll
            for (int hh = 0; hh < 8; ++hh) if (hh == h) { rt = __builtin_amdgcn_readlane(val, 4 * hh); T = __builtin_amdgcn_readlane(val, 4 * hh + 1); vbase = __builtin_amdgcn_readlane(val, 4 * hh + 2); W = __builtin_amdgcn_readlane(val, 4 * hh + 3); } }
        int pb = 0; for (int bb = 0; bb < b; ++bb) { const int jl = 4 * bb - rt; pb += 4 * (bb + 1) - (jl > 0 ? jl : 0); }
        const int jl0 = 4 * b - rt, nb = 4 * (b + 1) - (jl0 > 0 ? jl0 : 0);
        int w1 = (pb * W) / T; while (w1 > 0 && (w1 * T) / W > pb) --w1; while (((w1 + 1) * T) / W <= pb) ++w1;
        const bool whole = (w1 * T) / W <= pb && ((w1 + 1) * T) / W >= pb + nb;
        if (whole && h < 5) continue;
        int slots[ATT_MAXP]; int np = 0;
#pragma unroll
        for (int k = 0; k < ATT_MAXP; ++k) { const int w = w1 + k, lo = (w * T) / W; const bool on = w < W && lo < pb + nb; slots[k] = on ? ((pb < lo) ? 2 * (vbase + w) : 2 * (vbase + w) + 1) : 0; np += on ? 1 : 0; }
        if (whole) { slots[0] = 512 + (h - 5) * 32 + b; np = 1; }
        const int c8 = (tid & 15) * 8, rbase = 64 * qt + (tid >> 4);
        if (np <= 2) {
            const bool two = np == 2, gath = h >= 5; const int s0 = slots[0], s1 = two ? slots[1] : slots[0];
            f32x2v mlA[2], mlB[2]; f32x4 oA[2][2], oB[2][2]; f32x2v gml[2][3]; f32x4 go[2][3][2]; unsigned selw[2] = {0u, 0u};
#pragma unroll
            for (int r = 0; r < 2; ++r) { const int row = rbase + 32 * r;
                mlA[r] = *(const GAS f32x2v*)((const GAS float*)P.PML + ((size_t)s0 * 256 + row) * 2); mlB[r] = *(const GAS f32x2v*)((const GAS float*)P.PML + ((size_t)s1 * 256 + row) * 2);
                const GAS float* o0 = (const GAS float*)P.T + ((size_t)s0 * 256 + row) * 128 + c8; const GAS float* o1 = (const GAS float*)P.T + ((size_t)s1 * 256 + row) * 128 + c8;
                oA[r][0] = *(const GAS f32x4*)o0; oA[r][1] = *(const GAS f32x4*)(o0 + 4); oB[r][0] = *(const GAS f32x4*)o1; oB[r][1] = *(const GAS f32x4*)(o1 + 4); }
            if (gath) {
#pragma unroll
                for (int r = 0; r < 2; ++r) { const int qrow = b * 256 + rbase + 32 * r; selw[r] = ((const GAS unsigned*)P.SEL)[(h - 5) * S + qrow];
                    const GAS float* gp = (const GAS float*)P.RPML + ((size_t)(h - 5) * S + qrow) * 6; const GAS float* rp = (const GAS float*)P.RP + ((size_t)(h - 5) * S + qrow) * 384 + c8;
#pragma unroll
                    for (int k = 0; k < 3; ++k) { gml[r][k] = *(const GAS f32x2v*)(gp + 2 * k); go[r][k][0] = *(const GAS f32x4*)(rp + k * 128); go[r][k][1] = *(const GAS f32x4*)(rp + k * 128 + 4); } } }
#pragma unroll
            for (int r = 0; r < 2; ++r) { const int row = rbase + 32 * r; const int ng = gath ? __popc(selw[r]) : 0;
                float M = mlA[r].x; if (two) M = fmaxf(M, mlB[r].x);
                if (gath) {
#pragma unroll
                    for (int k = 0; k < 3; ++k) M = fmaxf(M, k < ng ? gml[r][k].x : -3.0e38f); }
                const float wA = __builtin_amdgcn_exp2f((mlA[r].x - M) * C2), wB = two ? __builtin_amdgcn_exp2f((mlB[r].x - M) * C2) : 0.f;
                float den = wA * mlA[r].y + wB * mlB[r].y; f32x4 a0 = oA[r][0] * wA + oB[r][0] * wB, a1 = oA[r][1] * wA + oB[r][1] * wB;
                if (gath) {
#pragma unroll
                    for (int k = 0; k < 3; ++k) { const float wgt = k < ng ? __builtin_amdgcn_exp2f((gml[r][k].x - M) * C2) : 0.f; den += wgt * (k < ng ? gml[r][k].y : 0.f);
                        a0 += (k < ng ? go[r][k][0] : f32x4{0.f, 0.f, 0.f, 0.f}) * wgt; a1 += (k < ng ? go[r][k][1] : f32x4{0.f, 0.f, 0.f, 0.f}) * wgt; } }
                const float inv = 1.0f / den; a0 = a0 * inv; a1 = a1 * inv;
                v4u wv; wv.x = pk2(a0.x, a0.y); wv.y = pk2(a0.z, a0.w); wv.z = pk2(a1.x, a1.y); wv.w = pk2(a1.z, a1.w);
                ST16P((P.A3 + (size_t)(b * 256 + row) * 1024 + h * 128 + c8), wv); }
            continue;
        }
        for (int rr = 0; rr < 2; ++rr) { const int row = rbase + 32 * rr;
            float m[ATT_MAXP], lsum[ATT_MAXP]; float M = -3.0e38f;
#pragma unroll
            for (int k = 0; k < ATT_MAXP; ++k) if (k < np) { const float* ml = P.PML + ((size_t)slots[k] * 256 + row) * 2; m[k] = ml[0]; lsum[k] = ml[1]; M = fmaxf(M, m[k]); }
            f32x4 a0 = {0.f, 0.f, 0.f, 0.f}, a1 = a0; float den = 0.f;
#pragma unroll
            for (int k = 0; k < ATT_MAXP; ++k) if (k < np) { const float wgt = __builtin_amdgcn_exp2f((m[k] - M) * C2); den += wgt * lsum[k];
                const float* o = P.T + ((size_t)slots[k] * 256 + row) * 128 + c8; a0 += *(const f32x4*)o * wgt; a1 += *(const f32x4*)(o + 4) * wgt; }
            const float inv = 1.0f / den; a0 = a0 * inv; a1 = a1 * inv;
            v4u wv; wv.x = pk2(a0.x, a0.y); wv.y = pk2(a0.z, a0.w); wv.z = pk2(a1.x, a1.y); wv.w = pk2(a1.z, a1.w);
            ST16P((P.A3 + (size_t)(b * 256 + row) * 1024 + h * 128 + c8), wv); }
    }
}
__device__ __forceinline__ void m3_gla_out(const Ptrs& P, LAS unsigned char* lds, int l) {
    OPAQUE_TID();
    LAS float* bcum = (LAS float*)lds; LAS unsigned char* QI = lds + 32768; LAS unsigned char* KI = lds + 50176; LAS unsigned char* VL = lds + 67584; LAS unsigned char* XS = lds + 104448; LAS float* tot = (LAS float*)(lds + 113664);
    LAS unsigned char* OL = lds;
    const int hl = lane >> 5, fc = tid >> 3, fpart = tid & 7;
    f32x4 gw[8]; { const GAS f32x4* gp = (const GAS f32x4*)(P.gla_norm_w + l * 256 + 32 * fpart);
#pragma unroll
        for (int j = 0; j < 8; ++j) gw[j] = gp[j]; }
    for (int unit = blockIdx.x; unit < 512; unit += P.G) { const int h = unit >> 7, n = unit & 127, t0 = n * 64;

        float la[16]; { const GAS float* p = (const GAS float*)P.LA + (size_t)(t0 + 16 * (tid >> 7)) * 512 + h * 128 + (tid & 127);
#pragma unroll
            for (int i = 0; i < 16; ++i) la[i] = p[(size_t)i * 512]; }
        v4u qq[2], kq[2], vv[4], rv[4]; bf16x8 spf[8];
#pragma unroll
        for (int i = 0; i < 2; ++i) { const int idx = tid + 512 * i, s = idx >> 4, ch = idx & 15; const GAS bf16* pr = (const GAS bf16*)P.PROJ + (size_t)(t0 + s) * LDP + h * 128 + 8 * ch;
            qq[i] = *(const GAS v4u*)(pr + PC_QG); kq[i] = *(const GAS v4u*)(pr + PC_KG); }
#pragma unroll
        for (int j = 0; j < 4; ++j) { const int idx = tid + 512 * j, s = idx >> 5, ch = idx & 31; vv[j] = *(const GAS v4u*)((const GAS bf16*)P.PROJ + (size_t)(t0 + s) * LDP + PC_VG + h * 256 + 8 * ch); }
        { const GAS bf16* spt = (const GAS bf16*)P.SPT + ((size_t)(h * 128 + n) * 256 + 32 * wave + (lane & 31)) * 128 + 8 * hl;
#pragma unroll
            for (int kk = 0; kk < 8; ++kk) spf[kk] = *(const GAS bf16x8*)(spt + 16 * kk); }
        { const GAS bf16* rp = (const GAS bf16*)P.PROJ + (size_t)(t0 + fc) * LDP + PC_RG + h * 256 + 32 * fpart;
#pragma unroll
            for (int j = 0; j < 4; ++j) rv[j] = *(const GAS v4u*)(rp + 8 * j); }
        gla_cumsum(la, tid, tot, bcum);

#pragma unroll
        for (int i = 0; i < 2; ++i) { const int idx = tid + 512 * i, s = idx >> 4, ch = idx & 15;
            const f32x4 b0 = *(const LAS f32x4*)(bcum + s * 128 + 8 * ch), b1 = *(const LAS f32x4*)(bcum + s * 128 + 8 * ch + 4);
            const float bb[8] = {b0.x, b0.y, b0.z, b0.w, b1.x, b1.y, b1.z, b1.w}; float q[8], k[8], qi[8], ki[8]; unpack8(qq[i], q); unpack8(kq[i], k);
#pragma unroll
            for (int j = 0; j < 8; ++j) { qi[j] = q[j] * 0.08838834764831845f * __expf(bb[j]); ki[j] = k[j] * __expf(-bb[j]); }
            v4u w; w.x = pk2(qi[0], qi[1]); w.y = pk2(qi[2], qi[3]); w.z = pk2(qi[4], qi[5]); w.w = pk2(qi[6], qi[7]); *(LAS v4u*)(QI + s * GL_QK_STRIDE + ch * 16) = w;
            w.x = pk2(ki[0], ki[1]); w.y = pk2(ki[2], ki[3]); w.z = pk2(ki[4], ki[5]); w.w = pk2(ki[6], ki[7]); *(LAS v4u*)(KI + s * GL_QK_STRIDE + ch * 16) = w; }
#pragma unroll
        for (int j = 0; j < 4; ++j) { const int idx = tid + 512 * j, s = idx >> 5, ch = idx & 31; *(LAS v4u*)(VL + s * GL_VL_STRIDE + ch * 16) = vv[j]; }
        __syncthreads();

        if (wave < 3) {
            const int ct = wave > 0 ? 1 : 0, st = wave > 1 ? 1 : 0; f32x16 x;
#pragma unroll
            for (int r = 0; r < 16; ++r) x[r] = 0.f;
#pragma unroll
            for (int kk = 0; kk < 8; ++kk) x = __builtin_amdgcn_mfma_f32_32x32x16_bf16(row_frag(QI, GL_QK_STRIDE, 32 * ct, 16 * kk, lane), row_frag(KI, GL_QK_STRIDE, 32 * st, 16 * kk, lane), x, 0, 0, 0);
#pragma unroll
            for (int r = 0; r < 16; ++r) { const int c = 32 * ct + crow(r, hl), sidx = 32 * st + (lane & 31); *(LAS bf16*)(XS + c * GL_XS_STRIDE + sidx * 2) = (bf16)f2bf(sidx <= c ? x[r] : 0.f); }
        } else if (wave == 3) {
#pragma unroll
            for (int r = 0; r < 16; ++r) *(LAS bf16*)(XS + crow(r, hl) * GL_XS_STRIDE + (32 + (lane & 31)) * 2) = (bf16)0;
        }
        f32x16 acc0, acc1;
#pragma unroll
        for (int r = 0; r < 16; ++r) { acc0[r] = 0.f; acc1[r] = 0.f; }
#pragma unroll
        for (int kk = 0; kk < 8; ++kk) {
            acc0 = __builtin_amdgcn_mfma_f32_32x32x16_bf16(row_frag(QI, GL_QK_STRIDE, 0, 16 * kk, lane), spf[kk], acc0, 0, 0, 0);
            acc1 = __builtin_amdgcn_mfma_f32_32x32x16_bf16(row_frag(QI, GL_QK_STRIDE, 32, 16 * kk, lane), spf[kk], acc1, 0, 0, 0); }
        __syncthreads();
#pragma unroll
        for (int ks = 0; ks < 4; ++ks) { const bf16x8 bfr = tr_frag(VL, GL_VL_STRIDE, 16 * ks, 32 * wave, lane);
            acc0 = __builtin_amdgcn_mfma_f32_32x32x16_bf16(row_frag(XS, GL_XS_STRIDE, 0, 16 * ks, lane), bfr, acc0, 0, 0, 0);
            acc1 = __builtin_amdgcn_mfma_f32_32x32x16_bf16(row_frag(XS, GL_XS_STRIDE, 32, 16 * ks, lane), bfr, acc1, 0, 0, 0); }
        __syncthreads();

#pragma unroll
        for (int r = 0; r < 16; ++r) { *(LAS float*)(OL + crow(r, hl) * GL_OL_STRIDE + (32 * wave + (lane & 31)) * 4) = acc0[r]; *(LAS float*)(OL + (32 + crow(r, hl)) * GL_OL_STRIDE + (32 * wave + (lane & 31)) * 4) = acc1[r]; }
        __syncthreads();
        { const int row = t0 + fc; float o[32]; float ss = 0.f;
#pragma unroll
            for (int j = 0; j < 8; ++j) { const f32x4 v = *(const LAS f32x4*)(OL + fc * GL_OL_STRIDE + (32 * fpart + 4 * j) * 4); o[4 * j] = v.x; o[4 * j + 1] = v.y; o[4 * j + 2] = v.z; o[4 * j + 3] = v.w; ss += (v.x * v.x + v.y * v.y) + (v.z * v.z + v.w * v.w); }
            ss += xshfl<1>(ss); ss += xshfl<2>(ss); ss += xshfl<4>(ss);
            const float inv = rsqrtf(ss * (1.0f / 256.0f) + RMS_EPS);
            GAS bf16* op = (GAS bf16*)P.A3 + (size_t)S * 1024 + (size_t)row * 1024 + h * 256 + 32 * fpart;
#pragma unroll
            for (int j = 0; j < 4; ++j) { float r[8], y[8]; unpack8(rv[j], r); const f32x4 g0 = gw[2 * j], g1 = gw[2 * j + 1]; const float gg[8] = {g0.x, g0.y, g0.z, g0.w, g1.x, g1.y, g1.z, g1.w};
#pragma unroll
                for (int bq = 0; bq < 8; ++bq) y[bq] = o[8 * j + bq] * inv * gg[bq] * (r[bq] / (1.0f + __expf(-r[bq])));
                v4u w; w.x = pk2(y[0], y[1]); w.y = pk2(y[2], y[3]); w.z = pk2(y[4], y[5]); w.w = pk2(y[6], y[7]);
                ST16((op + 8 * j), w); } }
        __syncthreads();

    }
}

__global__ void __launch_bounds__(NWAVES * 64, 2) mk_fwd(Args args) {
    extern __shared__ __attribute__((aligned(16))) unsigned char lds_raw[];
    LAS unsigned char* lds = (LAS unsigned char*)lds_raw;
    const int wv = __builtin_amdgcn_readfirstlane((int)threadIdx.x >> 6);
#define LOAD_PTRS() Ptrs P; do { KPTR kp_ = (KPTR)__builtin_amdgcn_kernarg_segment_ptr(); asm volatile("" : "+s"(kp_)); fill_ptrs(P, kp_, wv); } while (0)
    for (int u = threadIdx.x; u < (LDS_BYTES - LDSCTL_OFF) / 4; u += NWAVES * 64) ((LAS unsigned*)(lds + LDSCTL_OFF))[u] = 0u;
    __syncthreads();
    const int lo = args.ph_lo, hi = args.ph_hi;
    unsigned* barw = (unsigned*)(args.ws + WS_CTL) + CW_BAR + args.li * XCD_BAR_WORDS;
    XcdBarrier bar; bar.bar = barw; bar.x = 0; bar.st = nullptr;
    if (hi - lo > 1) bar = xcd_barrier_post(barw, (volatile LAS unsigned*)(lds + MISC_OFF) + 8);
#define IN(k) (lo <= (k) && (k) < hi)
#define SEAM(k) do { if ((k) + 1 < hi) { int l0_; asm volatile("v_mbcnt_lo_u32_b32 %0, -1, 0\n\tv_mbcnt_hi_u32_b32 %0, -1, %0" : "=v"(l0_)); xcd_barrier(bar, wv == 0 && l0_ == 0); } } while (0)
 if (IN(0)) { LOAD_PTRS(); p0_prologue(P, lds); SEAM(0); }
    for (int l = 0; l < NL; ++l) {
        const int pb = 1 + 8 * l;

        if (IN(pb + 0)) {
            LOAD_PTRS(); unsigned char* wl = P.ws + WS_W + (size_t)l * WL_BYTES;
            pg8::Gemm g{P.XB, (const bf16*)(wl + WL_IN), S, NPROJ, D}; pg8::StaticOrder So; So.init(S, NPROJ, P.G, (int)blockIdx.x);
            EpiProj E{P.PROJ, P.QKVH, P.LA, P.stats + (size_t)(2 * l) * S, P.gla_b + l * 512, P.KSUM + (size_t)l * 32 * 1024, P.QKMAX + l * 64};
            pg8::gemm_phase<EpiProj, pg8::StaticOrder, true, true>(lds, g, So, E, P.wv);
            if (l + 1 < NL && (int)blockIdx.x >= 192) convert_items(P, lds, R_T1, l + 1, 0, 1, 0, 0, 0, (int)blockIdx.x - 192, 64);
            SEAM(pb + 0); }

        if (IN(pb + 1)) { LOAD_PTRS(); { m1_att_select(P, l); m1_kmean_conv(P, l);  m1_gla_local(P, lds); } SEAM(pb + 1); }

        if (IN(pb + 2)) { LOAD_PTRS(); m2_gla_scan(P);  m2_attn(P, (char*)lds_raw, lds, l);  SEAM(pb + 2); }

        if (IN(pb + 3)) { LOAD_PTRS(); { m3_attn_merge(P, l);  m3_gla_out(P, lds, l); } SEAM(pb + 3); }

        if (IN(pb + 4)) {
            LOAD_PTRS(); unsigned char* wl = P.ws + WS_W + (size_t)l * WL_BYTES;
            pg8::Gemm g{P.A3, (const bf16*)(wl + WL_BR), 3 * S, 3 * D, 1024}; BranchOrder Bo; Bo.so.init(S, D, P.G, (int)blockIdx.x);
            EpiBranch E{P.PROJ, P.MIXED};
            pg8::gemm_phase<EpiBranch, BranchOrder, true, true>(lds, g, Bo, E, P.wv);
            SEAM(pb + 4); }

        if (IN(pb + 5)) {
            LOAD_PTRS(); unsigned char* wl = P.ws + WS_W + (size_t)l * WL_BYTES;
            pg8::Gemm g{P.MIXED, (const bf16*)(wl + WL_OUT), S, D, D}; pg8::StaticOrder So; So.init(S, D, P.G, (int)blockIdx.x);
            EpiResid E{P.XB, P.stats + (size_t)(2 * l + 1) * S};
            pg8::gemm_phase<EpiResid, pg8::StaticOrder, true, true>(lds, g, So, E, P.wv);
            SEAM(pb + 5); }

        if (IN(pb + 6)) {
            LOAD_PTRS(); unsigned char* wl = P.ws + WS_W + (size_t)l * WL_BYTES;
            pg8::Gemm g{P.XB, (const bf16*)(wl + WL_GU), S, 2 * DFF, D}; pg8::StaticOrder So; So.init(S, 2 * DFF, P.G, (int)blockIdx.x);
            EpiGU E{P.ACT, P.stats + (size_t)(2 * l + 1) * S};
            pg8::gemm_phase<EpiGU, pg8::StaticOrder, true, true>(lds, g, So, E, P.wv);
            if (l + 1 < NL && (int)blockIdx.x >= 128) convert_items(P, lds, R_TAIL - R_T1, l + 1, R_T1, 1, 0, 0, 0, (int)blockIdx.x - 128, 128);
            SEAM(pb + 6); }

        if (IN(pb + 7)) {
            LOAD_PTRS(); unsigned char* wl = P.ws + WS_W + (size_t)l * WL_BYTES;
            pg8::Gemm g{P.ACT, (const bf16*)(wl + WL_DN), S, D, DFF}; pg8::StaticOrder So; So.init(S, D, P.G, (int)blockIdx.x);
            EpiResid E{P.XB, P.stats + (size_t)(2 * l + 2) * S};
            pg8::gemm_phase<EpiResid, pg8::StaticOrder, true, true>(lds, g, So, E, P.wv);
            SEAM(pb + 7); }

    }
    if (IN(NPH - 1)) { LOAD_PTRS(); final_norm(P); }
#undef IN
#undef SEAM
}

#ifndef MK_SPLIT
#define MK_SPLIT 0
#endif
extern "C" void kernel_launch(void* const* d_in, const int* in_sizes, int n_in, void* d_out, int out_size, void* d_ws, size_t ws_size, hipStream_t stream) {
    static int grid = 0;
    if (grid == 0) {
        if (n_in != 16 || out_size != S * D || ws_size < WS_END) { fprintf(stderr, "kernel_launch: unexpected shapes (n_in %d out %d ws %zu)\n", n_in, out_size, ws_size); grid = -1; return; }
        int dev = 0, cus = 0, per_cu = 0;
        if (hipGetDevice(&dev) != hipSuccess || hipDeviceGetAttribute(&cus, hipDeviceAttributeMultiprocessorCount, dev) != hipSuccess) { grid = -1; return; }
        if (hipFuncSetAttribute((const void*)mk_fwd, hipFuncAttributeMaxDynamicSharedMemorySize, LDS_BYTES) != hipSuccess) { fprintf(stderr, "kernel_launch: hipFuncSetAttribute failed\n"); grid = -1; return; }
        if (hipOccupancyMaxActiveBlocksPerMultiprocessor(&per_cu, (const void*)mk_fwd, NWAVES * 64, LDS_BYTES) != hipSuccess || per_cu < 1) fprintf(stderr, "kernel_launch: occupancy query says %d\n", per_cu);
        (void)hipGetLastError();
        grid = cus;
        if (cus != 256) { fprintf(stderr, "kernel_launch: built for 256 CUs, found %d\n", cus); grid = -1; return; }
    }
    if (grid < 0) return;
    if (hipMemsetAsync((char*)d_ws + WS_CTL, 0, CTL_ZERO_BYTES, stream) != hipSuccess) return;
    Args a{};
    for (int i = 0; i < 16; ++i) a.in[i] = (const float*)d_in[i];
    a.out = (float*)d_out; a.ws = (unsigned char*)d_ws; a.pad = 0;
#if MK_SPLIT
    for (int p = 0; p < NPH; ++p) { a.ph_lo = p; a.ph_hi = p + 1; a.li = 0; hipLaunchKernelGGL(mk_fwd, dim3(grid), dim3(NWAVES * 64), LDS_BYTES, stream, a); }
#else
    a.ph_lo = 0; a.ph_hi = NPH; a.li = 0;
    hipLaunchKernelGGL(mk_fwd, dim3(grid), dim3(NWAVES * 64), LDS_BYTES, stream, a);
#endif
}
```
